# Optimizing an MI355X kernel written in HIP

```python
import math
import jax, jax.numpy as jnp
from jax import lax
import numpy as np

D_MODEL = 2048
BATCH = 1
SEQ = 8192
DEPTH = 4

CHUNK = 64
Q_BLOCK = 128
D_MIX = D_MODEL

MLA_HEADS = 6
MLA_NOPE = 128
MLA_ROPE = 64
MLA_V = 128
MLA_Q_RANK = 512
MLA_KV_RANK = 256
MLA_WIDTH = MLA_HEADS * MLA_V
ROPE_THETA = 10000.0

SG_GROUPS = 4
SG_GROUP_CH = 128
SG_WIDTH = SG_GROUPS * SG_GROUP_CH
SG_CHUNK = 128

SB_HEADS = 4
SB_HEAD_DIM = 128
SB_WIDTH = SB_HEADS * SB_HEAD_DIM

MEM_TOKENS = 256
MEM_HEADS = 4
MEM_HEAD_DIM = 64
MEM_WIDTH = MEM_HEADS * MEM_HEAD_DIM

IN_SIZES = (MLA_Q_RANK, MLA_KV_RANK, MLA_ROPE, MLA_WIDTH,
            SG_WIDTH, SG_WIDTH, SG_WIDTH,
            SB_WIDTH, SB_WIDTH, SB_WIDTH, SB_WIDTH,
            MEM_WIDTH, MEM_WIDTH)
D_IN = sum(IN_SIZES)

DEEPNORM_ALPHA = (2.0 * DEPTH) ** 0.25
DEEPNORM_BETA = (8.0 * DEPTH) ** -0.25
LN_EPS = 1e-5
RMS_EPS = 1e-6

kernel_name = "hybrid_mla_gmlp_stickbreak_deepnorm"


def _layer_norm(x, g, b):
    xf = x.astype(jnp.float32)
    mu = jnp.mean(xf, axis=-1, keepdims=True)
    xc = xf - mu
    var = jnp.mean(xc * xc, axis=-1, keepdims=True)
    return (xc * lax.rsqrt(var + LN_EPS) * g.astype(jnp.float32) + b.astype(jnp.float32)).astype(x.dtype)


def _rms_norm(x, g):
    xf = x.astype(jnp.float32)
    ms = jnp.mean(xf * xf, axis=-1, keepdims=True)
    return (xf * lax.rsqrt(ms + RMS_EPS) * g.astype(jnp.float32)).astype(x.dtype)


def _rope(x, cos, sin):
    half = x.shape[-1] // 2
    x1, x2 = x[..., :half], x[..., half:]
    return jnp.concatenate([x1 * cos - x2 * sin, x1 * sin + x2 * cos], axis=-1)


def _sweep_query_blocks(block_fn, q):
    b, s, h, d = q.shape
    nb = s // Q_BLOCK
    qb = q.reshape(b, nb, Q_BLOCK, h, d).transpose(1, 0, 2, 3, 4)
    out = lax.map(block_fn, (qb, jnp.arange(nb, dtype=jnp.int32)))
    return out.transpose(1, 0, 2, 3, 4).reshape(b, s, h, out.shape[-1])


def _chunk_causal_softmax_attention(q, k, v, scale):
    key_chunk = jnp.arange(k.shape[1]) // CHUNK

    def block(args):
        qblk, i = args
        qpos = i * Q_BLOCK + jnp.arange(Q_BLOCK)
        logits = jnp.einsum('bqhd,bkhd->bhqk', qblk, k).astype(jnp.float32) * scale
        mask = key_chunk[None, :] <= (qpos // CHUNK)[:, None]
        p = jax.nn.softmax(jnp.where(mask, logits, -jnp.inf), axis=-1)
        return jnp.einsum('bhqk,bkhd->bqhd', p.astype(v.dtype), v)

    return _sweep_query_blocks(block, q)


def _stick_breaking_attention(q, k, v, scale):
    kpos = jnp.arange(k.shape[1])

    def block(args):
        qblk, i = args
        qpos = i * Q_BLOCK + jnp.arange(Q_BLOCK)
        z = jnp.einsum('bqhd,bkhd->bhqk', qblk, k).astype(jnp.float32) * scale
        strict = kpos[None, :] < qpos[:, None]
        log_beta = jax.nn.log_sigmoid(z)
        log_1mb = jnp.where(strict, jax.nn.log_sigmoid(-z), 0.0)
        rev = lax.cumsum(log_1mb, axis=3, reverse=True)
        log_a = log_beta + rev - log_1mb
        a = jnp.where(strict, jnp.exp(log_a), 0.0)
        return jnp.einsum('bhqk,bkhd->bqhd', a.astype(v.dtype), v)

    return _sweep_query_blocks(block, q)


def setup_inputs(seed: int = 0) -> dict:
    key = jax.random.key(seed)
    ks = jax.random.split(key, 20)
    f32 = jnp.float32
    nrm = lambda k, shape, s: jax.random.normal(k, shape, f32) * s
    x = jax.random.normal(ks[0], (BATCH, SEQ, D_MODEL), f32)
    mem = jax.random.normal(ks[1], (BATCH, MEM_TOKENS, D_MODEL), f32)
    offset = jax.random.randint(ks[2], (BATCH, 1), 0, 4096, dtype=jnp.int32)
    positions = (offset + jnp.arange(SEQ, dtype=jnp.int32)[None, :]).astype(jnp.int32)
    w_in = nrm(ks[3], (DEPTH, D_MODEL, D_IN), D_MODEL ** -0.5)
    q_norm_g = 1.0 + nrm(ks[4], (DEPTH, MLA_Q_RANK), 0.01)
    w_uq = nrm(ks[5], (DEPTH, MLA_Q_RANK, MLA_HEADS * (MLA_NOPE + MLA_ROPE)), MLA_Q_RANK ** -0.5)
    kv_norm_g = 1.0 + nrm(ks[6], (DEPTH, MLA_KV_RANK), 0.01)
    w_ukv = nrm(ks[7], (DEPTH, MLA_KV_RANK, MLA_HEADS * (MLA_NOPE + MLA_V)), MLA_KV_RANK ** -0.5)
    sg_ln_g = 1.0 + nrm(ks[8], (DEPTH, SG_WIDTH), 0.01)
    sg_ln_b = nrm(ks[9], (DEPTH, SG_WIDTH), 0.01)
    sg_w = nrm(ks[10], (DEPTH, SG_GROUPS, SG_CHUNK, SG_CHUNK), SG_CHUNK ** -0.5)
    sg_b = 1.0 + nrm(ks[11], (DEPTH, SG_GROUPS, SG_CHUNK), 0.01)
    w_mem_k = nrm(ks[12], (DEPTH, D_MODEL, MEM_WIDTH), D_MODEL ** -0.5)
    w_mem_v = nrm(ks[13], (DEPTH, D_MODEL, MEM_WIDTH), D_MODEL ** -0.5)
    w_out = nrm(ks[14], (DEPTH, D_MIX, D_MODEL), D_MIX ** -0.5 * DEEPNORM_BETA)
    ln_g = 1.0 + nrm(ks[15], (DEPTH, D_MODEL), 0.01)
    ln_b = nrm(ks[16], (DEPTH, D_MODEL), 0.01)
    return {"x": x, "mem": mem, "positions": positions, "w_in": w_in,
            "q_norm_g": q_norm_g, "w_uq": w_uq, "kv_norm_g": kv_norm_g, "w_ukv": w_ukv,
            "sg_ln_g": sg_ln_g, "sg_ln_b": sg_ln_b, "sg_w": sg_w, "sg_b": sg_b,
            "w_mem_k": w_mem_k, "w_mem_v": w_mem_v, "w_out": w_out,
            "ln_g": ln_g, "ln_b": ln_b}


def reference(x, mem, positions, w_in, q_norm_g, w_uq, kv_norm_g, w_ukv,
              sg_ln_g, sg_ln_b, sg_w, sg_b, w_mem_k, w_mem_v, w_out, ln_g, ln_b):
    b, s, _ = x.shape
    inv_freq = ROPE_THETA ** (-jnp.arange(0, MLA_ROPE, 2, dtype=jnp.float32) / MLA_ROPE)
    ang = positions.astype(jnp.float32)[..., None] * inv_freq[None, None, :]
    cos = jnp.cos(ang).astype(x.dtype)
    sin = jnp.sin(ang).astype(x.dtype)
    split_idx = [int(v) for v in np.cumsum(IN_SIZES)[:-1]]
    p_in = jnp.arange(SG_CHUNK) // CHUNK
    sg_mask = (p_in[None, :] <= p_in[:, None]).astype(x.dtype)
    mla_scale = 1.0 / math.sqrt(MLA_NOPE + MLA_ROPE)
    sb_scale = 1.0 / math.sqrt(SB_HEAD_DIM)
    mem_scale = 1.0 / math.sqrt(MEM_HEAD_DIM)

    for l in range(DEPTH):
        h = jnp.einsum('bsd,de->bse', x, w_in[l])
        (c_q, c_kv, k_pe, g_a, sg_u, sg_v, g_b, sb_q, sb_k, sb_v, g_c, m_q, g_m) = jnp.split(h, split_idx, axis=-1)

        q = jnp.einsum('bsr,re->bse', _rms_norm(c_q, q_norm_g[l]), w_uq[l]).reshape(b, s, MLA_HEADS, MLA_NOPE + MLA_ROPE)
        q = jnp.concatenate([q[..., :MLA_NOPE], _rope(q[..., MLA_NOPE:], cos[:, :, None, :], sin[:, :, None, :])], axis=-1)
        kv = jnp.einsum('bsr,re->bse', _rms_norm(c_kv, kv_norm_g[l]), w_ukv[l]).reshape(b, s, MLA_HEADS, MLA_NOPE + MLA_V)
        k_rot = jnp.broadcast_to(_rope(k_pe, cos, sin)[:, :, None, :], (b, s, MLA_HEADS, MLA_ROPE))
        k = jnp.concatenate([kv[..., :MLA_NOPE], k_rot], axis=-1)
        o_a = _chunk_causal_softmax_attention(q, k, kv[..., MLA_NOPE:], mla_scale).reshape(b, s, MLA_WIDTH)

        u = jax.nn.gelu(sg_u)
        vn = _layer_norm(jax.nn.gelu(sg_v), sg_ln_g[l], sg_ln_b[l])
        vn = vn.reshape(b, s // SG_CHUNK, SG_CHUNK, SG_GROUPS, SG_GROUP_CH)
        w_sp = sg_w[l] * sg_mask[None]
        mixed = jnp.einsum('gts,bnsgc->bntgc', w_sp, vn) + sg_b[l].T[None, None, :, :, None]
        o_b = u * mixed.reshape(b, s, SG_WIDTH)

        o_c = _stick_breaking_attention(sb_q.reshape(b, s, SB_HEADS, SB_HEAD_DIM),
                                        sb_k.reshape(b, s, SB_HEADS, SB_HEAD_DIM),
                                        sb_v.reshape(b, s, SB_HEADS, SB_HEAD_DIM), sb_scale).reshape(b, s, SB_WIDTH)

        mk = jnp.einsum('bmd,de->bme', mem, w_mem_k[l]).reshape(b, MEM_TOKENS, MEM_HEADS, MEM_HEAD_DIM)
        mv = jnp.einsum('bmd,de->bme', mem, w_mem_v[l]).reshape(b, MEM_TOKENS, MEM_HEADS, MEM_HEAD_DIM)
        mq = m_q.reshape(b, s, MEM_HEADS, MEM_HEAD_DIM)
        mp = jax.nn.softmax(jnp.einsum('bshe,bmhe->bhsm', mq, mk).astype(jnp.float32) * mem_scale, axis=-1)
        o_m = jnp.einsum('bhsm,bmhe->bshe', mp.astype(mv.dtype), mv).reshape(b, s, MEM_WIDTH)

        y = jnp.concatenate([o_a * jax.nn.silu(g_a), o_b * jax.nn.silu(g_b),
                             o_c * jax.nn.silu(g_c), o_m * jax.nn.silu(g_m)], axis=-1)
        y = jnp.einsum('bse,ed->bsd', y, w_out[l])

        x = _layer_norm(DEEPNORM_ALPHA * x + y, ln_g[l], ln_b[l])
    return x
```

```cpp
#include <hip/hip_runtime.h>
#include <hip/hip_cooperative_groups.h>
#include <cstdio>
namespace cg = cooperative_groups;

typedef unsigned short u16;
using bf16x8 = __attribute__((ext_vector_type(8))) short;
using f32x4 = __attribute__((ext_vector_type(4))) float;
typedef __bf16 bf16x2_t __attribute__((ext_vector_type(2)));
typedef float f32x2_t __attribute__((ext_vector_type(2)));

#define SEQ 8192
#define DM 2048
#define DIN 5696
#define DINP 5760
#define NL 4
#define USE_CG_SYNC 1

constexpr int LDS_BYTES = 73728;
constexpr int CTL_OFF = LDS_BYTES - 64;

constexpr int C_CQ = 0, C_CKV = 512, C_KPE = 768, C_GA = 832, C_SGU = 1600, C_SGV = 2112, C_GB = 2624,
              C_SBQ = 3136, C_SBK = 3648, C_SBV = 4160, C_GC = 4672, C_MQ = 5184, C_GM = 5440;

constexpr size_t al256(size_t x) { return (x + 255) & ~(size_t)255; }
constexpr size_t OFF_BAR = 0;
constexpr size_t OFF_CTR = OFF_BAR + al256(16384);
constexpr size_t OFF_WT_IN = OFF_CTR + al256(256);
constexpr size_t OFF_WT_OUT = OFF_WT_IN + al256((size_t)NL * DINP * DM * 2);
constexpr size_t OFF_WT_UQ = OFF_WT_OUT + al256((size_t)NL * DM * DM * 2);
constexpr size_t OFF_WT_UKV = OFF_WT_UQ + al256((size_t)NL * 1152 * 512 * 2);
constexpr size_t OFF_WT_MEMKV = OFF_WT_UKV + al256((size_t)NL * 1536 * 256 * 2);
constexpr size_t OFF_MEMB = OFF_WT_MEMKV + al256((size_t)NL * 512 * DM * 2);
constexpr size_t OFF_XB = OFF_MEMB + al256((size_t)256 * DM * 2);
constexpr size_t OFF_H = OFF_XB + al256((size_t)SEQ * DM * 2);
constexpr size_t OFF_Q = OFF_H + al256((size_t)SEQ * DIN * 2);
constexpr size_t OFF_K = OFF_Q + al256((size_t)6 * SEQ * 192 * 2);
constexpr size_t OFF_VT = OFF_K + al256((size_t)6 * SEQ * 192 * 2);
constexpr size_t OFF_VTSB = OFF_VT + al256((size_t)6 * 128 * SEQ * 2);
constexpr size_t OFF_YIN = OFF_VTSB + al256((size_t)4 * 128 * SEQ * 2);
constexpr size_t OFF_MK = OFF_YIN + al256((size_t)SEQ * DM * 2);
constexpr size_t OFF_MVT = OFF_MK + al256((size_t)NL * 4 * 256 * 64 * 2);
constexpr size_t OFF_COST = OFF_MVT + al256((size_t)NL * 4 * 64 * 256 * 2);
constexpr size_t OFF_SINT = OFF_COST + al256((size_t)SEQ * 32 * 4);
constexpr size_t WS_TOTAL = OFF_SINT + al256((size_t)SEQ * 32 * 4);
struct Params {
  const float* x; const float* mem; const int* pos; const float* w_in; const float* q_norm_g; const float* w_uq;
  const float* kv_norm_g; const float* w_ukv; const float* sg_ln_g; const float* sg_ln_b; const float* sg_w; const float* sg_b;
  const float* w_mem_k; const float* w_mem_v; const float* w_out; const float* ln_g; const float* ln_b;
  float* out;
  char* ws;
  __device__ __forceinline__ unsigned* bar() const { return (unsigned*)(ws + OFF_BAR); }
  __device__ __forceinline__ unsigned* ctr() const { return (unsigned*)(ws + OFF_CTR); }
  __device__ __forceinline__ u16* wt_in() const { return (u16*)(ws + OFF_WT_IN); }
  __device__ __forceinline__ u16* wt_out() const { return (u16*)(ws + OFF_WT_OUT); }
  __device__ __forceinline__ u16* wt_uq() const { return (u16*)(ws + OFF_WT_UQ); }
  __device__ __forceinline__ u16* wt_ukv() const { return (u16*)(ws + OFF_WT_UKV); }
  __device__ __forceinline__ u16* wt_memkv() const { return (u16*)(ws + OFF_WT_MEMKV); }
  __device__ __forceinline__ u16* memb() const { return (u16*)(ws + OFF_MEMB); }
  __device__ __forceinline__ u16* xb() const { return (u16*)(ws + OFF_XB); }
  __device__ __forceinline__ u16* h() const { return (u16*)(ws + OFF_H); }
  __device__ __forceinline__ u16* q() const { return (u16*)(ws + OFF_Q); }
  __device__ __forceinline__ u16* k() const { return (u16*)(ws + OFF_K); }
  __device__ __forceinline__ u16* vt() const { return (u16*)(ws + OFF_VT); }
  __device__ __forceinline__ u16* vtsb() const { return (u16*)(ws + OFF_VTSB); }
  __device__ __forceinline__ u16* yin() const { return (u16*)(ws + OFF_YIN); }
  __device__ __forceinline__ u16* mk() const { return (u16*)(ws + OFF_MK); }
  __device__ __forceinline__ u16* mvt() const { return (u16*)(ws + OFF_MVT); }
  __device__ __forceinline__ float* cosT() const { return (float*)(ws + OFF_COST); }
  __device__ __forceinline__ float* sinT() const { return (float*)(ws + OFF_SINT); }
};

__device__ __forceinline__ unsigned pack2(float a, float b) {
  f32x2_t v = {a, b};
  bf16x2_t r = __builtin_convertvector(v, bf16x2_t);
  return *(unsigned*)&r;
}
__device__ __forceinline__ u16 f2bf(float a) { return (u16)(pack2(a, 0.f) & 0xffffu); }
__device__ __forceinline__ float bflo(unsigned w) { return __uint_as_float(w << 16); }
__device__ __forceinline__ float bfhi(unsigned w) { return __uint_as_float(w & 0xffff0000u); }
__device__ __forceinline__ float bf2f(u16 h) { return __uint_as_float(((unsigned)h) << 16); }
__device__ __forceinline__ float silu_f(float x) { return x / (1.f + __expf(-x)); }
__device__ __forceinline__ float gelu_f(float x) {
  float u = 0.7978845608028654f * (x + 0.044715f * x * x * x);
  float t = 1.f - 2.f / (__expf(2.f * u) + 1.f);
  return 0.5f * x * (1.f + t);
}
__device__ __forceinline__ f32x4 mfma16(bf16x8 a, bf16x8 b, f32x4 c) {
  return __builtin_amdgcn_mfma_f32_16x16x32_bf16(a, b, c, 0, 0, 0);
}

__device__ __forceinline__ void grid_barrier() {
  cg::this_grid().sync();
}

__device__ void tconv_tile(const float* __restrict__ src, u16* __restrict__ dst, int K, int N, int k0, int n0,
                           const float* __restrict__ g, float* lds) {
  int tid = threadIdx.x;
  asm volatile("" : "+v"(tid));
#pragma unroll
  for (int i = 0; i < 4; ++i) {
    int r = (tid >> 4) + 16 * i, c = (tid & 15) * 4;
    float4 v = make_float4(0.f, 0.f, 0.f, 0.f);
    if (n0 + c < N) v = *(const float4*)(src + (size_t)(k0 + r) * N + n0 + c);
    if (g) { float s = g[k0 + r]; v.x *= s; v.y *= s; v.z *= s; v.w *= s; }
    float* p = lds + r * 65 + c;
    p[0] = v.x; p[1] = v.y; p[2] = v.z; p[3] = v.w;
  }
  __syncthreads();
#pragma unroll
  for (int i = 0; i < 2; ++i) {
    int id = tid + 256 * i, n = id >> 3, kc = (id & 7) * 8;
    unsigned w0 = pack2(lds[(kc + 0) * 65 + n], lds[(kc + 1) * 65 + n]);
    unsigned w1 = pack2(lds[(kc + 2) * 65 + n], lds[(kc + 3) * 65 + n]);
    unsigned w2 = pack2(lds[(kc + 4) * 65 + n], lds[(kc + 5) * 65 + n]);
    unsigned w3 = pack2(lds[(kc + 6) * 65 + n], lds[(kc + 7) * 65 + n]);
    *(uint4*)(dst + (size_t)(n0 + n) * K + k0 + kc) = make_uint4(w0, w1, w2, w3);
  }
  __syncthreads();
}

__device__ void tconv_all(const float* src, u16* dst, int K, int N, int Npad, size_t srcLS, size_t dstLS, int dstRowOff,
                          const float* g, int gS, float* lds) {
  const int nkt = K / 64, nnt = Npad / 64, per = nkt * nnt;
  for (int t = blockIdx.x; t < NL * per; t += gridDim.x) {
    int l = t / per, r = t % per, kt = r / nnt, nt = r % nnt;
    tconv_tile(src + (size_t)l * srcLS, dst + (size_t)l * dstLS + (size_t)dstRowOff * K, K, N, kt * 64, nt * 64,
               g ? g + (size_t)l * gS : nullptr, lds);
  }
}

__device__ void phase_prep(const Params& p, char* smem) {
  float* lds = (float*)smem;
  const int tid = threadIdx.x;
  const size_t gtid = (size_t)blockIdx.x * 256 + tid, gsz = (size_t)gridDim.x * 256;
  if (blockIdx.x == 0 && tid < 16) p.ctr()[tid] = 0u;
  for (size_t c = gtid; c < (size_t)SEQ * DM / 8; c += gsz) {
    float4 a = *(const float4*)(p.x + c * 8), b = *(const float4*)(p.x + c * 8 + 4);
    *(uint4*)(p.xb() + c * 8) = make_uint4(pack2(a.x, a.y), pack2(a.z, a.w), pack2(b.x, b.y), pack2(b.z, b.w));
  }
  for (size_t c = gtid; c < (size_t)256 * DM / 8; c += gsz) {
    float4 a = *(const float4*)(p.mem + c * 8), b = *(const float4*)(p.mem + c * 8 + 4);
    *(uint4*)(p.memb() + c * 8) = make_uint4(pack2(a.x, a.y), pack2(a.z, a.w), pack2(b.x, b.y), pack2(b.z, b.w));
  }
  for (size_t e = gtid; e < (size_t)SEQ * 32; e += gsz) {
    int s = (int)(e >> 5), i = (int)(e & 31);
    float invf = __builtin_amdgcn_exp2f(-(float)i * (13.287712379549449f / 32.0f));
    float ang = (float)p.pos[s] * invf;
    double rev = (double)ang * 0.15915494309189535;
    float fr = (float)(rev - floor(rev));
    p.cosT()[e] = __builtin_amdgcn_cosf(fr);
    p.sinT()[e] = __builtin_amdgcn_sinf(fr);
  }
  tconv_all(p.w_in, p.wt_in(), DM, DIN, DINP, (size_t)DM * DIN, (size_t)DINP * DM, 0, nullptr, 0, lds);
  tconv_all(p.w_out, p.wt_out(), DM, DM, DM, (size_t)DM * DM, (size_t)DM * DM, 0, nullptr, 0, lds);
  tconv_all(p.w_uq, p.wt_uq(), 512, 1152, 1152, (size_t)512 * 1152, (size_t)1152 * 512, 0, p.q_norm_g, 512, lds);
  tconv_all(p.w_ukv, p.wt_ukv(), 256, 1536, 1536, (size_t)256 * 1536, (size_t)1536 * 256, 0, p.kv_norm_g, 256, lds);
  tconv_all(p.w_mem_k, p.wt_memkv(), DM, 256, 256, (size_t)DM * 256, (size_t)512 * DM, 0, nullptr, 0, lds);
  tconv_all(p.w_mem_v, p.wt_memkv(), DM, 256, 256, (size_t)DM * 256, (size_t)512 * DM, 256, nullptr, 0, lds);
}

template <bool SSQ>
__device__ __forceinline__ void gemm_core(const u16* __restrict__ A, int lda, const u16* __restrict__ B, int ldb, int K,
                                          int brow, int bcol, char* smem, f32x4 (&acc)[4][4], float (&ssq)[4],
                                          int wr, int wc, int fr, int fq) {
  int tid = threadIdx.x;
  asm volatile("" : "+v"(tid));
#pragma unroll
  for (int m = 0; m < 4; ++m) {
    ssq[m] = 0.f;
#pragma unroll
    for (int n = 0; n < 4; ++n) acc[m][n] = f32x4{0.f, 0.f, 0.f, 0.f};
  }
  const u16* pa = A + (size_t)(brow + (tid >> 2)) * lda + (tid & 3) * 8;
  const u16* pb = B + (size_t)(bcol + (tid >> 2)) * ldb + (tid & 3) * 8;
  const int nk = K >> 6;
  __syncthreads();
  auto stage = [&](int kt, int buf) __attribute__((always_inline)) {
    char* la = smem + buf * 32768 + tid * 16;
    char* lb = la + 16384;
#pragma unroll
    for (int i = 0; i < 4; ++i) {
      const u16* ga = pa + (size_t)((i & 1) * 64) * lda + (i >> 1) * 32 + kt * 64;
      const u16* gb = pb + (size_t)((i & 1) * 64) * ldb + (i >> 1) * 32 + kt * 64;
      __builtin_amdgcn_global_load_lds((const unsigned*)ga, (unsigned*)(la + i * 4096), 16, 0, 0);
      __builtin_amdgcn_global_load_lds((const unsigned*)gb, (unsigned*)(lb + i * 4096), 16, 0, 0);
    }
  };
  stage(0, 0);
  for (int kt = 0; kt < nk; ++kt) {
    asm volatile("s_waitcnt vmcnt(0)" ::: "memory");
    __syncthreads();
    if (kt + 1 < nk) stage(kt + 1, (kt + 1) & 1);
    const char* sa = smem + (kt & 1) * 32768;
    const char* sb = sa + 16384;
#pragma unroll
    for (int ks = 0; ks < 2; ++ks) {
      bf16x8 af[4], bfr[4];
#pragma unroll
      for (int m = 0; m < 4; ++m) af[m] = *(const bf16x8*)(sa + ks * 8192 + (wr * 64 + m * 16 + fr) * 64 + fq * 16);
#pragma unroll
      for (int n = 0; n < 4; ++n) bfr[n] = *(const bf16x8*)(sb + ks * 8192 + (wc * 64 + n * 16 + fr) * 64 + fq * 16);
      if (SSQ) {
#pragma unroll
        for (int m = 0; m < 4; ++m) {
          const unsigned* w = (const unsigned*)&af[m];
#pragma unroll
          for (int i = 0; i < 4; ++i) { float lo = bflo(w[i]), hi = bfhi(w[i]); ssq[m] += lo * lo + hi * hi; }
        }
      }
#pragma unroll
      for (int m = 0; m < 4; ++m)
#pragma unroll
        for (int n = 0; n < 4; ++n) acc[m][n] = mfma16(bfr[n], af[m], acc[m][n]);
    }
  }
  if (SSQ) {
#pragma unroll
    for (int m = 0; m < 4; ++m) {
      ssq[m] += __shfl_xor(ssq[m], 16);
      ssq[m] += __shfl_xor(ssq[m], 32);
    }
  }
}

__device__ __forceinline__ bool tile_map(int t, int ntn, int& m, int& n) {
  int r = t >> 9, b = t & 511;
  int xcd = b & 7, idx = b >> 3;
  m = xcd * 8 + (idx & 7);
  n = r * 8 + (idx >> 3);
  return n < ntn;
}

__device__ void phaseA_tile(const Params& p, int l, int tm, int tn, char* smem) {
  int tid = threadIdx.x;
  asm volatile("" : "+v"(tid));
  const int wid = __builtin_amdgcn_readfirstlane(tid >> 6), lane = tid & 63;
  const int wr = wid >> 1, wc = wid & 1, fr = lane & 15, fq = lane >> 4;
  f32x4 acc[4][4];
  float ssq[4];
  const int brow = tm * 128, bcol = tn * 128;
  gemm_core<false>(p.xb(), DM, p.wt_in() + (size_t)l * DINP * DM, DM, DM, brow, bcol, smem, acc, ssq, wr, wc, fr, fq);
  const int col0 = bcol + wc * 64;
  int kind;
  if (col0 < C_KPE) kind = 0; else if (col0 < C_GA) kind = 3; else if (col0 < C_SGU) kind = 1;
  else if (col0 < C_GB) kind = 2; else if (col0 < C_SBQ) kind = 1; else if (col0 < C_SBV) kind = 0;
  else if (col0 < C_GC) kind = 4; else if (col0 < C_MQ) kind = 1; else if (col0 < C_GM) kind = 0;
  else if (col0 < DIN) kind = 1; else kind = 5;
  if (kind == 5) return;
  if (kind <= 2) {
#pragma unroll
    for (int m = 0; m < 4; ++m) {
      const int row = brow + wr * 64 + m * 16 + fr;
#pragma unroll
      for (int n = 0; n < 4; ++n) {
        float v0 = acc[m][n][0], v1 = acc[m][n][1], v2 = acc[m][n][2], v3 = acc[m][n][3];
        if (kind == 1) { v0 = silu_f(v0); v1 = silu_f(v1); v2 = silu_f(v2); v3 = silu_f(v3); }
        else if (kind == 2) { v0 = gelu_f(v0); v1 = gelu_f(v1); v2 = gelu_f(v2); v3 = gelu_f(v3); }
        *(uint2*)(p.h() + (size_t)row * DIN + col0 + n * 16 + fq * 4) = make_uint2(pack2(v0, v1), pack2(v2, v3));
      }
    }
  } else if (kind == 3) {
#pragma unroll
    for (int m = 0; m < 4; ++m) {
      const int row = brow + wr * 64 + m * 16 + fr;
#pragma unroll
      for (int n = 0; n < 2; ++n) {
        const int i0 = n * 16 + fq * 4;
        float4 cs = *(const float4*)(p.cosT() + (size_t)row * 32 + i0);
        float4 sn = *(const float4*)(p.sinT() + (size_t)row * 32 + i0);
        f32x4 x1 = acc[m][n], x2 = acc[m][n + 2];
        float a0 = x1[0] * cs.x - x2[0] * sn.x, a1 = x1[1] * cs.y - x2[1] * sn.y, a2 = x1[2] * cs.z - x2[2] * sn.z, a3 = x1[3] * cs.w - x2[3] * sn.w;
        float b0 = x1[0] * sn.x + x2[0] * cs.x, b1 = x1[1] * sn.y + x2[1] * cs.y, b2 = x1[2] * sn.z + x2[2] * cs.z, b3 = x1[3] * sn.w + x2[3] * cs.w;
        uint2 ua = make_uint2(pack2(a0, a1), pack2(a2, a3)), ub = make_uint2(pack2(b0, b1), pack2(b2, b3));
#pragma unroll
        for (int hd = 0; hd < 6; ++hd) {
          u16* kp = p.k() + ((size_t)hd * SEQ + row) * 192 + 128 + i0;
          *(uint2*)kp = ua;
          *(uint2*)(kp + 32) = ub;
        }
      }
    }
  } else {
#pragma unroll
    for (int m = 0; m < 4; ++m) {
      const int row = brow + wr * 64 + m * 16 + fr;
#pragma unroll
      for (int n = 0; n < 4; ++n) {
        const int c = col0 - C_SBV + n * 16 + fq * 4;
#pragma unroll
        for (int j = 0; j < 4; ++j) p.vtsb()[(size_t)(c + j) * SEQ + row] = f2bf(acc[m][n][j]);
      }
    }
  }
}

__device__ void memkv_tile(const Params& p, int l, int tm, int tn, char* smem) {
  int tid = threadIdx.x;
  asm volatile("" : "+v"(tid));
  const int wid = __builtin_amdgcn_readfirstlane(tid >> 6), lane = tid & 63;
  const int wr = wid >> 1, wc = wid & 1, fr = lane & 15, fq = lane >> 4;
  f32x4 acc[4][4];
  float ssq[4];
  const int brow = tm * 128, bcol = tn * 128;
  gemm_core<false>(p.memb(), DM, p.wt_memkv() + (size_t)l * 512 * DM, DM, DM, brow, bcol, smem, acc, ssq, wr, wc, fr, fq);
  const int col0 = bcol + wc * 64;
  if (col0 < 256) {
    const int hd = col0 >> 6;
#pragma unroll
    for (int m = 0; m < 4; ++m) {
      const int row = brow + wr * 64 + m * 16 + fr;
#pragma unroll
      for (int n = 0; n < 4; ++n)
        *(uint2*)(p.mk() + ((size_t)(l * 4 + hd) * 256 + row) * 64 + n * 16 + fq * 4) =
            make_uint2(pack2(acc[m][n][0], acc[m][n][1]), pack2(acc[m][n][2], acc[m][n][3]));
    }
  } else {
    const int hd = (col0 - 256) >> 6;
#pragma unroll
    for (int m = 0; m < 4; ++m) {
      const int row = brow + wr * 64 + m * 16 + fr;
#pragma unroll
      for (int n = 0; n < 4; ++n)
#pragma unroll
        for (int j = 0; j < 4; ++j)
          p.mvt()[((size_t)(l * 4 + hd) * 64 + n * 16 + fq * 4 + j) * 256 + row] = f2bf(acc[m][n][j]);
    }
  }
}

__device__ void phaseB_tile(const Params& p, int l, int tm, int tn, char* smem) {
  int tid = threadIdx.x;
  asm volatile("" : "+v"(tid));
  const int wid = __builtin_amdgcn_readfirstlane(tid >> 6), lane = tid & 63;
  const int wr = wid >> 1, wc = wid & 1, fr = lane & 15, fq = lane >> 4;
  f32x4 acc[4][4];
  float ssq[4];
  const int brow = tm * 128;
  if (tn < 9) {
    const int bcol = tn * 128;
    gemm_core<true>(p.h() + C_CQ, DIN, p.wt_uq() + (size_t)l * 1152 * 512, 512, 512, brow, bcol, smem, acc, ssq, wr, wc, fr, fq);
    const int col0 = bcol + wc * 64;
    const int hd = col0 / 192, o = col0 % 192;
    const float qs = 0.07216878364870322f * 1.4426950408889634f;
#pragma unroll
    for (int m = 0; m < 4; ++m) {
      const int row = brow + wr * 64 + m * 16 + fr;
      const float rs = rsqrtf(ssq[m] * (1.f / 512.f) + 1e-6f) * qs;
      u16* qp = p.q() + ((size_t)hd * SEQ + row) * 192;
      if (o < 128) {
#pragma unroll
        for (int n = 0; n < 4; ++n)
          *(uint2*)(qp + o + n * 16 + fq * 4) =
              make_uint2(pack2(acc[m][n][0] * rs, acc[m][n][1] * rs), pack2(acc[m][n][2] * rs, acc[m][n][3] * rs));
      } else {
#pragma unroll
        for (int n = 0; n < 2; ++n) {
          const int i0 = n * 16 + fq * 4;
          float4 cs = *(const float4*)(p.cosT() + (size_t)row * 32 + i0);
          float4 sn = *(const float4*)(p.sinT() + (size_t)row * 32 + i0);
          f32x4 x1 = acc[m][n] * rs, x2 = acc[m][n + 2] * rs;
          float a0 = x1[0] * cs.x - x2[0] * sn.x, a1 = x1[1] * cs.y - x2[1] * sn.y, a2 = x1[2] * cs.z - x2[2] * sn.z, a3 = x1[3] * cs.w - x2[3] * sn.w;
          float b0 = x1[0] * sn.x + x2[0] * cs.x, b1 = x1[1] * sn.y + x2[1] * cs.y, b2 = x1[2] * sn.z + x2[2] * cs.z, b3 = x1[3] * sn.w + x2[3] * cs.w;
          *(uint2*)(qp + 128 + i0) = make_uint2(pack2(a0, a1), pack2(a2, a3));
          *(uint2*)(qp + 160 + i0) = make_uint2(pack2(b0, b1), pack2(b2, b3));
        }
      }
    }
  } else {
    const int bcol = (tn - 9) * 128;
    gemm_core<true>(p.h() + C_CKV, DIN, p.wt_ukv() + (size_t)l * 1536 * 256, 256, 256, brow, bcol, smem, acc, ssq, wr, wc, fr, fq);
    const int col0 = bcol + wc * 64;
    const int hd = col0 >> 8, o = col0 & 255;
#pragma unroll
    for (int m = 0; m < 4; ++m) {
      const int row = brow + wr * 64 + m * 16 + fr;
      const float rs = rsqrtf(ssq[m] * (1.f / 256.f) + 1e-6f);
      if (o < 128) {
        u16* kp = p.k() + ((size_t)hd * SEQ + row) * 192 + o;
#pragma unroll
        for (int n = 0; n < 4; ++n)
          *(uint2*)(kp + n * 16 + fq * 4) =
              make_uint2(pack2(acc[m][n][0] * rs, acc[m][n][1] * rs), pack2(acc[m][n][2] * rs, acc[m][n][3] * rs));
      } else {
#pragma unroll
        for (int n = 0; n < 4; ++n)
#pragma unroll
          for (int j = 0; j < 4; ++j)
            p.vt()[((size_t)hd * 128 + (o - 128) + n * 16 + fq * 4 + j) * SEQ + row] = f2bf(acc[m][n][j] * rs);
      }
    }
  }
}

__device__ void phaseD_tile(const Params& p, int l, int tm, int tn, char* smem) {
  int tid = threadIdx.x;
  asm volatile("" : "+v"(tid));
  const int wid = __builtin_amdgcn_readfirstlane(tid >> 6), lane = tid & 63;
  const int wr = wid >> 1, wc = wid & 1, fr = lane & 15, fq = lane >> 4;
  f32x4 acc[4][4];
  float ssq[4];
  const int brow = tm * 128, bcol = tn * 128;
  gemm_core<false>(p.yin(), DM, p.wt_out() + (size_t)l * DM * DM, DM, DM, brow, bcol, smem, acc, ssq, wr, wc, fr, fq);
  const float alpha = 1.681792830507429f;
  const float* xres = (l == 0) ? p.x : p.out;
#pragma unroll
  for (int m = 0; m < 4; ++m) {
    const int row = brow + wr * 64 + m * 16 + fr;
#pragma unroll
    for (int n = 0; n < 4; ++n) {
      const size_t off = (size_t)row * DM + bcol + wc * 64 + n * 16 + fq * 4;
      float4 xr = *(const float4*)(xres + off);
      float4 z = make_float4(alpha * xr.x + acc[m][n][0], alpha * xr.y + acc[m][n][1], alpha * xr.z + acc[m][n][2], alpha * xr.w + acc[m][n][3]);
      *(float4*)(p.out + off) = z;
    }
  }
}

__device__ void phaseE(const Params& p, int l) {
  int tid = threadIdx.x;
  asm volatile("" : "+v"(tid));
  const int lane = tid & 63;
  const int gw = blockIdx.x * 4 + (tid >> 6), nw = gridDim.x * 4;
  const float* g = p.ln_g + (size_t)l * DM;
  const float* b = p.ln_b + (size_t)l * DM;
  for (int row = gw; row < SEQ; row += nw) {
    float* zr = p.out + (size_t)row * DM;
    float4 v[8];
    float s = 0.f;
#pragma unroll
    for (int i = 0; i < 8; ++i) { v[i] = *(const float4*)(zr + (i * 64 + lane) * 4); s += v[i].x + v[i].y + v[i].z + v[i].w; }
#pragma unroll
    for (int o = 1; o < 64; o <<= 1) s += __shfl_xor(s, o);
    const float mu = s * (1.f / DM);
    float q = 0.f;
#pragma unroll
    for (int i = 0; i < 8; ++i) {
      v[i].x -= mu; v[i].y -= mu; v[i].z -= mu; v[i].w -= mu;
      q += v[i].x * v[i].x + v[i].y * v[i].y + v[i].z * v[i].z + v[i].w * v[i].w;
    }
#pragma unroll
    for (int o = 1; o < 64; o <<= 1) q += __shfl_xor(q, o);
    const float rstd = rsqrtf(q * (1.f / DM) + 1e-5f);
#pragma unroll
    for (int i = 0; i < 8; ++i) {
      const int c = (i * 64 + lane) * 4;
      float4 gg = *(const float4*)(g + c), bb = *(const float4*)(b + c);
      float4 r = make_float4(v[i].x * rstd * gg.x + bb.x, v[i].y * rstd * gg.y + bb.y, v[i].z * rstd * gg.z + bb.z, v[i].w * rstd * gg.w + bb.w);
      *(float4*)(zr + c) = r;
      *(uint2*)(p.xb() + (size_t)row * DM + c) = make_uint2(pack2(r.x, r.y), pack2(r.z, r.w));
    }
  }
}

template <int DK, int DV, int MODE>
__device__ void attn_item(const u16* __restrict__ Qp, int ldq, const u16* __restrict__ Kp, int ldk, const u16* __restrict__ Vt, int ldv,
                          int t_last, float zscale, int q0, const u16* __restrict__ gate, u16* __restrict__ outp, char* smem) {
  constexpr int KST = DK + 8, VST = 72, KCH = DK / 8;
  constexpr int NKR = (64 * KCH) / 256, NVR = (DV * 8) / 256, NST = DK / 32, NDS = DV / 16;
  u16* Ks = (u16*)smem;
  u16* Vs = Ks + 64 * KST;
  int tid = threadIdx.x;
  asm volatile("" : "+v"(tid));
  asm volatile("" : "+s"(t_last));
  const int w = __builtin_amdgcn_readfirstlane(tid >> 6), lane = tid & 63, fr = lane & 15, fq = lane >> 4;

  constexpr int NSR = (MODE == 0) ? 4 : NST;
  bf16x8 qf[2][NSR];
  bf16x8* Qr = (bf16x8*)(Vs + DV * VST) + (w * 4) * 64 + lane;
#pragma unroll
  for (int qs = 0; qs < 2; ++qs)
#pragma unroll
    for (int st = 0; st < NST; ++st) {
      bf16x8 v = *(const bf16x8*)(Qp + (unsigned)((w * 32 + qs * 16 + fr) * ldq + st * 32 + fq * 8));
      if (st < NSR) qf[qs][st < NSR ? st : 0] = v;
      else Qr[(qs * 2 + (st - NSR)) * 64] = v;
    }

  f32x4 o[NDS][2];
#pragma unroll
  for (int ds = 0; ds < NDS; ++ds) { o[ds][0] = f32x4{0.f, 0.f, 0.f, 0.f}; o[ds][1] = f32x4{0.f, 0.f, 0.f, 0.f}; }
  float mrow[2] = {-1e30f, -1e30f};
  float lrow[2] = {0.f, 0.f};

  uint4 kk0, kk1, kk2, kk3, kk4, kk5, vv0, vv1, vv2, vv3;
#define KLOAD(i, T) if constexpr (NKR > i) { const int c_ = tid + 256 * i, row_ = c_ / KCH, cc_ = c_ % KCH; kk##i = *(const uint4*)((Kp + (size_t)(T) * 64 * ldk) + (unsigned)(row_ * ldk + cc_ * 8)); }
#define KSTORE(i) if constexpr (NKR > i) { const int c_ = tid + 256 * i, row_ = c_ / KCH, cc_ = c_ % KCH; *(uint4*)(Ks + row_ * KST + cc_ * 8) = kk##i; }
#define VLOAD(i, T) if constexpr (NVR > i) { const int c_ = tid + 256 * i, dv_ = c_ >> 3, cc_ = c_ & 7; vv##i = *(const uint4*)((Vt + (T) * 64) + (unsigned)(dv_ * ldv + cc_ * 8)); }
#define VSTORE(i) if constexpr (NVR > i) { const int c_ = tid + 256 * i, dv_ = c_ >> 3, cc_ = c_ & 7; *(uint4*)(Vs + dv_ * VST + cc_ * 8) = vv##i; }
#define load_k(T) do { KLOAD(0, T) KLOAD(1, T) KLOAD(2, T) KLOAD(3, T) KLOAD(4, T) KLOAD(5, T) } while (0)
#define load_v(T) do { VLOAD(0, T) VLOAD(1, T) VLOAD(2, T) VLOAD(3, T) } while (0)
#define store_tile() do { KSTORE(0) KSTORE(1) KSTORE(2) KSTORE(3) KSTORE(4) KSTORE(5) VSTORE(0) VSTORE(1) VSTORE(2) VSTORE(3) } while (0)

  int t = (MODE == 2) ? t_last : 0;
  load_k(t);
  load_v(t);
  while (true) {
    store_tile();
    __syncthreads();
    const int tn = (MODE == 2) ? t - 1 : t + 1;
    const bool more = (MODE == 2) ? (t > 0) : (t < t_last);
    if (MODE == 2 && more) load_k(tn);
    bool active = true;
    if (MODE == 0 || MODE == 2) active = !(t == t_last && w < 2);
    if (MODE != 2 && active) {
      f32x4 s[4][2];
#pragma unroll
      for (int ks = 0; ks < 4; ++ks) { s[ks][0] = f32x4{0.f, 0.f, 0.f, 0.f}; s[ks][1] = f32x4{0.f, 0.f, 0.f, 0.f}; }
#pragma unroll
      for (int st = 0; st < NST; ++st) {
#pragma unroll
        for (int ks = 0; ks < 4; ++ks) {
          bf16x8 kf = *(const bf16x8*)(Ks + (ks * 16 + fr) * KST + st * 32 + fq * 8);
          if (st < NSR) {
            s[ks][0] = mfma16(kf, qf[0][st < NSR ? st : 0], s[ks][0]);
            s[ks][1] = mfma16(kf, qf[1][st < NSR ? st : 0], s[ks][1]);
          } else {
            s[ks][0] = mfma16(kf, Qr[(st - NSR) * 64], s[ks][0]);
            s[ks][1] = mfma16(kf, Qr[(2 + st - NSR) * 64], s[ks][1]);
          }
        }
      }
      {
#pragma unroll
        for (int qs = 0; qs < 2; ++qs) {
          float mx = -1e30f;
#pragma unroll
          for (int ks = 0; ks < 4; ++ks)
#pragma unroll
            for (int j = 0; j < 4; ++j) mx = fmaxf(mx, s[ks][qs][j]);
          mx *= zscale;
          mx = fmaxf(mx, __shfl_xor(mx, 16));
          mx = fmaxf(mx, __shfl_xor(mx, 32));
          const float mn = fmaxf(mrow[qs], mx);
          const float alpha = __builtin_amdgcn_exp2f(mrow[qs] - mn);
          mrow[qs] = mn;
          float ls = 0.f;
#pragma unroll
          for (int ks = 0; ks < 4; ++ks)
#pragma unroll
            for (int j = 0; j < 4; ++j) {
              float pv = __builtin_amdgcn_exp2f(s[ks][qs][j] * zscale - mn);
              ls += pv;
              s[ks][qs][j] = pv;
            }
          lrow[qs] = lrow[qs] * alpha + ls;
#pragma unroll
          for (int ds = 0; ds < NDS; ++ds) o[ds][qs] *= alpha;
        }
      }
      __builtin_amdgcn_sched_barrier(0);
      if (more) { load_k(tn); load_v(tn); }
      __builtin_amdgcn_sched_barrier(0);
      bf16x8 pf[2][2];
#pragma unroll
      for (int qs = 0; qs < 2; ++qs)
#pragma unroll
        for (int u = 0; u < 2; ++u) {
          uint4 pk;
          pk.x = pack2(s[2 * u][qs][0], s[2 * u][qs][1]);
          pk.y = pack2(s[2 * u][qs][2], s[2 * u][qs][3]);
          pk.z = pack2(s[2 * u + 1][qs][0], s[2 * u + 1][qs][1]);
          pk.w = pack2(s[2 * u + 1][qs][2], s[2 * u + 1][qs][3]);
          pf[qs][u] = *(bf16x8*)&pk;
        }
#pragma unroll
      for (int u = 0; u < 2; ++u) {
#pragma unroll
        for (int ds = 0; ds < NDS; ++ds) {
          const u16* vp = Vs + (ds * 16 + fr) * VST + u * 32 + fq * 4;
          uint2 lo = *(const uint2*)vp, hi = *(const uint2*)(vp + 16);
          uint4 vv = make_uint4(lo.x, lo.y, hi.x, hi.y);
          bf16x8 vf = *(bf16x8*)&vv;
          o[ds][0] = mfma16(vf, pf[0][u], o[ds][0]);
          o[ds][1] = mfma16(vf, pf[1][u], o[ds][1]);
        }
      }
    }
    if (MODE == 2 && active) {
#pragma unroll
      for (int qs = 0; qs < 2; ++qs) {
        f32x4 s1[4];
#pragma unroll
        for (int ks = 0; ks < 4; ++ks) s1[ks] = f32x4{0.f, 0.f, 0.f, 0.f};
#pragma unroll
        for (int st = 0; st < NST; ++st) {
#pragma unroll
          for (int ks = 0; ks < 4; ++ks) {
            bf16x8 kf = *(const bf16x8*)(Ks + (ks * 16 + fr) * KST + st * 32 + fq * 8);
            s1[ks] = mfma16(kf, qf[qs][st], s1[ks]);
          }
        }
        const int tq = q0 + w * 32 + qs * 16 + fr;
        float running = lrow[qs];
#pragma unroll
        for (int ks = 3; ks >= 0; --ks) {
          float l1[4], lb[4];
#pragma unroll
          for (int j = 0; j < 4; ++j) {
            const float z = s1[ks][j] * zscale;
            const float e = __expf(-fabsf(z));
            const float sp = fmaxf(z, 0.f) + __logf(1.f + e);
            const int key = t * 64 + ks * 16 + fq * 4 + j;
            l1[j] = (key < tq) ? -sp : 0.f;
            lb[j] = z - sp;
          }
          const float p4 = (l1[0] + l1[1]) + (l1[2] + l1[3]);
          const float x16 = __shfl_xor(p4, 16);
          const float a2 = p4 + x16;
          const float x32 = __shfl_xor(a2, 32);
          const float tot = a2 + x32;
          const float gt = ((fq & 1) == 0 ? x16 : 0.f) + ((fq & 2) == 0 ? x32 : 0.f);
          const float s3 = running + gt;
          const float s2 = s3 + l1[3];
          const float s1_ = s2 + l1[2];
          const float s0 = s1_ + l1[1];
          s1[ks][0] = (l1[0] < 0.f) ? __expf(lb[0] + s0) : 0.f;
          s1[ks][1] = (l1[1] < 0.f) ? __expf(lb[1] + s1_) : 0.f;
          s1[ks][2] = (l1[2] < 0.f) ? __expf(lb[2] + s2) : 0.f;
          s1[ks][3] = (l1[3] < 0.f) ? __expf(lb[3] + s3) : 0.f;
          running += tot;
        }
        lrow[qs] = running;
        if (qs == 0) {
          __builtin_amdgcn_sched_barrier(0);
          if (more) load_v(tn);
          __builtin_amdgcn_sched_barrier(0);
        }
#pragma unroll
        for (int u = 0; u < 2; ++u) {
          uint4 pk;
          pk.x = pack2(s1[2 * u][0], s1[2 * u][1]);
          pk.y = pack2(s1[2 * u][2], s1[2 * u][3]);
          pk.z = pack2(s1[2 * u + 1][0], s1[2 * u + 1][1]);
          pk.w = pack2(s1[2 * u + 1][2], s1[2 * u + 1][3]);
          bf16x8 pf1 = *(bf16x8*)&pk;
#pragma unroll
          for (int ds = 0; ds < NDS; ++ds) {
            const u16* vp = Vs + (ds * 16 + fr) * VST + u * 32 + fq * 4;
            uint2 lo = *(const uint2*)vp, hi = *(const uint2*)(vp + 16);
            uint4 vv = make_uint4(lo.x, lo.y, hi.x, hi.y);
            bf16x8 vf = *(bf16x8*)&vv;
            o[ds][qs] = mfma16(vf, pf1, o[ds][qs]);
          }
        }
        __builtin_amdgcn_sched_barrier(0);
      }
    }
    if (!active && more) { if (MODE != 2) load_k(tn); load_v(tn); }
    if (MODE == 2) {
      const int cont = (more && (lrow[0] >= -104.f || lrow[1] >= -104.f)) ? 1 : 0;
      if (!__syncthreads_or(cont)) break;
    } else {
      __syncthreads();
      if (!more) break;
    }
    t = tn;
  }
  int fr_e = fr, fq_e = fq;
  asm volatile("" : "+v"(fr_e), "+v"(fq_e));
#pragma unroll
  for (int qs = 0; qs < 2; ++qs) {
    float inv = 1.f;
    if (MODE != 2) {
      float lsum = lrow[qs];
      lsum += __shfl_xor(lsum, 16);
      lsum += __shfl_xor(lsum, 32);
      inv = 1.f / lsum;
    }
    const int row = w * 32 + qs * 16 + fr_e;
#pragma unroll
    for (int ds = 0; ds < NDS; ++ds) {
      const int dv = ds * 16 + fq_e * 4;
      uint2 g2 = *(const uint2*)(gate + (unsigned)(row * DIN + dv));
      float v0 = o[ds][qs][0] * inv * bflo(g2.x), v1 = o[ds][qs][1] * inv * bfhi(g2.x);
      float v2 = o[ds][qs][2] * inv * bflo(g2.y), v3 = o[ds][qs][3] * inv * bfhi(g2.y);
      *(uint2*)(outp + (unsigned)(row * DM + dv)) = make_uint2(pack2(v0, v1), pack2(v2, v3));
    }
  }
}

#undef KLOAD
#undef KSTORE
#undef VLOAD
#undef VSTORE
#undef load_k
#undef load_v
#undef store_tile

__device__ void gmlp_item(const Params& p, int l, int n, int g, char* smem) {
  constexpr int WST = 136;
  u16* Ws = (u16*)smem;
  u16* Bs = Ws + 128 * WST;
  float* s_mu = (float*)(Bs + 128 * WST);
  float* s_rs = s_mu + 128;
  int tid = threadIdx.x;
  asm volatile("" : "+v"(tid));
  const int w = __builtin_amdgcn_readfirstlane(tid >> 6), lane = tid & 63, fr = lane & 15, fq = lane >> 4;
  const int row0 = n * 128;
  {
    const int r = tid >> 1, half = tid & 1;
    const u16* src = p.h() + (size_t)(row0 + r) * DIN + C_SGV + half * 256;
    float s = 0.f, q = 0.f;
#pragma unroll 4
    for (int i = 0; i < 32; ++i) {
      uint4 v = *(const uint4*)(src + i * 8);
      const unsigned ww[4] = {v.x, v.y, v.z, v.w};
#pragma unroll
      for (int k = 0; k < 4; ++k) { float a = bflo(ww[k]), b = bfhi(ww[k]); s += a + b; q += a * a + b * b; }
    }
    s += __shfl_xor(s, 1);
    q += __shfl_xor(q, 1);
    const float mu = s * (1.f / 512.f);
    const float var = fmaxf(q * (1.f / 512.f) - mu * mu, 0.f);
    if (half == 0) { s_mu[r] = mu; s_rs[r] = rsqrtf(var + 1e-5f); }
  }
  {
    const float* wsrc = p.sg_w + (size_t)(l * 4 + g) * 128 * 128;
#pragma unroll 4
    for (int i = 0; i < 16; ++i) {
      int id = tid + 256 * i, tt = id >> 5, s4 = (id & 31) * 4;
      float4 v = *(const float4*)(wsrc + tt * 128 + s4);
      if (tt < 64 && s4 >= 64) v = make_float4(0.f, 0.f, 0.f, 0.f);
      *(uint2*)(Ws + tt * WST + s4) = make_uint2(pack2(v.x, v.y), pack2(v.z, v.w));
    }
  }
  __syncthreads();
  {
    const int c = tid & 127, sh = tid >> 7;
    const float lg = p.sg_ln_g[(size_t)l * 512 + g * 128 + c], lbv = p.sg_ln_b[(size_t)l * 512 + g * 128 + c];
    const u16* src = p.h() + (size_t)row0 * DIN + C_SGV + g * 128 + c;
#pragma unroll 2
    for (int s8 = 0; s8 < 8; ++s8) {
      const int so = (sh * 8 + s8) * 8;
      float v[8];
#pragma unroll
      for (int jj = 0; jj < 8; ++jj) {
        const int s = so + jj;
        v[jj] = (bf2f(src[(size_t)s * DIN]) - s_mu[s]) * s_rs[s] * lg + lbv;
      }
      *(uint4*)(Bs + c * WST + so) = make_uint4(pack2(v[0], v[1]), pack2(v[2], v[3]), pack2(v[4], v[5]), pack2(v[6], v[7]));
    }
  }
  __syncthreads();
  f32x4 acc[2][8];
#pragma unroll
  for (int mt = 0; mt < 2; ++mt)
#pragma unroll
    for (int ns = 0; ns < 8; ++ns) acc[mt][ns] = f32x4{0.f, 0.f, 0.f, 0.f};
#pragma unroll
  for (int st = 0; st < 4; ++st) {
    bf16x8 wf[2];
#pragma unroll
    for (int mt = 0; mt < 2; ++mt) wf[mt] = *(const bf16x8*)(Ws + (w * 32 + mt * 16 + fr) * WST + st * 32 + fq * 8);
#pragma unroll
    for (int ns = 0; ns < 8; ++ns) {
      bf16x8 bfv = *(const bf16x8*)(Bs + (ns * 16 + fr) * WST + st * 32 + fq * 8);
      acc[0][ns] = mfma16(bfv, wf[0], acc[0][ns]);
      acc[1][ns] = mfma16(bfv, wf[1], acc[1][ns]);
    }
  }
#pragma unroll
  for (int mt = 0; mt < 2; ++mt) {
    const int tt = w * 32 + mt * 16 + fr;
    const float bias = p.sg_b[(size_t)(l * 4 + g) * 128 + tt];
    const u16* hrow = p.h() + (size_t)(row0 + tt) * DIN;
#pragma unroll
    for (int ns = 0; ns < 8; ++ns) {
      const int c = g * 128 + ns * 16 + fq * 4;
      uint2 u2 = *(const uint2*)(hrow + C_SGU + c);
      uint2 g2 = *(const uint2*)(hrow + C_GB + c);
      float v0 = bflo(u2.x) * (acc[mt][ns][0] + bias) * bflo(g2.x);
      float v1 = bfhi(u2.x) * (acc[mt][ns][1] + bias) * bfhi(g2.x);
      float v2 = bflo(u2.y) * (acc[mt][ns][2] + bias) * bflo(g2.y);
      float v3 = bfhi(u2.y) * (acc[mt][ns][3] + bias) * bfhi(g2.y);
      *(uint2*)(p.yin() + (size_t)(row0 + tt) * DM + 768 + c) = make_uint2(pack2(v0, v1), pack2(v2, v3));
    }
  }
  __syncthreads();
}

__device__ void phaseC(const Params& p, int l, char* smem) {
  volatile int* ctl = (volatile int*)(smem + CTL_OFF);
  const int tid = threadIdx.x;
  constexpr int N_MLA = 384, N_SB = 256, N_MEM = 256, N_G = 256;
  constexpr int N_ALL = N_MLA + N_SB + N_MEM + N_G;
  while (true) {
    __syncthreads();
    if (tid == 0) ctl[0] = (int)atomicAdd(&p.ctr()[l], 1u);
    __syncthreads();
    const int item = __builtin_amdgcn_readfirstlane(ctl[0]);
    if (item >= N_ALL) break;
    if (item < N_MLA) {
      const int qb = 63 - item / 6, hd = item % 6, q0 = qb * 128;
      attn_item<192, 128, 0>(p.q() + ((size_t)hd * SEQ + q0) * 192, 192, p.k() + (size_t)hd * SEQ * 192, 192,
                             p.vt() + (size_t)hd * 128 * SEQ, SEQ, 2 * qb + 1, 1.0f, q0,
                             p.h() + (size_t)q0 * DIN + C_GA + hd * 128, p.yin() + (size_t)q0 * DM + hd * 128, smem);
    } else if (item < N_MLA + N_SB) {
      const int it = item - N_MLA, qb = it >> 2, hd = it & 3, q0 = qb * 128;
      attn_item<128, 128, 2>(p.h() + (size_t)q0 * DIN + C_SBQ + hd * 128, DIN, p.h() + C_SBK + hd * 128, DIN,
                             p.vtsb() + (size_t)hd * 128 * SEQ, SEQ, 2 * qb + 1, 0.08838834764831845f, q0,
                             p.h() + (size_t)q0 * DIN + C_GC + hd * 128, p.yin() + (size_t)q0 * DM + 1280 + hd * 128, smem);
    } else if (item < N_MLA + N_SB + N_MEM) {
      const int it = item - N_MLA - N_SB, qb = it >> 2, hd = it & 3, q0 = qb * 128;
      attn_item<64, 64, 1>(p.h() + (size_t)q0 * DIN + C_MQ + hd * 64, DIN, p.mk() + (size_t)(l * 4 + hd) * 256 * 64, 64,
                           p.mvt() + (size_t)(l * 4 + hd) * 64 * 256, 256, 3, 0.125f * 1.4426950408889634f, q0,
                           p.h() + (size_t)q0 * DIN + C_GM + hd * 64, p.yin() + (size_t)q0 * DM + 1792 + hd * 64, smem);
    } else {
      const int it = item - N_MLA - N_SB - N_MEM;
      gmlp_item(p, l, it >> 2, it & 3, smem);
    }
  }
}

__global__ void __launch_bounds__(256, 2) fwd_megakernel(Params p) {
  extern __shared__ __attribute__((aligned(16))) char smem[];
  phase_prep(p, smem);
  grid_barrier();
  for (int l = 0; l < NL; ++l) {
    for (int t = blockIdx.x; t < 6 * 512; t += gridDim.x) {
      int tm, tn;
      if (tile_map(t, 45, tm, tn)) phaseA_tile(p, l, tm, tn, smem);
    }
    if (l == 0) {
      for (int t = blockIdx.x; t < NL * 8; t += gridDim.x) memkv_tile(p, t >> 3, (t >> 2) & 1, t & 3, smem);
    }
    grid_barrier();
    for (int t = blockIdx.x; t < 3 * 512; t += gridDim.x) {
      int tm, tn;
      if (tile_map(t, 21, tm, tn)) phaseB_tile(p, l, tm, tn, smem);
    }
    grid_barrier();
    phaseC(p, l, smem);
    grid_barrier();
    for (int t = blockIdx.x; t < 2 * 512; t += gridDim.x) {
      int tm, tn;
      if (tile_map(t, 16, tm, tn)) phaseD_tile(p, l, tm, tn, smem);
    }
    grid_barrier();
    phaseE(p, l);
    if (l + 1 < NL) grid_barrier();
  }
}

extern "C" void kernel_launch(void* const* d_in, const int* in_sizes, int n_in, void* d_out, int out_size, void* d_ws,
                              size_t ws_size, hipStream_t stream) {
  static int grid_blocks = 0;
  if (!grid_blocks) {
    int dev = 0, cus = 0, per_cu = 0;
    hipGetDevice(&dev);
    hipDeviceGetAttribute(&cus, hipDeviceAttributeMultiprocessorCount, dev);
    hipFuncSetAttribute((const void*)fwd_megakernel, hipFuncAttributeMaxDynamicSharedMemorySize, LDS_BYTES);
    hipOccupancyMaxActiveBlocksPerMultiprocessor(&per_cu, fwd_megakernel, 256, LDS_BYTES);
    if (per_cu > 2) per_cu = 2;
    if (per_cu < 1) per_cu = 1;
    grid_blocks = cus * per_cu;
  }
  Params p{};
  p.x = (const float*)d_in[0]; p.mem = (const float*)d_in[1]; p.pos = (const int*)d_in[2]; p.w_in = (const float*)d_in[3];
  p.q_norm_g = (const float*)d_in[4]; p.w_uq = (const float*)d_in[5]; p.kv_norm_g = (const float*)d_in[6];
  p.w_ukv = (const float*)d_in[7]; p.sg_ln_g = (const float*)d_in[8]; p.sg_ln_b = (const float*)d_in[9];
  p.sg_w = (const float*)d_in[10]; p.sg_b = (const float*)d_in[11]; p.w_mem_k = (const float*)d_in[12];
  p.w_mem_v = (const float*)d_in[13]; p.w_out = (const float*)d_in[14]; p.ln_g = (const float*)d_in[15];
  p.ln_b = (const float*)d_in[16];
  p.out = (float*)d_out;
  p.ws = (char*)d_ws;
  void* args[] = {&p};
  hipError_t e = hipLaunchCooperativeKernel((const void*)fwd_megakernel, dim3(grid_blocks), dim3(256), args, LDS_BYTES, stream);
  if (e != hipSuccess) fprintf(stderr, "cooperative launch failed: %s (grid %d)\n", hipGetErrorString(e), grid_blocks);
}
```

```cpp
#include <hip/hip_runtime.h>
#include <hip/hip_cooperative_groups.h>
#include <cstdio>
namespace cg = cooperative_groups;

typedef unsigned short u16;
using bf16x8 = __attribute__((ext_vector_type(8))) short;
using f32x4 = __attribute__((ext_vector_type(4))) float;
typedef __bf16 bf16x2_t __attribute__((ext_vector_type(2)));
typedef float f32x2_t __attribute__((ext_vector_type(2)));

#define SEQ 8192
#define DM 2048
#define DIN 5696
#define DINP 5760
#define NL 4
#define USE_CG_SYNC 1

constexpr int LDS_BYTES = 73728;
constexpr int CTL_OFF = LDS_BYTES - 64;

constexpr int C_CQ = 0, C_CKV = 512, C_KPE = 768, C_GA = 832, C_SGU = 1600, C_SGV = 2112, C_GB = 2624,
              C_SBQ = 3136, C_SBK = 3648, C_SBV = 4160, C_GC = 4672, C_MQ = 5184, C_GM = 5440;

constexpr size_t al256(size_t x) { return (x + 255) & ~(size_t)255; }
constexpr size_t OFF_BAR = 0;
constexpr size_t OFF_CTR = OFF_BAR + al256(16384);
constexpr size_t OFF_WT_IN = OFF_CTR + al256(256);
constexpr size_t OFF_WT_OUT = OFF_WT_IN + al256((size_t)NL * DINP * DM * 2);
constexpr size_t OFF_WT_UQ = OFF_WT_OUT + al256((size_t)NL * DM * DM * 2);
constexpr size_t OFF_WT_UKV = OFF_WT_UQ + al256((size_t)NL * 1152 * 512 * 2);
constexpr size_t OFF_WT_MEMKV = OFF_WT_UKV + al256((size_t)NL * 1536 * 256 * 2);
constexpr size_t OFF_MEMB = OFF_WT_MEMKV + al256((size_t)NL * 512 * DM * 2);
constexpr size_t OFF_XB = OFF_MEMB + al256((size_t)256 * DM * 2);
constexpr size_t OFF_H = OFF_XB + al256((size_t)SEQ * DM * 2);
constexpr size_t OFF_Q = OFF_H + al256((size_t)SEQ * DIN * 2);
constexpr size_t OFF_K = OFF_Q + al256((size_t)6 * SEQ * 192 * 2);
constexpr size_t OFF_VT = OFF_K + al256((size_t)6 * SEQ * 192 * 2);
constexpr size_t OFF_VTSB = OFF_VT + al256((size_t)6 * 128 * SEQ * 2);
constexpr size_t OFF_YIN = OFF_VTSB + al256((size_t)4 * 128 * SEQ * 2);
constexpr size_t OFF_MK = OFF_YIN + al256((size_t)SEQ * DM * 2);
constexpr size_t OFF_MVT = OFF_MK + al256((size_t)NL * 4 * 256 * 64 * 2);
constexpr size_t OFF_COST = OFF_MVT + al256((size_t)NL * 4 * 64 * 256 * 2);
constexpr size_t OFF_SINT = OFF_COST + al256((size_t)SEQ * 32 * 4);
constexpr size_t WS_TOTAL = OFF_SINT + al256((size_t)SEQ * 32 * 4);
struct Params {
  const float* x; const float* mem; const int* pos; const float* w_in; const float* q_norm_g; const float* w_uq;
  const float* kv_norm_g; const float* w_ukv; const float* sg_ln_g; const float* sg_ln_b; const float* sg_w; const float* sg_b;
  const float* w_mem_k; const float* w_mem_v; const float* w_out; const float* ln_g; const float* ln_b;
  float* out;
  char* ws;
  __device__ __forceinline__ unsigned* bar() const { return (unsigned*)(ws + OFF_BAR); }
  __device__ __forceinline__ unsigned* ctr() const { return (unsigned*)(ws + OFF_CTR); }
  __device__ __forceinline__ u16* wt_in() const { return (u16*)(ws + OFF_WT_IN); }
  __device__ __forceinline__ u16* wt_out() const { return (u16*)(ws + OFF_WT_OUT); }
  __device__ __forceinline__ u16* wt_uq() const { return (u16*)(ws + OFF_WT_UQ); }
  __device__ __forceinline__ u16* wt_ukv() const { return (u16*)(ws + OFF_WT_UKV); }
  __device__ __forceinline__ u16* wt_memkv() const { return (u16*)(ws + OFF_WT_MEMKV); }
  __device__ __forceinline__ u16* memb() const { return (u16*)(ws + OFF_MEMB); }
  __device__ __forceinline__ u16* xb() const { return (u16*)(ws + OFF_XB); }
  __device__ __forceinline__ u16* h() const { return (u16*)(ws + OFF_H); }
  __device__ __forceinline__ u16* q() const { return (u16*)(ws + OFF_Q); }
  __device__ __forceinline__ u16* k() const { return (u16*)(ws + OFF_K); }
  __device__ __forceinline__ u16* vt() const { return (u16*)(ws + OFF_VT); }
  __device__ __forceinline__ u16* vtsb() const { return (u16*)(ws + OFF_VTSB); }
  __device__ __forceinline__ u16* yin() const { return (u16*)(ws + OFF_YIN); }
  __device__ __forceinline__ u16* mk() const { return (u16*)(ws + OFF_MK); }
  __device__ __forceinline__ u16* mvt() const { return (u16*)(ws + OFF_MVT); }
  __device__ __forceinline__ float* cosT() const { return (float*)(ws + OFF_COST); }
  __device__ __forceinline__ float* sinT() const { return (float*)(ws + OFF_SINT); }
};

__device__ __forceinline__ unsigned pack2(float a, float b) {
  f32x2_t v = {a, b};
  bf16x2_t r = __builtin_convertvector(v, bf16x2_t);
  return *(unsigned*)&r;
}
__device__ __forceinline__ u16 f2bf(float a) { return (u16)(pack2(a, 0.f) & 0xffffu); }
__device__ __forceinline__ float bflo(unsigned w) { return __uint_as_float(w << 16); }
__device__ __forceinline__ float bfhi(unsigned w) { return __uint_as_float(w & 0xffff0000u); }
__device__ __forceinline__ float bf2f(u16 h) { return __uint_as_float(((unsigned)h) << 16); }
__device__ __forceinline__ float silu_f(float x) { return x / (1.f + __expf(-x)); }
__device__ __forceinline__ float gelu_f(float x) {
  float u = 0.7978845608028654f * (x + 0.044715f * x * x * x);
  float t = 1.f - 2.f / (__expf(2.f * u) + 1.f);
  return 0.5f * x * (1.f + t);
}
__device__ __forceinline__ f32x4 mfma16(bf16x8 a, bf16x8 b, f32x4 c) {
  return __builtin_amdgcn_mfma_f32_16x16x32_bf16(a, b, c, 0, 0, 0);
}

#define XB_TMO      128
#define XB_XCNT(j)  (256  + 64 * (j))
#define XB_XSUB(j)  (1280 + 64 * (j))
#define XB_XGEN(j)  (2304 + 64 * (j))
#define XB_TOP      3328
#define XB_TOPGEN   3392
#define XCD_BAR_WORDS 3456
#define XB_SPIN_CAP (1u << 22)
#define LAS __attribute__((address_space(3)))
__device__ __forceinline__ unsigned xb_ld(unsigned* p) { return __hip_atomic_load(p, __ATOMIC_RELAXED, __HIP_MEMORY_SCOPE_AGENT); }
__device__ __forceinline__ unsigned xb_add(unsigned* p, unsigned v) { return __hip_atomic_fetch_add(p, v, __ATOMIC_RELAXED, __HIP_MEMORY_SCOPE_AGENT); }
__device__ __forceinline__ unsigned xb_xcc_id() { return (unsigned)__builtin_amdgcn_s_getreg((3 << 11) | 20) & 0xFu; }
#define XB_SPIN(cond, bar) do { unsigned _sp = 0; while (cond) { __builtin_amdgcn_s_sleep(1); \
    if ((++_sp & 255u) == 0u) { if (xb_ld(&(bar)[XB_TMO])) break; if (_sp > XB_SPIN_CAP) { atomicAdd(&(bar)[XB_TMO], 1u); break; } } } } while (0)
struct XcdBarrier { unsigned* bar; unsigned x; volatile LAS unsigned* st; };
__device__ __forceinline__ XcdBarrier xcd_barrier_post(unsigned* bar, volatile LAS unsigned* st) {
  XcdBarrier b; b.bar = bar; b.x = xb_xcc_id(); b.st = st;
  if (threadIdx.x == 0) (void)xb_add(&bar[XB_XCNT(b.x)], 1u);
  return b;
}
__device__ __forceinline__ void xcd_barrier_complete(unsigned* bar, unsigned x, unsigned& nloc, unsigned& nx) {
  const unsigned G = gridDim.x * gridDim.y * gridDim.z;
  unsigned sum, cnt, mine, sp = 0u;
  for (;;) {
    sum = 0u; cnt = 0u; mine = 0u;
#pragma unroll
    for (unsigned j = 0; j < 16; ++j) { const unsigned c = xb_ld(&bar[XB_XCNT(j)]); sum += c; cnt += (c > 0u) ? 1u : 0u; mine = (j == x) ? c : mine; }
    if (sum == G) break;
    __builtin_amdgcn_s_sleep(1);
    if ((++sp & 255u) == 0u) { if (xb_ld(&bar[XB_TMO])) break; if (sp > XB_SPIN_CAP) { atomicAdd(&bar[XB_TMO], 1u); break; } }
  }
  nloc = mine > 0u ? mine : 1u; nx = cnt > 0u ? cnt : 1u;
}
__device__ __forceinline__ void xcd_barrier(const XcdBarrier& b) {
  asm volatile("s_waitcnt vmcnt(0)" ::: "memory");
  __syncthreads();
  if (threadIdx.x == 0) {
    unsigned* bar = b.bar;
    __builtin_amdgcn_s_waitcnt(0);
    unsigned nloc = b.st[0], nx = b.st[1];
    if (nloc == 0u) { xcd_barrier_complete(bar, b.x, nloc, nx); b.st[0] = nloc; b.st[1] = nx; }
    const unsigned old = xb_add(&bar[XB_XSUB(b.x)], 1u);
    const unsigned gen = old / nloc;
    if (old + 1u == (gen + 1u) * nloc) {
      __builtin_amdgcn_fence(__ATOMIC_RELEASE, "agent");
      asm volatile("s_waitcnt vmcnt(0)" ::: "memory");
      const unsigned og = xb_add(&bar[XB_TOP], 1u);
      const unsigned tg = og / nx;
      if (og + 1u == (tg + 1u) * nx) xb_add(&bar[XB_TOPGEN], 1u);
      else XB_SPIN(xb_ld(&bar[XB_TOPGEN]) == tg, bar);
      __builtin_amdgcn_fence(__ATOMIC_ACQUIRE, "agent");
      xb_add(&bar[XB_XGEN(b.x)], 1u);
      asm volatile("s_waitcnt vmcnt(0)" ::: "memory");
    } else {
      XB_SPIN(xb_ld(&bar[XB_XGEN(b.x)]) == gen, bar);
      __builtin_amdgcn_fence(__ATOMIC_ACQUIRE, "agent");
      asm volatile("s_waitcnt vmcnt(0)" ::: "memory");
    }
  }
  __syncthreads();
}

__device__ void tconv_tile(const float* __restrict__ src, u16* __restrict__ dst, int K, int N, int k0, int n0,
                           const float* __restrict__ g, float* lds) {
  int tid = threadIdx.x;
  asm volatile("" : "+v"(tid));
#pragma unroll
  for (int i = 0; i < 4; ++i) {
    int r = (tid >> 4) + 16 * i, c = (tid & 15) * 4;
    float4 v = make_float4(0.f, 0.f, 0.f, 0.f);
    if (n0 + c < N) v = *(const float4*)(src + (size_t)(k0 + r) * N + n0 + c);
    if (g) { float s = g[k0 + r]; v.x *= s; v.y *= s; v.z *= s; v.w *= s; }
    float* p = lds + r * 65 + c;
    p[0] = v.x; p[1] = v.y; p[2] = v.z; p[3] = v.w;
  }
  __syncthreads();
#pragma unroll
  for (int i = 0; i < 2; ++i) {
    int id = tid + 256 * i, n = id >> 3, kc = (id & 7) * 8;
    unsigned w0 = pack2(lds[(kc + 0) * 65 + n], lds[(kc + 1) * 65 + n]);
    unsigned w1 = pack2(lds[(kc + 2) * 65 + n], lds[(kc + 3) * 65 + n]);
    unsigned w2 = pack2(lds[(kc + 4) * 65 + n], lds[(kc + 5) * 65 + n]);
    unsigned w3 = pack2(lds[(kc + 6) * 65 + n], lds[(kc + 7) * 65 + n]);
    *(uint4*)(dst + (size_t)(n0 + n) * K + k0 + kc) = make_uint4(w0, w1, w2, w3);
  }
  __syncthreads();
}

__device__ void tconv_all(const float* src, u16* dst, int K, int N, int Npad, size_t srcLS, size_t dstLS, int dstRowOff,
                          const float* g, int gS, float* lds) {
  const int nkt = K / 64, nnt = Npad / 64, per = nkt * nnt;
  for (int t = blockIdx.x; t < NL * per; t += gridDim.x) {
    int l = t / per, r = t % per, kt = r / nnt, nt = r % nnt;
    tconv_tile(src + (size_t)l * srcLS, dst + (size_t)l * dstLS + (size_t)dstRowOff * K, K, N, kt * 64, nt * 64,
               g ? g + (size_t)l * gS : nullptr, lds);
  }
}

__device__ void phase_prep(const Params& p, char* smem) {
  float* lds = (float*)smem;
  const int tid = threadIdx.x;
  const size_t gtid = (size_t)blockIdx.x * 256 + tid, gsz = (size_t)gridDim.x * 256;
  if (blockIdx.x == 0 && tid < 16) p.ctr()[tid] = 0u;
  for (size_t c = gtid; c < (size_t)SEQ * DM / 8; c += gsz) {
    float4 a = *(const float4*)(p.x + c * 8), b = *(const float4*)(p.x + c * 8 + 4);
    *(uint4*)(p.xb() + c * 8) = make_uint4(pack2(a.x, a.y), pack2(a.z, a.w), pack2(b.x, b.y), pack2(b.z, b.w));
  }
  for (size_t c = gtid; c < (size_t)256 * DM / 8; c += gsz) {
    float4 a = *(const float4*)(p.mem + c * 8), b = *(const float4*)(p.mem + c * 8 + 4);
    *(uint4*)(p.memb() + c * 8) = make_uint4(pack2(a.x, a.y), pack2(a.z, a.w), pack2(b.x, b.y), pack2(b.z, b.w));
  }
  for (size_t e = gtid; e < (size_t)SEQ * 32; e += gsz) {
    int s = (int)(e >> 5), i = (int)(e & 31);
    float invf = __builtin_amdgcn_exp2f(-(float)i * (13.287712379549449f / 32.0f));
    float ang = (float)p.pos[s] * invf;
    double rev = (double)ang * 0.15915494309189535;
    float fr = (float)(rev - floor(rev));
    p.cosT()[e] = __builtin_amdgcn_cosf(fr);
    p.sinT()[e] = __builtin_amdgcn_sinf(fr);
  }
  tconv_all(p.w_in, p.wt_in(), DM, DIN, DINP, (size_t)DM * DIN, (size_t)DINP * DM, 0, nullptr, 0, lds);
  tconv_all(p.w_out, p.wt_out(), DM, DM, DM, (size_t)DM * DM, (size_t)DM * DM, 0, nullptr, 0, lds);
  tconv_all(p.w_uq, p.wt_uq(), 512, 1152, 1152, (size_t)512 * 1152, (size_t)1152 * 512, 0, p.q_norm_g, 512, lds);
  tconv_all(p.w_ukv, p.wt_ukv(), 256, 1536, 1536, (size_t)256 * 1536, (size_t)1536 * 256, 0, p.kv_norm_g, 256, lds);
  tconv_all(p.w_mem_k, p.wt_memkv(), DM, 256, 256, (size_t)DM * 256, (size_t)512 * DM, 0, nullptr, 0, lds);
  tconv_all(p.w_mem_v, p.wt_memkv(), DM, 256, 256, (size_t)DM * 256, (size_t)512 * DM, 256, nullptr, 0, lds);
}

template <bool SSQ>
__device__ __forceinline__ void gemm_core(const u16* __restrict__ A, int lda, const u16* __restrict__ B, int ldb, int K,
                                          int brow, int bcol, char* smem, f32x4 (&acc)[4][4], float (&ssq)[4],
                                          int wr, int wc, int fr, int fq) {
  int tid = threadIdx.x;
  asm volatile("" : "+v"(tid));
#pragma unroll
  for (int m = 0; m < 4; ++m) {
    ssq[m] = 0.f;
#pragma unroll
    for (int n = 0; n < 4; ++n) acc[m][n] = f32x4{0.f, 0.f, 0.f, 0.f};
  }
  const u16* pa = A + (size_t)(brow + (tid >> 2)) * lda + (tid & 3) * 8;
  const u16* pb = B + (size_t)(bcol + (tid >> 2)) * ldb + (tid & 3) * 8;
  const int nk = K >> 6;
  __syncthreads();
  auto stage = [&](int kt, int buf) __attribute__((always_inline)) {
    char* la = smem + buf * 32768 + tid * 16;
    char* lb = la + 16384;
#pragma unroll
    for (int i = 0; i < 4; ++i) {
      const u16* ga = pa + (size_t)((i & 1) * 64) * lda + (i >> 1) * 32 + kt * 64;
      const u16* gb = pb + (size_t)((i & 1) * 64) * ldb + (i >> 1) * 32 + kt * 64;
      __builtin_amdgcn_global_load_lds((const unsigned*)ga, (unsigned*)(la + i * 4096), 16, 0, 0);
      __builtin_amdgcn_global_load_lds((const unsigned*)gb, (unsigned*)(lb + i * 4096), 16, 0, 0);
    }
  };
  stage(0, 0);
  for (int kt = 0; kt < nk; ++kt) {
    asm volatile("s_waitcnt vmcnt(0)" ::: "memory");
    __syncthreads();
    if (kt + 1 < nk) stage(kt + 1, (kt + 1) & 1);
    const char* sa = smem + (kt & 1) * 32768;
    const char* sb = sa + 16384;
#pragma unroll
    for (int ks = 0; ks < 2; ++ks) {
      bf16x8 af[4], bfr[4];
#pragma unroll
      for (int m = 0; m < 4; ++m) af[m] = *(const bf16x8*)(sa + ks * 8192 + (wr * 64 + m * 16 + fr) * 64 + fq * 16);
#pragma unroll
      for (int n = 0; n < 4; ++n) bfr[n] = *(const bf16x8*)(sb + ks * 8192 + (wc * 64 + n * 16 + fr) * 64 + fq * 16);
      if (SSQ) {
#pragma unroll
        for (int m = 0; m < 4; ++m) {
          const unsigned* w = (const unsigned*)&af[m];
#pragma unroll
          for (int i = 0; i < 4; ++i) { float lo = bflo(w[i]), hi = bfhi(w[i]); ssq[m] += lo * lo + hi * hi; }
        }
      }
#pragma unroll
      for (int m = 0; m < 4; ++m)
#pragma unroll
        for (int n = 0; n < 4; ++n) acc[m][n] = mfma16(bfr[n], af[m], acc[m][n]);
    }
  }
  if (SSQ) {
#pragma unroll
    for (int m = 0; m < 4; ++m) {
      ssq[m] += __shfl_xor(ssq[m], 16);
      ssq[m] += __shfl_xor(ssq[m], 32);
    }
  }
}

__device__ __forceinline__ bool tile_map(int t, int ntn, int& m, int& n) {
  int r = t >> 9, b = t & 511;
  int xcd = b & 7, idx = b >> 3;
  m = xcd * 8 + (idx & 7);
  n = r * 8 + (idx >> 3);
  return n < ntn;
}

__device__ void phaseA_tile(const Params& p, int l, int tm, int tn, char* smem) {
  int tid = threadIdx.x;
  asm volatile("" : "+v"(tid));
  const int wid = __builtin_amdgcn_readfirstlane(tid >> 6), lane = tid & 63;
  const int wr = wid >> 1, wc = wid & 1, fr = lane & 15, fq = lane >> 4;
  f32x4 acc[4][4];
  float ssq[4];
  const int brow = tm * 128, bcol = tn * 128;
  gemm_core<false>(p.xb(), DM, p.wt_in() + (size_t)l * DINP * DM, DM, DM, brow, bcol, smem, acc, ssq, wr, wc, fr, fq);
  const int col0 = bcol + wc * 64;
  int kind;
  if (col0 < C_KPE) kind = 0; else if (col0 < C_GA) kind = 3; else if (col0 < C_SGU) kind = 1;
  else if (col0 < C_GB) kind = 2; else if (col0 < C_SBQ) kind = 1; else if (col0 < C_SBV) kind = 0;
  else if (col0 < C_GC) kind = 4; else if (col0 < C_MQ) kind = 1; else if (col0 < C_GM) kind = 0;
  else if (col0 < DIN) kind = 1; else kind = 5;
  if (kind == 5) return;
  if (kind <= 2) {
#pragma unroll
    for (int m = 0; m < 4; ++m) {
      const int row = brow + wr * 64 + m * 16 + fr;
#pragma unroll
      for (int n = 0; n < 4; ++n) {
        float v0 = acc[m][n][0], v1 = acc[m][n][1], v2 = acc[m][n][2], v3 = acc[m][n][3];
        if (kind == 1) { v0 = silu_f(v0); v1 = silu_f(v1); v2 = silu_f(v2); v3 = silu_f(v3); }
        else if (kind == 2) { v0 = gelu_f(v0); v1 = gelu_f(v1); v2 = gelu_f(v2); v3 = gelu_f(v3); }
        *(uint2*)(p.h() + (size_t)row * DIN + col0 + n * 16 + fq * 4) = make_uint2(pack2(v0, v1), pack2(v2, v3));
      }
    }
  } else if (kind == 3) {
#pragma unroll
    for (int m = 0; m < 4; ++m) {
      const int row = brow + wr * 64 + m * 16 + fr;
#pragma unroll
      for (int n = 0; n < 2; ++n) {
        const int i0 = n * 16 + fq * 4;
        float4 cs = *(const float4*)(p.cosT() + (size_t)row * 32 + i0);
        float4 sn = *(const float4*)(p.sinT() + (size_t)row * 32 + i0);
        f32x4 x1 = acc[m][n], x2 = acc[m][n + 2];
        float a0 = x1[0] * cs.x - x2[0] * sn.x, a1 = x1[1] * cs.y - x2[1] * sn.y, a2 = x1[2] * cs.z - x2[2] * sn.z, a3 = x1[3] * cs.w - x2[3] * sn.w;
        float b0 = x1[0] * sn.x + x2[0] * cs.x, b1 = x1[1] * sn.y + x2[1] * cs.y, b2 = x1[2] * sn.z + x2[2] * cs.z, b3 = x1[3] * sn.w + x2[3] * cs.w;
        uint2 ua = make_uint2(pack2(a0, a1), pack2(a2, a3)), ub = make_uint2(pack2(b0, b1), pack2(b2, b3));
#pragma unroll
        for (int hd = 0; hd < 6; ++hd) {
          u16* kp = p.k() + ((size_t)hd * SEQ + row) * 192 + 128 + i0;
          *(uint2*)kp = ua;
          *(uint2*)(kp + 32) = ub;
        }
      }
    }
  } else {
#pragma unroll
    for (int m = 0; m < 4; ++m) {
      const int row = brow + wr * 64 + m * 16 + fr;
#pragma unroll
      for (int n = 0; n < 4; ++n) {
        const int c = col0 - C_SBV + n * 16 + fq * 4;
#pragma unroll
        for (int j = 0; j < 4; ++j) p.vtsb()[(size_t)(c + j) * SEQ + row] = f2bf(acc[m][n][j]);
      }
    }
  }
}

__device__ void memkv_tile(const Params& p, int l, int tm, int tn, char* smem) {
  int tid = threadIdx.x;
  asm volatile("" : "+v"(tid));
  const int wid = __builtin_amdgcn_readfirstlane(tid >> 6), lane = tid & 63;
  const int wr = wid >> 1, wc = wid & 1, fr = lane & 15, fq = lane >> 4;
  f32x4 acc[4][4];
  float ssq[4];
  const int brow = tm * 128, bcol = tn * 128;
  gemm_core<false>(p.memb(), DM, p.wt_memkv() + (size_t)l * 512 * DM, DM, DM, brow, bcol, smem, acc, ssq, wr, wc, fr, fq);
  const int col0 = bcol + wc * 64;
  if (col0 < 256) {
    const int hd = col0 >> 6;
#pragma unroll
    for (int m = 0; m < 4; ++m) {
      const int row = brow + wr * 64 + m * 16 + fr;
#pragma unroll
      for (int n = 0; n < 4; ++n)
        *(uint2*)(p.mk() + ((size_t)(l * 4 + hd) * 256 + row) * 64 + n * 16 + fq * 4) =
            make_uint2(pack2(acc[m][n][0], acc[m][n][1]), pack2(acc[m][n][2], acc[m][n][3]));
    }
  } else {
    const int hd = (col0 - 256) >> 6;
#pragma unroll
    for (int m = 0; m < 4; ++m) {
      const int row = brow + wr * 64 + m * 16 + fr;
#pragma unroll
      for (int n = 0; n < 4; ++n)
#pragma unroll
        for (int j = 0; j < 4; ++j)
          p.mvt()[((size_t)(l * 4 + hd) * 64 + n * 16 + fq * 4 + j) * 256 + row] = f2bf(acc[m][n][j]);
    }
  }
}

__device__ void phaseB_tile(const Params& p, int l, int tm, int tn, char* smem) {
  int tid = threadIdx.x;
  asm volatile("" : "+v"(tid));
  const int wid = __builtin_amdgcn_readfirstlane(tid >> 6), lane = tid & 63;
  const int wr = wid >> 1, wc = wid & 1, fr = lane & 15, fq = lane >> 4;
  f32x4 acc[4][4];
  float ssq[4];
  const int brow = tm * 128;
  if (tn < 9) {
    const int bcol = tn * 128;
    gemm_core<true>(p.h() + C_CQ, DIN, p.wt_uq() + (size_t)l * 1152 * 512, 512, 512, brow, bcol, smem, acc, ssq, wr, wc, fr, fq);
    const int col0 = bcol + wc * 64;
    const int hd = col0 / 192, o = col0 % 192;
    const float qs = 0.07216878364870322f * 1.4426950408889634f;
#pragma unroll
    for (int m = 0; m < 4; ++m) {
      const int row = brow + wr * 64 + m * 16 + fr;
      const float rs = rsqrtf(ssq[m] * (1.f / 512.f) + 1e-6f) * qs;
      u16* qp = p.q() + ((size_t)hd * SEQ + row) * 192;
      if (o < 128) {
#pragma unroll
        for (int n = 0; n < 4; ++n)
          *(uint2*)(qp + o + n * 16 + fq * 4) =
              make_uint2(pack2(acc[m][n][0] * rs, acc[m][n][1] * rs), pack2(acc[m][n][2] * rs, acc[m][n][3] * rs));
      } else {
#pragma unroll
        for (int n = 0; n < 2; ++n) {
          const int i0 = n * 16 + fq * 4;
          float4 cs = *(const float4*)(p.cosT() + (size_t)row * 32 + i0);
          float4 sn = *(const float4*)(p.sinT() + (size_t)row * 32 + i0);
          f32x4 x1 = acc[m][n] * rs, x2 = acc[m][n + 2] * rs;
          float a0 = x1[0] * cs.x - x2[0] * sn.x, a1 = x1[1] * cs.y - x2[1] * sn.y, a2 = x1[2] * cs.z - x2[2] * sn.z, a3 = x1[3] * cs.w - x2[3] * sn.w;
          float b0 = x1[0] * sn.x + x2[0] * cs.x, b1 = x1[1] * sn.y + x2[1] * cs.y, b2 = x1[2] * sn.z + x2[2] * cs.z, b3 = x1[3] * sn.w + x2[3] * cs.w;
          *(uint2*)(qp + 128 + i0) = make_uint2(pack2(a0, a1), pack2(a2, a3));
          *(uint2*)(qp + 160 + i0) = make_uint2(pack2(b0, b1), pack2(b2, b3));
        }
      }
    }
  } else {
    const int bcol = (tn - 9) * 128;
    gemm_core<true>(p.h() + C_CKV, DIN, p.wt_ukv() + (size_t)l * 1536 * 256, 256, 256, brow, bcol, smem, acc, ssq, wr, wc, fr, fq);
    const int col0 = bcol + wc * 64;
    const int hd = col0 >> 8, o = col0 & 255;
#pragma unroll
    for (int m = 0; m < 4; ++m) {
      const int row = brow + wr * 64 + m * 16 + fr;
      const float rs = rsqrtf(ssq[m] * (1.f / 256.f) + 1e-6f);
      if (o < 128) {
        u16* kp = p.k() + ((size_t)hd * SEQ + row) * 192 + o;
#pragma unroll
        for (int n = 0; n < 4; ++n)
          *(uint2*)(kp + n * 16 + fq * 4) =
              make_uint2(pack2(acc[m][n][0] * rs, acc[m][n][1] * rs), pack2(acc[m][n][2] * rs, acc[m][n][3] * rs));
      } else {
#pragma unroll
        for (int n = 0; n < 4; ++n)
#pragma unroll
          for (int j = 0; j < 4; ++j)
            p.vt()[((size_t)hd * 128 + (o - 128) + n * 16 + fq * 4 + j) * SEQ + row] = f2bf(acc[m][n][j] * rs);
      }
    }
  }
}

__device__ void phaseD_tile(const Params& p, int l, int tm, int tn, char* smem) {
  int tid = threadIdx.x;
  asm volatile("" : "+v"(tid));
  const int wid = __builtin_amdgcn_readfirstlane(tid >> 6), lane = tid & 63;
  const int wr = wid >> 1, wc = wid & 1, fr = lane & 15, fq = lane >> 4;
  f32x4 acc[4][4];
  float ssq[4];
  const int brow = tm * 128, bcol = tn * 128;
  gemm_core<false>(p.yin(), DM, p.wt_out() + (size_t)l * DM * DM, DM, DM, brow, bcol, smem, acc, ssq, wr, wc, fr, fq);
  const float alpha = 1.681792830507429f;
  const float* xres = (l == 0) ? p.x : p.out;
#pragma unroll
  for (int m = 0; m < 4; ++m) {
    const int row = brow + wr * 64 + m * 16 + fr;
#pragma unroll
    for (int n = 0; n < 4; ++n) {
      const size_t off = (size_t)row * DM + bcol + wc * 64 + n * 16 + fq * 4;
      float4 xr = *(const float4*)(xres + off);
      float4 z = make_float4(alpha * xr.x + acc[m][n][0], alpha * xr.y + acc[m][n][1], alpha * xr.z + acc[m][n][2], alpha * xr.w + acc[m][n][3]);
      *(float4*)(p.out + off) = z;
    }
  }
}

__device__ void phaseE(const Params& p, int l) {
  int tid = threadIdx.x;
  asm volatile("" : "+v"(tid));
  const int lane = tid & 63;
  const int gw = blockIdx.x * 4 + (tid >> 6), nw = gridDim.x * 4;
  const float* g = p.ln_g + (size_t)l * DM;
  const float* b = p.ln_b + (size_t)l * DM;
  for (int row = gw; row < SEQ; row += nw) {
    float* zr = p.out + (size_t)row * DM;
    float4 v[8];
    float s = 0.f;
#pragma unroll
    for (int i = 0; i < 8; ++i) { v[i] = *(const float4*)(zr + (i * 64 + lane) * 4); s += v[i].x + v[i].y + v[i].z + v[i].w; }
#pragma unroll
    for (int o = 1; o < 64; o <<= 1) s += __shfl_xor(s, o);
    const float mu = s * (1.f / DM);
    float q = 0.f;
#pragma unroll
    for (int i = 0; i < 8; ++i) {
      v[i].x -= mu; v[i].y -= mu; v[i].z -= mu; v[i].w -= mu;
      q += v[i].x * v[i].x + v[i].y * v[i].y + v[i].z * v[i].z + v[i].w * v[i].w;
    }
#pragma unroll
    for (int o = 1; o < 64; o <<= 1) q += __shfl_xor(q, o);
    const float rstd = rsqrtf(q * (1.f / DM) + 1e-5f);
#pragma unroll
    for (int i = 0; i < 8; ++i) {
      const int c = (i * 64 + lane) * 4;
      float4 gg = *(const float4*)(g + c), bb = *(const float4*)(b + c);
      float4 r = make_float4(v[i].x * rstd * gg.x + bb.x, v[i].y * rstd * gg.y + bb.y, v[i].z * rstd * gg.z + bb.z, v[i].w * rstd * gg.w + bb.w);
      *(float4*)(zr + c) = r;
      *(uint2*)(p.xb() + (size_t)row * DM + c) = make_uint2(pack2(r.x, r.y), pack2(r.z, r.w));
    }
  }
}

template <int DK, int DV, int MODE>
__device__ void attn_item(const u16* __restrict__ Qp, int ldq, const u16* __restrict__ Kp, int ldk, const u16* __restrict__ Vt, int ldv,
                          int t_last, float zscale, int q0, const u16* __restrict__ gate, u16* __restrict__ outp, char* smem) {
  constexpr int KST = DK + 8, VST = 72, KCH = DK / 8;
  constexpr int NKR = (64 * KCH) / 256, NVR = (DV * 8) / 256, NST = DK / 32, NDS = DV / 16;
  u16* Ks = (u16*)smem;
  u16* Vs = Ks + 64 * KST;
  int tid = threadIdx.x;
  asm volatile("" : "+v"(tid));
  asm volatile("" : "+s"(t_last));
  const int w = __builtin_amdgcn_readfirstlane(tid >> 6), lane = tid & 63, fr = lane & 15, fq = lane >> 4;

  constexpr int NSR = (MODE == 0) ? 4 : NST;
  bf16x8 qf[2][NSR];
  bf16x8* Qr = (bf16x8*)(Vs + DV * VST) + (w * 4) * 64 + lane;
#pragma unroll
  for (int qs = 0; qs < 2; ++qs)
#pragma unroll
    for (int st = 0; st < NST; ++st) {
      bf16x8 v = *(const bf16x8*)(Qp + (unsigned)((w * 32 + qs * 16 + fr) * ldq + st * 32 + fq * 8));
      if (st < NSR) qf[qs][st < NSR ? st : 0] = v;
      else Qr[(qs * 2 + (st - NSR)) * 64] = v;
    }

  f32x4 o[NDS][2];
#pragma unroll
  for (int ds = 0; ds < NDS; ++ds) { o[ds][0] = f32x4{0.f, 0.f, 0.f, 0.f}; o[ds][1] = f32x4{0.f, 0.f, 0.f, 0.f}; }
  float mrow[2] = {-1e30f, -1e30f};
  float lrow[2] = {0.f, 0.f};

  uint4 kk0, kk1, kk2, kk3, kk4, kk5, vv0, vv1, vv2, vv3;
#define KLOAD(i, T) if constexpr (NKR > i) { const int c_ = tid + 256 * i, row_ = c_ / KCH, cc_ = c_ % KCH; kk##i = *(const uint4*)((Kp + (size_t)(T) * 64 * ldk) + (unsigned)(row_ * ldk + cc_ * 8)); }
#define KSTORE(i) if constexpr (NKR > i) { const int c_ = tid + 256 * i, row_ = c_ / KCH, cc_ = c_ % KCH; *(uint4*)(Ks + row_ * KST + cc_ * 8) = kk##i; }
#define VLOAD(i, T) if constexpr (NVR > i) { const int c_ = tid + 256 * i, dv_ = c_ >> 3, cc_ = c_ & 7; vv##i = *(const uint4*)((Vt + (T) * 64) + (unsigned)(dv_ * ldv + cc_ * 8)); }
#define VSTORE(i) if constexpr (NVR > i) { const int c_ = tid + 256 * i, dv_ = c_ >> 3, cc_ = c_ & 7; *(uint4*)(Vs + dv_ * VST + cc_ * 8) = vv##i; }
#define load_k(T) do { KLOAD(0, T) KLOAD(1, T) KLOAD(2, T) KLOAD(3, T) KLOAD(4, T) KLOAD(5, T) } while (0)
#define load_v(T) do { VLOAD(0, T) VLOAD(1, T) VLOAD(2, T) VLOAD(3, T) } while (0)
#define store_tile() do { KSTORE(0) KSTORE(1) KSTORE(2) KSTORE(3) KSTORE(4) KSTORE(5) VSTORE(0) VSTORE(1) VSTORE(2) VSTORE(3) } while (0)

  int t = (MODE == 2) ? t_last : 0;
  load_k(t);
  load_v(t);
  while (true) {
    store_tile();
    __syncthreads();
    const int tn = (MODE == 2) ? t - 1 : t + 1;
    const bool more = (MODE == 2) ? (t > 0) : (t < t_last);
    if (MODE == 2 && more) load_k(tn);
    bool active = true;
    if (MODE == 0 || MODE == 2) active = !(t == t_last && w < 2);
    if (MODE != 2 && active) {
      f32x4 s[4][2];
#pragma unroll
      for (int ks = 0; ks < 4; ++ks) { s[ks][0] = f32x4{0.f, 0.f, 0.f, 0.f}; s[ks][1] = f32x4{0.f, 0.f, 0.f, 0.f}; }
#pragma unroll
      for (int st = 0; st < NST; ++st) {
#pragma unroll
        for (int ks = 0; ks < 4; ++ks) {
          bf16x8 kf = *(const bf16x8*)(Ks + (ks * 16 + fr) * KST + st * 32 + fq * 8);
          if (st < NSR) {
            s[ks][0] = mfma16(kf, qf[0][st < NSR ? st : 0], s[ks][0]);
            s[ks][1] = mfma16(kf, qf[1][st < NSR ? st : 0], s[ks][1]);
          } else {
            s[ks][0] = mfma16(kf, Qr[(st - NSR) * 64], s[ks][0]);
            s[ks][1] = mfma16(kf, Qr[(2 + st - NSR) * 64], s[ks][1]);
          }
        }
      }
      {
#pragma unroll
        for (int qs = 0; qs < 2; ++qs) {
          float mx = -1e30f;
#pragma unroll
          for (int ks = 0; ks < 4; ++ks)
#pragma unroll
            for (int j = 0; j < 4; ++j) mx = fmaxf(mx, s[ks][qs][j]);
          mx *= zscale;
          mx = fmaxf(mx, __shfl_xor(mx, 16));
          mx = fmaxf(mx, __shfl_xor(mx, 32));
          const float mn = fmaxf(mrow[qs], mx);
          const float alpha = __builtin_amdgcn_exp2f(mrow[qs] - mn);
          mrow[qs] = mn;
          float ls = 0.f;
#pragma unroll
          for (int ks = 0; ks < 4; ++ks)
#pragma unroll
            for (int j = 0; j < 4; ++j) {
              float pv = __builtin_amdgcn_exp2f(s[ks][qs][j] * zscale - mn);
              ls += pv;
              s[ks][qs][j] = pv;
            }
          lrow[qs] = lrow[qs] * alpha + ls;
#pragma unroll
          for (int ds = 0; ds < NDS; ++ds) o[ds][qs] *= alpha;
        }
      }
      __builtin_amdgcn_sched_barrier(0);
      if (more) { load_k(tn); load_v(tn); }
      __builtin_amdgcn_sched_barrier(0);
      bf16x8 pf[2][2];
#pragma unroll
      for (int qs = 0; qs < 2; ++qs)
#pragma unroll
        for (int u = 0; u < 2; ++u) {
          uint4 pk;
          pk.x = pack2(s[2 * u][qs][0], s[2 * u][qs][1]);
          pk.y = pack2(s[2 * u][qs][2], s[2 * u][qs][3]);
          pk.z = pack2(s[2 * u + 1][qs][0], s[2 * u + 1][qs][1]);
          pk.w = pack2(s[2 * u + 1][qs][2], s[2 * u + 1][qs][3]);
          pf[qs][u] = *(bf16x8*)&pk;
        }
#pragma unroll
      for (int u = 0; u < 2; ++u) {
#pragma unroll
        for (int ds = 0; ds < NDS; ++ds) {
          const u16* vp = Vs + (ds * 16 + fr) * VST + u * 32 + fq * 4;
          uint2 lo = *(const uint2*)vp, hi = *(const uint2*)(vp + 16);
          uint4 vv = make_uint4(lo.x, lo.y, hi.x, hi.y);
          bf16x8 vf = *(bf16x8*)&vv;
          o[ds][0] = mfma16(vf, pf[0][u], o[ds][0]);
          o[ds][1] = mfma16(vf, pf[1][u], o[ds][1]);
        }
      }
    }
    if (MODE == 2 && active) {
#pragma unroll
      for (int qs = 0; qs < 2; ++qs) {
        f32x4 s1[4];
#pragma unroll
        for (int ks = 0; ks < 4; ++ks) s1[ks] = f32x4{0.f, 0.f, 0.f, 0.f};
#pragma unroll
        for (int st = 0; st < NST; ++st) {
#pragma unroll
          for (int ks = 0; ks < 4; ++ks) {
            bf16x8 kf = *(const bf16x8*)(Ks + (ks * 16 + fr) * KST + st * 32 + fq * 8);
            s1[ks] = mfma16(kf, qf[qs][st], s1[ks]);
          }
        }
        const int tq = q0 + w * 32 + qs * 16 + fr;
        float running = lrow[qs];
#pragma unroll
        for (int ks = 3; ks >= 0; --ks) {
          float l1[4], lb[4];
#pragma unroll
          for (int j = 0; j < 4; ++j) {
            const float z = s1[ks][j] * zscale;
            const float e = __expf(-fabsf(z));
            const float sp = fmaxf(z, 0.f) + __logf(1.f + e);
            const int key = t * 64 + ks * 16 + fq * 4 + j;
            l1[j] = (key < tq) ? -sp : 0.f;
            lb[j] = z - sp;
          }
          const float p4 = (l1[0] + l1[1]) + (l1[2] + l1[3]);
          const float x16 = __shfl_xor(p4, 16);
          const float a2 = p4 + x16;
          const float x32 = __shfl_xor(a2, 32);
          const float tot = a2 + x32;
          const float gt = ((fq & 1) == 0 ? x16 : 0.f) + ((fq & 2) == 0 ? x32 : 0.f);
          const float s3 = running + gt;
          const float s2 = s3 + l1[3];
          const float s1_ = s2 + l1[2];
          const float s0 = s1_ + l1[1];
          s1[ks][0] = (l1[0] < 0.f) ? __expf(lb[0] + s0) : 0.f;
          s1[ks][1] = (l1[1] < 0.f) ? __expf(lb[1] + s1_) : 0.f;
          s1[ks][2] = (l1[2] < 0.f) ? __expf(lb[2] + s2) : 0.f;
          s1[ks][3] = (l1[3] < 0.f) ? __expf(lb[3] + s3) : 0.f;
          running += tot;
        }
        lrow[qs] = running;
        if (qs == 0) {
          __builtin_amdgcn_sched_barrier(0);
          if (more) load_v(tn);
          __builtin_amdgcn_sched_barrier(0);
        }
#pragma unroll
        for (int u = 0; u < 2; ++u) {
          uint4 pk;
          pk.x = pack2(s1[2 * u][0], s1[2 * u][1]);
          pk.y = pack2(s1[2 * u][2], s1[2 * u][3]);
          pk.z = pack2(s1[2 * u + 1][0], s1[2 * u + 1][1]);
          pk.w = pack2(s1[2 * u + 1][2], s1[2 * u + 1][3]);
          bf16x8 pf1 = *(bf16x8*)&pk;
#pragma unroll
          for (int ds = 0; ds < NDS; ++ds) {
            const u16* vp = Vs + (ds * 16 + fr) * VST + u * 32 + fq * 4;
            uint2 lo = *(const uint2*)vp, hi = *(const uint2*)(vp + 16);
            uint4 vv = make_uint4(lo.x, lo.y, hi.x, hi.y);
            bf16x8 vf = *(bf16x8*)&vv;
            o[ds][qs] = mfma16(vf, pf1, o[ds][qs]);
          }
        }
        __builtin_amdgcn_sched_barrier(0);
      }
    }
    if (!active && more) { if (MODE != 2) load_k(tn); load_v(tn); }
    if (MODE == 2) {
      const int cont = (more && (lrow[0] >= -104.f || lrow[1] >= -104.f)) ? 1 : 0;
      if (!__syncthreads_or(cont)) break;
    } else {
      __syncthreads();
      if (!more) break;
    }
    t = tn;
  }
  int fr_e = fr, fq_e = fq;
  asm volatile("" : "+v"(fr_e), "+v"(fq_e));
#pragma unroll
  for (int qs = 0; qs < 2; ++qs) {
    float inv = 1.f;
    if (MODE != 2) {
      float lsum = lrow[qs];
      lsum += __shfl_xor(lsum, 16);
      lsum += __shfl_xor(lsum, 32);
      inv = 1.f / lsum;
    }
    const int row = w * 32 + qs * 16 + fr_e;
#pragma unroll
    for (int ds = 0; ds < NDS; ++ds) {
      const int dv = ds * 16 + fq_e * 4;
      uint2 g2 = *(const uint2*)(gate + (unsigned)(row * DIN + dv));
      float v0 = o[ds][qs][0] * inv * bflo(g2.x), v1 = o[ds][qs][1] * inv * bfhi(g2.x);
      float v2 = o[ds][qs][2] * inv * bflo(g2.y), v3 = o[ds][qs][3] * inv * bfhi(g2.y);
      *(uint2*)(outp + (unsigned)(row * DM + dv)) = make_uint2(pack2(v0, v1), pack2(v2, v3));
    }
  }
}

#undef KLOAD
#undef KSTORE
#undef VLOAD
#undef VSTORE
#undef load_k
#undef load_v
#undef store_tile

__device__ void gmlp_item(const Params& p, int l, int n, int g, char* smem) {
  constexpr int WST = 136;
  u16* Ws = (u16*)smem;
  u16* Bs = Ws + 128 * WST;
  float* s_mu = (float*)(Bs + 128 * WST);
  float* s_rs = s_mu + 128;
  int tid = threadIdx.x;
  asm volatile("" : "+v"(tid));
  const int w = __builtin_amdgcn_readfirstlane(tid >> 6), lane = tid & 63, fr = lane & 15, fq = lane >> 4;
  const int row0 = n * 128;
  {
    const int r = tid >> 1, half = tid & 1;
    const u16* src = p.h() + (size_t)(row0 + r) * DIN + C_SGV + half * 256;
    float s = 0.f, q = 0.f;
#pragma unroll 4
    for (int i = 0; i < 32; ++i) {
      uint4 v = *(const uint4*)(src + i * 8);
      const unsigned ww[4] = {v.x, v.y, v.z, v.w};
#pragma unroll
      for (int k = 0; k < 4; ++k) { float a = bflo(ww[k]), b = bfhi(ww[k]); s += a + b; q += a * a + b * b; }
    }
    s += __shfl_xor(s, 1);
    q += __shfl_xor(q, 1);
    const float mu = s * (1.f / 512.f);
    const float var = fmaxf(q * (1.f / 512.f) - mu * mu, 0.f);
    if (half == 0) { s_mu[r] = mu; s_rs[r] = rsqrtf(var + 1e-5f); }
  }
  {
    const float* wsrc = p.sg_w + (size_t)(l * 4 + g) * 128 * 128;
#pragma unroll 4
    for (int i = 0; i < 16; ++i) {
      int id = tid + 256 * i, tt = id >> 5, s4 = (id & 31) * 4;
      float4 v = *(const float4*)(wsrc + tt * 128 + s4);
      if (tt < 64 && s4 >= 64) v = make_float4(0.f, 0.f, 0.f, 0.f);
      *(uint2*)(Ws + tt * WST + s4) = make_uint2(pack2(v.x, v.y), pack2(v.z, v.w));
    }
  }
  __syncthreads();
  {
    const int c = tid & 127, sh = tid >> 7;
    const float lg = p.sg_ln_g[(size_t)l * 512 + g * 128 + c], lbv = p.sg_ln_b[(size_t)l * 512 + g * 128 + c];
    const u16* src = p.h() + (size_t)row0 * DIN + C_SGV + g * 128 + c;
#pragma unroll 2
    for (int s8 = 0; s8 < 8; ++s8) {
      const int so = (sh * 8 + s8) * 8;
      float v[8];
#pragma unroll
      for (int jj = 0; jj < 8; ++jj) {
        const int s = so + jj;
        v[jj] = (bf2f(src[(size_t)s * DIN]) - s_mu[s]) * s_rs[s] * lg + lbv;
      }
      *(uint4*)(Bs + c * WST + so) = make_uint4(pack2(v[0], v[1]), pack2(v[2], v[3]), pack2(v[4], v[5]), pack2(v[6], v[7]));
    }
  }
  __syncthreads();
  f32x4 acc[2][8];
#pragma unroll
  for (int mt = 0; mt < 2; ++mt)
#pragma unroll
    for (int ns = 0; ns < 8; ++ns) acc[mt][ns] = f32x4{0.f, 0.f, 0.f, 0.f};
#pragma unroll
  for (int st = 0; st < 4; ++st) {
    bf16x8 wf[2];
#pragma unroll
    for (int mt = 0; mt < 2; ++mt) wf[mt] = *(const bf16x8*)(Ws + (w * 32 + mt * 16 + fr) * WST + st * 32 + fq * 8);
#pragma unroll
    for (int ns = 0; ns < 8; ++ns) {
      bf16x8 bfv = *(const bf16x8*)(Bs + (ns * 16 + fr) * WST + st * 32 + fq * 8);
      acc[0][ns] = mfma16(bfv, wf[0], acc[0][ns]);
      acc[1][ns] = mfma16(bfv, wf[1], acc[1][ns]);
    }
  }
#pragma unroll
  for (int mt = 0; mt < 2; ++mt) {
    const int tt = w * 32 + mt * 16 + fr;
    const float bias = p.sg_b[(size_t)(l * 4 + g) * 128 + tt];
    const u16* hrow = p.h() + (size_t)(row0 + tt) * DIN;
#pragma unroll
    for (int ns = 0; ns < 8; ++ns) {
      const int c = g * 128 + ns * 16 + fq * 4;
      uint2 u2 = *(const uint2*)(hrow + C_SGU + c);
      uint2 g2 = *(const uint2*)(hrow + C_GB + c);
      float v0 = bflo(u2.x) * (acc[mt][ns][0] + bias) * bflo(g2.x);
      float v1 = bfhi(u2.x) * (acc[mt][ns][1] + bias) * bfhi(g2.x);
      float v2 = bflo(u2.y) * (acc[mt][ns][2] + bias) * bflo(g2.y);
      float v3 = bfhi(u2.y) * (acc[mt][ns][3] + bias) * bfhi(g2.y);
      *(uint2*)(p.yin() + (size_t)(row0 + tt) * DM + 768 + c) = make_uint2(pack2(v0, v1), pack2(v2, v3));
    }
  }
  __syncthreads();
}

__device__ void phaseC(const Params& p, int l, char* smem) {
  volatile int* ctl = (volatile int*)(smem + CTL_OFF);
  const int tid = threadIdx.x;
  constexpr int N_MLA = 384, N_SB = 256, N_MEM = 256, N_G = 256;
  constexpr int N_ALL = N_MLA + N_SB + N_MEM + N_G;
  while (true) {
    __syncthreads();
    if (tid == 0) ctl[0] = (int)atomicAdd(&p.ctr()[l], 1u);
    __syncthreads();
    const int item = __builtin_amdgcn_readfirstlane(ctl[0]);
    if (item >= N_ALL) break;
    if (item < N_MLA) {
      const int qb = 63 - item / 6, hd = item % 6, q0 = qb * 128;
      attn_item<192, 128, 0>(p.q() + ((size_t)hd * SEQ + q0) * 192, 192, p.k() + (size_t)hd * SEQ * 192, 192,
                             p.vt() + (size_t)hd * 128 * SEQ, SEQ, 2 * qb + 1, 1.0f, q0,
                             p.h() + (size_t)q0 * DIN + C_GA + hd * 128, p.yin() + (size_t)q0 * DM + hd * 128, smem);
    } else if (item < N_MLA + N_SB) {
      const int it = item - N_MLA, qb = it >> 2, hd = it & 3, q0 = qb * 128;
      attn_item<128, 128, 2>(p.h() + (size_t)q0 * DIN + C_SBQ + hd * 128, DIN, p.h() + C_SBK + hd * 128, DIN,
                             p.vtsb() + (size_t)hd * 128 * SEQ, SEQ, 2 * qb + 1, 0.08838834764831845f, q0,
                             p.h() + (size_t)q0 * DIN + C_GC + hd * 128, p.yin() + (size_t)q0 * DM + 1280 + hd * 128, smem);
    } else if (item < N_MLA + N_SB + N_MEM) {
      const int it = item - N_MLA - N_SB, qb = it >> 2, hd = it & 3, q0 = qb * 128;
      attn_item<64, 64, 1>(p.h() + (size_t)q0 * DIN + C_MQ + hd * 64, DIN, p.mk() + (size_t)(l * 4 + hd) * 256 * 64, 64,
                           p.mvt() + (size_t)(l * 4 + hd) * 64 * 256, 256, 3, 0.125f * 1.4426950408889634f, q0,
                           p.h() + (size_t)q0 * DIN + C_GM + hd * 64, p.yin() + (size_t)q0 * DM + 1792 + hd * 64, smem);
    } else {
      const int it = item - N_MLA - N_SB - N_MEM;
      gmlp_item(p, l, it >> 2, it & 3, smem);
    }
  }
}

__global__ void __launch_bounds__(256, 2) fwd_megakernel(Params p) {
  extern __shared__ __attribute__((aligned(16))) char smem[];
  volatile LAS unsigned* xst = (volatile LAS unsigned*)(smem + CTL_OFF + 16);
  if (threadIdx.x == 0) { xst[0] = 0u; xst[1] = 0u; }
  __syncthreads();
  const XcdBarrier xb = xcd_barrier_post(p.bar(), xst);
#define grid_barrier() xcd_barrier(xb)
  phase_prep(p, smem);
  cg::this_grid().sync();
  for (int l = 0; l < NL; ++l) {
    for (int t = blockIdx.x; t < 6 * 512; t += gridDim.x) {
      int tm, tn;
      if (tile_map(t, 45, tm, tn)) phaseA_tile(p, l, tm, tn, smem);
    }
    if (l == 0) {
      for (int t = blockIdx.x; t < NL * 8; t += gridDim.x) memkv_tile(p, t >> 3, (t >> 2) & 1, t & 3, smem);
    }
    grid_barrier();
    for (int t = blockIdx.x; t < 3 * 512; t += gridDim.x) {
      int tm, tn;
      if (tile_map(t, 21, tm, tn)) phaseB_tile(p, l, tm, tn, smem);
    }
    grid_barrier();
    phaseC(p, l, smem);
    grid_barrier();
    for (int t = blockIdx.x; t < 2 * 512; t += gridDim.x) {
      int tm, tn;
      if (tile_map(t, 16, tm, tn)) phaseD_tile(p, l, tm, tn, smem);
    }
    grid_barrier();
    phaseE(p, l);
    if (l + 1 < NL) grid_barrier();
  }
}

extern "C" void kernel_launch(void* const* d_in, const int* in_sizes, int n_in, void* d_out, int out_size, void* d_ws,
                              size_t ws_size, hipStream_t stream) {
  static int grid_blocks = 0;
  if (!grid_blocks) {
    int dev = 0, cus = 0, per_cu = 0;
    hipGetDevice(&dev);
    hipDeviceGetAttribute(&cus, hipDeviceAttributeMultiprocessorCount, dev);
    hipFuncSetAttribute((const void*)fwd_megakernel, hipFuncAttributeMaxDynamicSharedMemorySize, LDS_BYTES);
    hipOccupancyMaxActiveBlocksPerMultiprocessor(&per_cu, fwd_megakernel, 256, LDS_BYTES);
    if (per_cu > 2) per_cu = 2;
    if (per_cu < 1) per_cu = 1;
    grid_blocks = cus * per_cu;
  }
  Params p{};
  p.x = (const float*)d_in[0]; p.mem = (const float*)d_in[1]; p.pos = (const int*)d_in[2]; p.w_in = (const float*)d_in[3];
  p.q_norm_g = (const float*)d_in[4]; p.w_uq = (const float*)d_in[5]; p.kv_norm_g = (const float*)d_in[6];
  p.w_ukv = (const float*)d_in[7]; p.sg_ln_g = (const float*)d_in[8]; p.sg_ln_b = (const float*)d_in[9];
  p.sg_w = (const float*)d_in[10]; p.sg_b = (const float*)d_in[11]; p.w_mem_k = (const float*)d_in[12];
  p.w_mem_v = (const float*)d_in[13]; p.w_out = (const float*)d_in[14]; p.ln_g = (const float*)d_in[15];
  p.ln_b = (const float*)d_in[16];
  p.out = (float*)d_out;
  p.ws = (char*)d_ws;
  hipMemsetAsync(p.ws + OFF_BAR, 0, 16384, stream);
  void* args[] = {&p};
  hipError_t e = hipLaunchCooperativeKernel((const void*)fwd_megakernel, dim3(grid_blocks), dim3(256), args, LDS_BYTES, stream);
  if (e != hipSuccess) fprintf(stderr, "cooperative launch failed: %s (grid %d)\n", hipGetErrorString(e), grid_blocks);
}
```

```cpp
#include <hip/hip_runtime.h>
#include <hip/hip_cooperative_groups.h>
#include <cstdio>
namespace cg = cooperative_groups;

typedef unsigned short u16;
using bf16x8 = __attribute__((ext_vector_type(8))) short;
using f32x4 = __attribute__((ext_vector_type(4))) float;
typedef __bf16 bf16x2_t __attribute__((ext_vector_type(2)));
typedef float f32x2_t __attribute__((ext_vector_type(2)));

#define SEQ 8192
#define DM 2048
#define DIN 5696
#define DINP 5760
#define NL 4
#define PROBE_DUP 0

constexpr int LDS_BYTES = 73728;
constexpr int CTL_OFF = LDS_BYTES - 64;

constexpr int C_CQ = 0, C_CKV = 512, C_KPE = 768, C_GA = 832, C_SGU = 1600, C_SGV = 2112, C_GB = 2624,
              C_SBQ = 3136, C_SBK = 3648, C_SBV = 4160, C_GC = 4672, C_MQ = 5184, C_GM = 5440;

constexpr size_t al256(size_t x) { return (x + 255) & ~(size_t)255; }
constexpr size_t OFF_BAR = 0;
constexpr size_t OFF_CTR = OFF_BAR + al256(16384);
constexpr size_t OFF_WT_IN = OFF_CTR + al256(256);
constexpr size_t OFF_WT_OUT = OFF_WT_IN + al256((size_t)NL * DINP * DM * 2);
constexpr size_t OFF_WT_UQ = OFF_WT_OUT + al256((size_t)NL * DM * DM * 2);
constexpr size_t OFF_WT_UKV = OFF_WT_UQ + al256((size_t)NL * 1152 * 512 * 2);
constexpr size_t OFF_WT_MEMKV = OFF_WT_UKV + al256((size_t)NL * 1536 * 256 * 2);
constexpr size_t OFF_MEMB = OFF_WT_MEMKV + al256((size_t)NL * 512 * DM * 2);
constexpr size_t OFF_XB = OFF_MEMB + al256((size_t)256 * DM * 2);
constexpr size_t OFF_H = OFF_XB + al256((size_t)SEQ * DM * 2);
constexpr size_t OFF_Q = OFF_H + al256((size_t)SEQ * DIN * 2);
constexpr size_t OFF_K = OFF_Q + al256((size_t)6 * SEQ * 192 * 2);
constexpr size_t OFF_VT = OFF_K + al256((size_t)6 * SEQ * 192 * 2);
constexpr size_t OFF_VTSB = OFF_VT + al256((size_t)6 * 128 * SEQ * 2);
constexpr size_t OFF_YIN = OFF_VTSB + al256((size_t)4 * 128 * SEQ * 2);
constexpr size_t OFF_MK = OFF_YIN + al256((size_t)SEQ * DM * 2);
constexpr size_t OFF_MVT = OFF_MK + al256((size_t)NL * 4 * 256 * 64 * 2);
constexpr size_t OFF_COST = OFF_MVT + al256((size_t)NL * 4 * 64 * 256 * 2);
constexpr size_t OFF_SINT = OFF_COST + al256((size_t)SEQ * 32 * 4);
constexpr size_t WS_TOTAL = OFF_SINT + al256((size_t)SEQ * 32 * 4);
struct Params {
  const float* x; const float* mem; const int* pos; const float* w_in; const float* q_norm_g; const float* w_uq;
  const float* kv_norm_g; const float* w_ukv; const float* sg_ln_g; const float* sg_ln_b; const float* sg_w; const float* sg_b;
  const float* w_mem_k; const float* w_mem_v; const float* w_out; const float* ln_g; const float* ln_b;
  float* out;
  char* ws;
  __device__ __forceinline__ unsigned* bar() const { return (unsigned*)(ws + OFF_BAR); }
  __device__ __forceinline__ unsigned* ctr() const { return (unsigned*)(ws + OFF_CTR); }
  __device__ __forceinline__ u16* wt_in() const { return (u16*)(ws + OFF_WT_IN); }
  __device__ __forceinline__ u16* wt_out() const { return (u16*)(ws + OFF_WT_OUT); }
  __device__ __forceinline__ u16* wt_uq() const { return (u16*)(ws + OFF_WT_UQ); }
  __device__ __forceinline__ u16* wt_ukv() const { return (u16*)(ws + OFF_WT_UKV); }
  __device__ __forceinline__ u16* wt_memkv() const { return (u16*)(ws + OFF_WT_MEMKV); }
  __device__ __forceinline__ u16* memb() const { return (u16*)(ws + OFF_MEMB); }
  __device__ __forceinline__ u16* xb() const { return (u16*)(ws + OFF_XB); }
  __device__ __forceinline__ u16* h() const { return (u16*)(ws + OFF_H); }
  __device__ __forceinline__ u16* q() const { return (u16*)(ws + OFF_Q); }
  __device__ __forceinline__ u16* k() const { return (u16*)(ws + OFF_K); }
  __device__ __forceinline__ u16* vt() const { return (u16*)(ws + OFF_VT); }
  __device__ __forceinline__ u16* vtsb() const { return (u16*)(ws + OFF_VTSB); }
  __device__ __forceinline__ u16* yin() const { return (u16*)(ws + OFF_YIN); }
  __device__ __forceinline__ u16* mk() const { return (u16*)(ws + OFF_MK); }
  __device__ __forceinline__ u16* mvt() const { return (u16*)(ws + OFF_MVT); }
  __device__ __forceinline__ float* cosT() const { return (float*)(ws + OFF_COST); }
  __device__ __forceinline__ float* sinT() const { return (float*)(ws + OFF_SINT); }
};

__device__ __forceinline__ unsigned pack2(float a, float b) {
  f32x2_t v = {a, b};
  bf16x2_t r = __builtin_convertvector(v, bf16x2_t);
  return *(unsigned*)&r;
}
__device__ __forceinline__ u16 f2bf(float a) { return (u16)(pack2(a, 0.f) & 0xffffu); }
__device__ __forceinline__ float bflo(unsigned w) { return __uint_as_float(w << 16); }
__device__ __forceinline__ float bfhi(unsigned w) { return __uint_as_float(w & 0xffff0000u); }
__device__ __forceinline__ float bf2f(u16 h) { return __uint_as_float(((unsigned)h) << 16); }
__device__ __forceinline__ float silu_f(float x) { return x / (1.f + __expf(-x)); }
__device__ __forceinline__ float gelu_f(float x) {
  float u = 0.7978845608028654f * (x + 0.044715f * x * x * x);
  float t = 1.f - 2.f / (__expf(2.f * u) + 1.f);
  return 0.5f * x * (1.f + t);
}
__device__ __forceinline__ f32x4 mfma16(bf16x8 a, bf16x8 b, f32x4 c) {
  return __builtin_amdgcn_mfma_f32_16x16x32_bf16(a, b, c, 0, 0, 0);
}

#define XB_TMO      128
#define XB_XCNT(j)  (256  + 64 * (j))
#define XB_XSUB(j)  (1280 + 64 * (j))
#define XB_XGEN(j)  (2304 + 64 * (j))
#define XB_TOP      3328
#define XB_TOPGEN   3392
#define XCD_BAR_WORDS 3456
#define XB_SPIN_CAP (1u << 22)
#define LAS __attribute__((address_space(3)))
__device__ __forceinline__ unsigned xb_ld(unsigned* p) { return __hip_atomic_load(p, __ATOMIC_RELAXED, __HIP_MEMORY_SCOPE_AGENT); }
__device__ __forceinline__ unsigned xb_add(unsigned* p, unsigned v) { return __hip_atomic_fetch_add(p, v, __ATOMIC_RELAXED, __HIP_MEMORY_SCOPE_AGENT); }
__device__ __forceinline__ unsigned xb_xcc_id() { return (unsigned)__builtin_amdgcn_s_getreg((3 << 11) | 20) & 0xFu; }
#define XB_SPIN(cond, bar) do { unsigned _sp = 0; while (cond) { __builtin_amdgcn_s_sleep(1); \
    if ((++_sp & 255u) == 0u) { if (xb_ld(&(bar)[XB_TMO])) break; if (_sp > XB_SPIN_CAP) { atomicAdd(&(bar)[XB_TMO], 1u); break; } } } } while (0)
struct XcdBarrier { unsigned* bar; unsigned x; volatile LAS unsigned* st; };
__device__ __forceinline__ XcdBarrier xcd_barrier_post(unsigned* bar, volatile LAS unsigned* st) {
  XcdBarrier b; b.bar = bar; b.x = xb_xcc_id(); b.st = st;
  if (threadIdx.x == 0) (void)xb_add(&bar[XB_XCNT(b.x)], 1u);
  return b;
}
__device__ __forceinline__ void xcd_barrier_complete(unsigned* bar, unsigned x, unsigned& nloc, unsigned& nx) {
  const unsigned G = gridDim.x * gridDim.y * gridDim.z;
  unsigned sum, cnt, mine, sp = 0u;
  for (;;) {
    sum = 0u; cnt = 0u; mine = 0u;
#pragma unroll
    for (unsigned j = 0; j < 16; ++j) { const unsigned c = xb_ld(&bar[XB_XCNT(j)]); sum += c; cnt += (c > 0u) ? 1u : 0u; mine = (j == x) ? c : mine; }
    if (sum == G) break;
    __builtin_amdgcn_s_sleep(1);
    if ((++sp & 255u) == 0u) { if (xb_ld(&bar[XB_TMO])) break; if (sp > XB_SPIN_CAP) { atomicAdd(&bar[XB_TMO], 1u); break; } }
  }
  nloc = mine > 0u ? mine : 1u; nx = cnt > 0u ? cnt : 1u;
}
__device__ __forceinline__ void xcd_barrier(const XcdBarrier& b) {
  asm volatile("s_waitcnt vmcnt(0)" ::: "memory");
  __syncthreads();
  if (threadIdx.x == 0) {
    unsigned* bar = b.bar;
    __builtin_amdgcn_s_waitcnt(0);
    unsigned nloc = b.st[0], nx = b.st[1];
    if (nloc == 0u) { xcd_barrier_complete(bar, b.x, nloc, nx); b.st[0] = nloc; b.st[1] = nx; }
    const unsigned old = xb_add(&bar[XB_XSUB(b.x)], 1u);
    const unsigned gen = old / nloc;
    if (old + 1u == (gen + 1u) * nloc) {
      __builtin_amdgcn_fence(__ATOMIC_RELEASE, "agent");
      asm volatile("s_waitcnt vmcnt(0)" ::: "memory");
      const unsigned og = xb_add(&bar[XB_TOP], 1u);
      const unsigned tg = og / nx;
      if (og + 1u == (tg + 1u) * nx) xb_add(&bar[XB_TOPGEN], 1u);
      else XB_SPIN(xb_ld(&bar[XB_TOPGEN]) == tg, bar);
      __builtin_amdgcn_fence(__ATOMIC_ACQUIRE, "agent");
      xb_add(&bar[XB_XGEN(b.x)], 1u);
      asm volatile("s_waitcnt vmcnt(0)" ::: "memory");
    } else {
      XB_SPIN(xb_ld(&bar[XB_XGEN(b.x)]) == gen, bar);
      __builtin_amdgcn_fence(__ATOMIC_ACQUIRE, "agent");
      asm volatile("s_waitcnt vmcnt(0)" ::: "memory");
    }
  }
  __syncthreads();
}

__device__ void tconv_tile(const float* __restrict__ src, u16* __restrict__ dst, int K, int N, int k0, int n0,
                           const float* __restrict__ g, float* lds) {
  int tid = threadIdx.x;
  asm volatile("" : "+v"(tid));
#pragma unroll
  for (int i = 0; i < 4; ++i) {
    int r = (tid >> 4) + 16 * i, c = (tid & 15) * 4;
    float4 v = make_float4(0.f, 0.f, 0.f, 0.f);
    if (n0 + c < N) v = *(const float4*)(src + (size_t)(k0 + r) * N + n0 + c);
    if (g) { float s = g[k0 + r]; v.x *= s; v.y *= s; v.z *= s; v.w *= s; }
    float* p = lds + r * 65 + c;
    p[0] = v.x; p[1] = v.y; p[2] = v.z; p[3] = v.w;
  }
  __syncthreads();
#pragma unroll
  for (int i = 0; i < 2; ++i) {
    int id = tid + 256 * i, n = id >> 3, kc = (id & 7) * 8;
    unsigned w0 = pack2(lds[(kc + 0) * 65 + n], lds[(kc + 1) * 65 + n]);
    unsigned w1 = pack2(lds[(kc + 2) * 65 + n], lds[(kc + 3) * 65 + n]);
    unsigned w2 = pack2(lds[(kc + 4) * 65 + n], lds[(kc + 5) * 65 + n]);
    unsigned w3 = pack2(lds[(kc + 6) * 65 + n], lds[(kc + 7) * 65 + n]);
    *(uint4*)(dst + (size_t)(n0 + n) * K + k0 + kc) = make_uint4(w0, w1, w2, w3);
  }
  __syncthreads();
}

__device__ void tconv_all(const float* src, u16* dst, int K, int N, int Npad, size_t srcLS, size_t dstLS, int dstRowOff,
                          const float* g, int gS, float* lds) {
  const int nkt = K / 64, nnt = Npad / 64, per = nkt * nnt;
  for (int t = blockIdx.x; t < NL * per; t += gridDim.x) {
    int l = t / per, r = t % per, kt = r / nnt, nt = r % nnt;
    tconv_tile(src + (size_t)l * srcLS, dst + (size_t)l * dstLS + (size_t)dstRowOff * K, K, N, kt * 64, nt * 64,
               g ? g + (size_t)l * gS : nullptr, lds);
  }
}

__device__ void phase_prep(const Params& p, char* smem) {
  float* lds = (float*)smem;
  const int tid = threadIdx.x;
  const size_t gtid = (size_t)blockIdx.x * 256 + tid, gsz = (size_t)gridDim.x * 256;
  if (blockIdx.x == 0 && tid < 16) p.ctr()[tid] = 0u;
  for (size_t c = gtid; c < (size_t)SEQ * DM / 8; c += gsz) {
    float4 a = *(const float4*)(p.x + c * 8), b = *(const float4*)(p.x + c * 8 + 4);
    *(uint4*)(p.xb() + c * 8) = make_uint4(pack2(a.x, a.y), pack2(a.z, a.w), pack2(b.x, b.y), pack2(b.z, b.w));
  }
  for (size_t c = gtid; c < (size_t)256 * DM / 8; c += gsz) {
    float4 a = *(const float4*)(p.mem + c * 8), b = *(const float4*)(p.mem + c * 8 + 4);
    *(uint4*)(p.memb() + c * 8) = make_uint4(pack2(a.x, a.y), pack2(a.z, a.w), pack2(b.x, b.y), pack2(b.z, b.w));
  }
  for (size_t e = gtid; e < (size_t)SEQ * 32; e += gsz) {
    int s = (int)(e >> 5), i = (int)(e & 31);
    float invf = __builtin_amdgcn_exp2f(-(float)i * (13.287712379549449f / 32.0f));
    float ang = (float)p.pos[s] * invf;
    double rev = (double)ang * 0.15915494309189535;
    float fr = (float)(rev - floor(rev));
    p.cosT()[e] = __builtin_amdgcn_cosf(fr);
    p.sinT()[e] = __builtin_amdgcn_sinf(fr);
  }
  tconv_all(p.w_in, p.wt_in(), DM, DIN, DINP, (size_t)DM * DIN, (size_t)DINP * DM, 0, nullptr, 0, lds);
  tconv_all(p.w_out, p.wt_out(), DM, DM, DM, (size_t)DM * DM, (size_t)DM * DM, 0, nullptr, 0, lds);
  tconv_all(p.w_uq, p.wt_uq(), 512, 1152, 1152, (size_t)512 * 1152, (size_t)1152 * 512, 0, p.q_norm_g, 512, lds);
  tconv_all(p.w_ukv, p.wt_ukv(), 256, 1536, 1536, (size_t)256 * 1536, (size_t)1536 * 256, 0, p.kv_norm_g, 256, lds);
  tconv_all(p.w_mem_k, p.wt_memkv(), DM, 256, 256, (size_t)DM * 256, (size_t)512 * DM, 0, nullptr, 0, lds);
  tconv_all(p.w_mem_v, p.wt_memkv(), DM, 256, 256, (size_t)DM * 256, (size_t)512 * DM, 256, nullptr, 0, lds);
}

template <bool SSQ>
__device__ __forceinline__ void gemm_core(const u16* __restrict__ A, int lda, const u16* __restrict__ B, int ldb, int K,
                                          int brow, int bcol, char* smem, f32x4 (&acc)[4][4], float (&ssq)[4],
                                          int wr, int wc, int fr, int fq) {
  int tid = threadIdx.x;
  asm volatile("" : "+v"(tid));
#pragma unroll
  for (int m = 0; m < 4; ++m) {
    ssq[m] = 0.f;
#pragma unroll
    for (int n = 0; n < 4; ++n) acc[m][n] = f32x4{0.f, 0.f, 0.f, 0.f};
  }
  const int kcs = ((tid & 3) ^ (((tid >> 5) & 1) << 1)) * 8;
  const u16* pa = A + (size_t)(brow + (tid >> 2)) * lda + kcs;
  const u16* pb = B + (size_t)(bcol + (tid >> 2)) * ldb + kcs;
  const int fqs = (fq ^ ((fr >> 3) << 1)) * 16;
  const int nk = K >> 6;
  __syncthreads();
  auto stage = [&](int kt, int buf) __attribute__((always_inline)) {
    char* la = smem + buf * 32768 + tid * 16;
    char* lb = la + 16384;
#pragma unroll
    for (int i = 0; i < 4; ++i) {
      const u16* ga = pa + (size_t)((i & 1) * 64) * lda + (i >> 1) * 32 + kt * 64;
      const u16* gb = pb + (size_t)((i & 1) * 64) * ldb + (i >> 1) * 32 + kt * 64;
      __builtin_amdgcn_global_load_lds((const unsigned*)ga, (unsigned*)(la + i * 4096), 16, 0, 0);
      __builtin_amdgcn_global_load_lds((const unsigned*)gb, (unsigned*)(lb + i * 4096), 16, 0, 0);
    }
  };
  stage(0, 0);
  for (int kt = 0; kt < nk; ++kt) {
    asm volatile("s_waitcnt vmcnt(0)" ::: "memory");
    __syncthreads();
    if (kt + 1 < nk) stage(kt + 1, (kt + 1) & 1);
    const char* sa = smem + (kt & 1) * 32768;
    const char* sb = sa + 16384;
#pragma unroll
    for (int ks = 0; ks < 2; ++ks) {
      bf16x8 af[4], bfr[4];
#pragma unroll
      for (int m = 0; m < 4; ++m) af[m] = *(const bf16x8*)(sa + ks * 8192 + (wr * 64 + m * 16 + fr) * 64 + fqs);
#pragma unroll
      for (int n = 0; n < 4; ++n) bfr[n] = *(const bf16x8*)(sb + ks * 8192 + (wc * 64 + n * 16 + fr) * 64 + fqs);
      if (SSQ) {
#pragma unroll
        for (int m = 0; m < 4; ++m) {
          const unsigned* w = (const unsigned*)&af[m];
#pragma unroll
          for (int i = 0; i < 4; ++i) { float lo = bflo(w[i]), hi = bfhi(w[i]); ssq[m] += lo * lo + hi * hi; }
        }
      }
#pragma unroll
      for (int m = 0; m < 4; ++m)
#pragma unroll
        for (int n = 0; n < 4; ++n) acc[m][n] = mfma16(bfr[n], af[m], acc[m][n]);
    }
  }
  if (SSQ) {
#pragma unroll
    for (int m = 0; m < 4; ++m) {
      ssq[m] += __shfl_xor(ssq[m], 16);
      ssq[m] += __shfl_xor(ssq[m], 32);
    }
  }
}

__device__ __forceinline__ bool tile_map(int t, int ntn, int& m, int& n) {
  int r = t >> 9, b = t & 511;
  int xcd = b & 7, idx = b >> 3;
  m = xcd * 8 + (idx & 7);
  n = r * 8 + (idx >> 3);
  return n < ntn;
}

__device__ void phaseA_tile(const Params& p, int l, int tm, int tn, char* smem) {
  int tid = threadIdx.x;
  asm volatile("" : "+v"(tid));
  const int wid = __builtin_amdgcn_readfirstlane(tid >> 6), lane = tid & 63;
  const int wr = wid >> 1, wc = wid & 1, fr = lane & 15, fq = lane >> 4;
  f32x4 acc[4][4];
  float ssq[4];
  const int brow = tm * 128, bcol = tn * 128;
  gemm_core<false>(p.xb(), DM, p.wt_in() + (size_t)l * DINP * DM, DM, DM, brow, bcol, smem, acc, ssq, wr, wc, fr, fq);
  const int col0 = bcol + wc * 64;
  int kind;
  if (col0 < C_KPE) kind = 0; else if (col0 < C_GA) kind = 3; else if (col0 < C_SGU) kind = 1;
  else if (col0 < C_GB) kind = 2; else if (col0 < C_SBQ) kind = 1; else if (col0 < C_SBV) kind = 0;
  else if (col0 < C_GC) kind = 4; else if (col0 < C_MQ) kind = 1; else if (col0 < C_GM) kind = 0;
  else if (col0 < DIN) kind = 1; else kind = 5;
  if (kind == 5) return;
  if (kind <= 2) {
#pragma unroll
    for (int m = 0; m < 4; ++m) {
      const int row = brow + wr * 64 + m * 16 + fr;
#pragma unroll
      for (int n = 0; n < 4; ++n) {
        float v0 = acc[m][n][0], v1 = acc[m][n][1], v2 = acc[m][n][2], v3 = acc[m][n][3];
        if (kind == 1) { v0 = silu_f(v0); v1 = silu_f(v1); v2 = silu_f(v2); v3 = silu_f(v3); }
        else if (kind == 2) { v0 = gelu_f(v0); v1 = gelu_f(v1); v2 = gelu_f(v2); v3 = gelu_f(v3); }
        *(uint2*)(p.h() + (size_t)row * DIN + col0 + n * 16 + fq * 4) = make_uint2(pack2(v0, v1), pack2(v2, v3));
      }
    }
  } else if (kind == 3) {
#pragma unroll
    for (int m = 0; m < 4; ++m) {
      const int row = brow + wr * 64 + m * 16 + fr;
#pragma unroll
      for (int n = 0; n < 2; ++n) {
        const int i0 = n * 16 + fq * 4;
        float4 cs = *(const float4*)(p.cosT() + (size_t)row * 32 + i0);
        float4 sn = *(const float4*)(p.sinT() + (size_t)row * 32 + i0);
        f32x4 x1 = acc[m][n], x2 = acc[m][n + 2];
        float a0 = x1[0] * cs.x - x2[0] * sn.x, a1 = x1[1] * cs.y - x2[1] * sn.y, a2 = x1[2] * cs.z - x2[2] * sn.z, a3 = x1[3] * cs.w - x2[3] * sn.w;
        float b0 = x1[0] * sn.x + x2[0] * cs.x, b1 = x1[1] * sn.y + x2[1] * cs.y, b2 = x1[2] * sn.z + x2[2] * cs.z, b3 = x1[3] * sn.w + x2[3] * cs.w;
        uint2 ua = make_uint2(pack2(a0, a1), pack2(a2, a3)), ub = make_uint2(pack2(b0, b1), pack2(b2, b3));
#pragma unroll
        for (int hd = 0; hd < 6; ++hd) {
          u16* kp = p.k() + ((size_t)hd * SEQ + row) * 192 + 128 + i0;
          *(uint2*)kp = ua;
          *(uint2*)(kp + 32) = ub;
        }
      }
    }
  } else {
#pragma unroll
    for (int m = 0; m < 4; ++m) {
      const int row = brow + wr * 64 + m * 16 + fr;
#pragma unroll
      for (int n = 0; n < 4; ++n) {
        const int c = col0 - C_SBV + n * 16 + fq * 4;
#pragma unroll
        for (int j = 0; j < 4; ++j) p.vtsb()[(size_t)(c + j) * SEQ + row] = f2bf(acc[m][n][j]);
      }
    }
  }
}

__device__ void memkv_tile(const Params& p, int l, int tm, int tn, char* smem) {
  int tid = threadIdx.x;
  asm volatile("" : "+v"(tid));
  const int wid = __builtin_amdgcn_readfirstlane(tid >> 6), lane = tid & 63;
  const int wr = wid >> 1, wc = wid & 1, fr = lane & 15, fq = lane >> 4;
  f32x4 acc[4][4];
  float ssq[4];
  const int brow = tm * 128, bcol = tn * 128;
  gemm_core<false>(p.memb(), DM, p.wt_memkv() + (size_t)l * 512 * DM, DM, DM, brow, bcol, smem, acc, ssq, wr, wc, fr, fq);
  const int col0 = bcol + wc * 64;
  if (col0 < 256) {
    const int hd = col0 >> 6;
#pragma unroll
    for (int m = 0; m < 4; ++m) {
      const int row = brow + wr * 64 + m * 16 + fr;
#pragma unroll
      for (int n = 0; n < 4; ++n)
        *(uint2*)(p.mk() + ((size_t)(l * 4 + hd) * 256 + row) * 64 + n * 16 + fq * 4) =
            make_uint2(pack2(acc[m][n][0], acc[m][n][1]), pack2(acc[m][n][2], acc[m][n][3]));
    }
  } else {
    const int hd = (col0 - 256) >> 6;
#pragma unroll
    for (int m = 0; m < 4; ++m) {
      const int row = brow + wr * 64 + m * 16 + fr;
#pragma unroll
      for (int n = 0; n < 4; ++n)
#pragma unroll
        for (int j = 0; j < 4; ++j)
          p.mvt()[((size_t)(l * 4 + hd) * 64 + n * 16 + fq * 4 + j) * 256 + row] = f2bf(acc[m][n][j]);
    }
  }
}

__device__ void phaseB_tile(const Params& p, int l, int tm, int tn, char* smem) {
  int tid = threadIdx.x;
  asm volatile("" : "+v"(tid));
  const int wid = __builtin_amdgcn_readfirstlane(tid >> 6), lane = tid & 63;
  const int wr = wid >> 1, wc = wid & 1, fr = lane & 15, fq = lane >> 4;
  f32x4 acc[4][4];
  float ssq[4];
  const int brow = tm * 128;
  if (tn < 9) {
    const int bcol = tn * 128;
    gemm_core<true>(p.h() + C_CQ, DIN, p.wt_uq() + (size_t)l * 1152 * 512, 512, 512, brow, bcol, smem, acc, ssq, wr, wc, fr, fq);
    const int col0 = bcol + wc * 64;
    const int hd = col0 / 192, o = col0 % 192;
    const float qs = 0.07216878364870322f * 1.4426950408889634f;
#pragma unroll
    for (int m = 0; m < 4; ++m) {
      const int row = brow + wr * 64 + m * 16 + fr;
      const float rs = rsqrtf(ssq[m] * (1.f / 512.f) + 1e-6f) * qs;
      u16* qp = p.q() + ((size_t)hd * SEQ + row) * 192;
      if (o < 128) {
#pragma unroll
        for (int n = 0; n < 4; ++n)
          *(uint2*)(qp + o + n * 16 + fq * 4) =
              make_uint2(pack2(acc[m][n][0] * rs, acc[m][n][1] * rs), pack2(acc[m][n][2] * rs, acc[m][n][3] * rs));
      } else {
#pragma unroll
        for (int n = 0; n < 2; ++n) {
          const int i0 = n * 16 + fq * 4;
          float4 cs = *(const float4*)(p.cosT() + (size_t)row * 32 + i0);
          float4 sn = *(const float4*)(p.sinT() + (size_t)row * 32 + i0);
          f32x4 x1 = acc[m][n] * rs, x2 = acc[m][n + 2] * rs;
          float a0 = x1[0] * cs.x - x2[0] * sn.x, a1 = x1[1] * cs.y - x2[1] * sn.y, a2 = x1[2] * cs.z - x2[2] * sn.z, a3 = x1[3] * cs.w - x2[3] * sn.w;
          float b0 = x1[0] * sn.x + x2[0] * cs.x, b1 = x1[1] * sn.y + x2[1] * cs.y, b2 = x1[2] * sn.z + x2[2] * cs.z, b3 = x1[3] * sn.w + x2[3] * cs.w;
          *(uint2*)(qp + 128 + i0) = make_uint2(pack2(a0, a1), pack2(a2, a3));
          *(uint2*)(qp + 160 + i0) = make_uint2(pack2(b0, b1), pack2(b2, b3));
        }
      }
    }
  } else {
    const int bcol = (tn - 9) * 128;
    gemm_core<true>(p.h() + C_CKV, DIN, p.wt_ukv() + (size_t)l * 1536 * 256, 256, 256, brow, bcol, smem, acc, ssq, wr, wc, fr, fq);
    const int col0 = bcol + wc * 64;
    const int hd = col0 >> 8, o = col0 & 255;
#pragma unroll
    for (int m = 0; m < 4; ++m) {
      const int row = brow + wr * 64 + m * 16 + fr;
      const float rs = rsqrtf(ssq[m] * (1.f / 256.f) + 1e-6f);
      if (o < 128) {
        u16* kp = p.k() + ((size_t)hd * SEQ + row) * 192 + o;
#pragma unroll
        for (int n = 0; n < 4; ++n)
          *(uint2*)(kp + n * 16 + fq * 4) =
              make_uint2(pack2(acc[m][n][0] * rs, acc[m][n][1] * rs), pack2(acc[m][n][2] * rs, acc[m][n][3] * rs));
      } else {
#pragma unroll
        for (int n = 0; n < 4; ++n)
#pragma unroll
          for (int j = 0; j < 4; ++j)
            p.vt()[((size_t)hd * 128 + (o - 128) + n * 16 + fq * 4 + j) * SEQ + row] = f2bf(acc[m][n][j] * rs);
      }
    }
  }
}

__device__ void phaseD_tile(const Params& p, int l, int tm, int tn, char* smem) {
  int tid = threadIdx.x;
  asm volatile("" : "+v"(tid));
  const int wid = __builtin_amdgcn_readfirstlane(tid >> 6), lane = tid & 63;
  const int wr = wid >> 1, wc = wid & 1, fr = lane & 15, fq = lane >> 4;
  f32x4 acc[4][4];
  float ssq[4];
  const int brow = tm * 128, bcol = tn * 128;
  gemm_core<false>(p.yin(), DM, p.wt_out() + (size_t)l * DM * DM, DM, DM, brow, bcol, smem, acc, ssq, wr, wc, fr, fq);
  const float alpha = 1.681792830507429f;
  const float* xres = (l == 0) ? p.x : p.out;
#pragma unroll
  for (int m = 0; m < 4; ++m) {
    const int row = brow + wr * 64 + m * 16 + fr;
#pragma unroll
    for (int n = 0; n < 4; ++n) {
      const size_t off = (size_t)row * DM + bcol + wc * 64 + n * 16 + fq * 4;
      float4 xr = *(const float4*)(xres + off);
      float4 z = make_float4(alpha * xr.x + acc[m][n][0], alpha * xr.y + acc[m][n][1], alpha * xr.z + acc[m][n][2], alpha * xr.w + acc[m][n][3]);
      *(float4*)(p.out + off) = z;
    }
  }
}

__device__ void phaseE(const Params& p, int l) {
  int tid = threadIdx.x;
  asm volatile("" : "+v"(tid));
  const int lane = tid & 63;
  const int gw = blockIdx.x * 4 + (tid >> 6), nw = gridDim.x * 4;
  const float* g = p.ln_g + (size_t)l * DM;
  const float* b = p.ln_b + (size_t)l * DM;
  for (int row = gw; row < SEQ; row += nw) {
    float* zr = p.out + (size_t)row * DM;
    float4 v[8];
    float s = 0.f;
#pragma unroll
    for (int i = 0; i < 8; ++i) { v[i] = *(const float4*)(zr + (i * 64 + lane) * 4); s += v[i].x + v[i].y + v[i].z + v[i].w; }
#pragma unroll
    for (int o = 1; o < 64; o <<= 1) s += __shfl_xor(s, o);
    const float mu = s * (1.f / DM);
    float q = 0.f;
#pragma unroll
    for (int i = 0; i < 8; ++i) {
      v[i].x -= mu; v[i].y -= mu; v[i].z -= mu; v[i].w -= mu;
      q += v[i].x * v[i].x + v[i].y * v[i].y + v[i].z * v[i].z + v[i].w * v[i].w;
    }
#pragma unroll
    for (int o = 1; o < 64; o <<= 1) q += __shfl_xor(q, o);
    const float rstd = rsqrtf(q * (1.f / DM) + 1e-5f);
#pragma unroll
    for (int i = 0; i < 8; ++i) {
      const int c = (i * 64 + lane) * 4;
      float4 gg = *(const float4*)(g + c), bb = *(const float4*)(b + c);
      float4 r = make_float4(v[i].x * rstd * gg.x + bb.x, v[i].y * rstd * gg.y + bb.y, v[i].z * rstd * gg.z + bb.z, v[i].w * rstd * gg.w + bb.w);
      *(float4*)(zr + c) = r;
      *(uint2*)(p.xb() + (size_t)row * DM + c) = make_uint2(pack2(r.x, r.y), pack2(r.z, r.w));
    }
  }
}

template <int DK, int DV, int MODE>
__device__ void attn_item(const u16* __restrict__ Qp, int ldq, const u16* __restrict__ Kp, int ldk, const u16* __restrict__ Vt, int ldv,
                          int t_last, float zscale, int q0, const u16* __restrict__ gate, u16* __restrict__ outp, char* smem) {
  constexpr int VST = 72, KCH = DK / 8;
  constexpr int NKR = (64 * KCH) / 256, NVR = (DV * 8) / 256, NST = DK / 32, NDS = DV / 16;
  u16* Ks = (u16*)smem;
  u16* Vs = Ks + 64 * DK;
  int tid = threadIdx.x;
  asm volatile("" : "+v"(tid));
  asm volatile("" : "+s"(t_last));
  const int w = __builtin_amdgcn_readfirstlane(tid >> 6), lane = tid & 63, fr = lane & 15, fq = lane >> 4;

  const int fqs = (fq ^ ((fr >> 3) << 1)) * 16;
  constexpr int NSR = (MODE == 0) ? 4 : NST;
  bf16x8 qf[2][NSR];
  bf16x8* Qr = (bf16x8*)(Vs + DV * VST) + (w * 4) * 64 + lane;
#pragma unroll
  for (int qs = 0; qs < 2; ++qs)
#pragma unroll
    for (int st = 0; st < NST; ++st) {
      bf16x8 v = *(const bf16x8*)(Qp + (unsigned)((w * 32 + qs * 16 + fr) * ldq + st * 32 + fq * 8));
      if (st < NSR) qf[qs][st < NSR ? st : 0] = v;
      else Qr[(qs * 2 + (st - NSR)) * 64] = v;
    }

  f32x4 o[NDS][2];
#pragma unroll
  for (int ds = 0; ds < NDS; ++ds) { o[ds][0] = f32x4{0.f, 0.f, 0.f, 0.f}; o[ds][1] = f32x4{0.f, 0.f, 0.f, 0.f}; }
  float mrow[2] = {-1e30f, -1e30f};
  float lrow[2] = {0.f, 0.f};

  uint4 kk0, kk1, kk2, kk3, kk4, kk5, vv0, vv1, vv2, vv3;
#define KLOAD(i, T) if constexpr (NKR > i) { const int c_ = tid + 256 * i, row_ = c_ / KCH, cc_ = c_ % KCH; kk##i = *(const uint4*)((Kp + (size_t)(T) * 64 * ldk) + (unsigned)(row_ * ldk + cc_ * 8)); }
#define KSTORE(i) if constexpr (NKR > i) { const int c_ = tid + 256 * i, row_ = c_ / KCH, cc_ = c_ % KCH; \
    *(uint4*)((char*)Ks + (cc_ >> 2) * 4096 + row_ * 64 + (((cc_ & 3) ^ (((row_ >> 3) & 1) << 1)) * 16)) = kk##i; }
#define VLOAD(i, T) if constexpr (NVR > i) { const int c_ = tid + 256 * i, dv_ = c_ >> 3, cc_ = c_ & 7; vv##i = *(const uint4*)((Vt + (T) * 64) + (unsigned)(dv_ * ldv + cc_ * 8)); }
#define VSTORE(i) if constexpr (NVR > i) { const int c_ = tid + 256 * i, dv_ = c_ >> 3, cc_ = c_ & 7; *(uint4*)(Vs + dv_ * VST + cc_ * 8) = vv##i; }
#define load_k(T) do { KLOAD(0, T) KLOAD(1, T) KLOAD(2, T) KLOAD(3, T) KLOAD(4, T) KLOAD(5, T) } while (0)
#define load_v(T) do { VLOAD(0, T) VLOAD(1, T) VLOAD(2, T) VLOAD(3, T) } while (0)
#define store_tile() do { KSTORE(0) KSTORE(1) KSTORE(2) KSTORE(3) KSTORE(4) KSTORE(5) VSTORE(0) VSTORE(1) VSTORE(2) VSTORE(3) } while (0)

  int t = (MODE == 2) ? t_last : 0;
  load_k(t);
  load_v(t);
  while (true) {
    store_tile();
    __syncthreads();
    const int tn = (MODE == 2) ? t - 1 : t + 1;
    const bool more = (MODE == 2) ? (t > 0) : (t < t_last);
    if (MODE == 2 && more) load_k(tn);
    bool active = true;
    if (MODE == 0 || MODE == 2) active = !(t == t_last && w < 2);
    if (MODE != 2 && active) {
      f32x4 s[4][2];
#pragma unroll
      for (int ks = 0; ks < 4; ++ks) { s[ks][0] = f32x4{0.f, 0.f, 0.f, 0.f}; s[ks][1] = f32x4{0.f, 0.f, 0.f, 0.f}; }
#pragma unroll
      for (int st = 0; st < NST; ++st) {
#pragma unroll
        for (int ks = 0; ks < 4; ++ks) {
          bf16x8 kf = *(const bf16x8*)((const char*)Ks + st * 4096 + (ks * 16 + fr) * 64 + fqs);
          if (st < NSR) {
            s[ks][0] = mfma16(kf, qf[0][st < NSR ? st : 0], s[ks][0]);
            s[ks][1] = mfma16(kf, qf[1][st < NSR ? st : 0], s[ks][1]);
          } else {
            s[ks][0] = mfma16(kf, Qr[(st - NSR) * 64], s[ks][0]);
            s[ks][1] = mfma16(kf, Qr[(2 + st - NSR) * 64], s[ks][1]);
          }
        }
      }
      {
#pragma unroll
        for (int qs = 0; qs < 2; ++qs) {
          float mx = -1e30f;
#pragma unroll
          for (int ks = 0; ks < 4; ++ks)
#pragma unroll
            for (int j = 0; j < 4; ++j) mx = fmaxf(mx, s[ks][qs][j]);
          mx *= zscale;
          mx = fmaxf(mx, __shfl_xor(mx, 16));
          mx = fmaxf(mx, __shfl_xor(mx, 32));
          const float mn = fmaxf(mrow[qs], mx);
          const float alpha = __builtin_amdgcn_exp2f(mrow[qs] - mn);
          mrow[qs] = mn;
          float ls = 0.f;
#pragma unroll
          for (int ks = 0; ks < 4; ++ks)
#pragma unroll
            for (int j = 0; j < 4; ++j) {
              float pv = __builtin_amdgcn_exp2f(s[ks][qs][j] * zscale - mn);
              ls += pv;
              s[ks][qs][j] = pv;
            }
          lrow[qs] = lrow[qs] * alpha + ls;
#pragma unroll
          for (int ds = 0; ds < NDS; ++ds) o[ds][qs] *= alpha;
        }
      }
      __builtin_amdgcn_sched_barrier(0);
      if (more) { load_k(tn); load_v(tn); }
      __builtin_amdgcn_sched_barrier(0);
      bf16x8 pf[2][2];
#pragma unroll
      for (int qs = 0; qs < 2; ++qs)
#pragma unroll
        for (int u = 0; u < 2; ++u) {
          uint4 pk;
          pk.x = pack2(s[2 * u][qs][0], s[2 * u][qs][1]);
          pk.y = pack2(s[2 * u][qs][2], s[2 * u][qs][3]);
          pk.z = pack2(s[2 * u + 1][qs][0], s[2 * u + 1][qs][1]);
          pk.w = pack2(s[2 * u + 1][qs][2], s[2 * u + 1][qs][3]);
          pf[qs][u] = *(bf16x8*)&pk;
        }
#pragma unroll
      for (int u = 0; u < 2; ++u) {
#pragma unroll
        for (int ds = 0; ds < NDS; ++ds) {
          const u16* vp = Vs + (ds * 16 + fr) * VST + u * 32 + fq * 4;
          uint2 lo = *(const uint2*)vp, hi = *(const uint2*)(vp + 16);
          uint4 vv = make_uint4(lo.x, lo.y, hi.x, hi.y);
          bf16x8 vf = *(bf16x8*)&vv;
          o[ds][0] = mfma16(vf, pf[0][u], o[ds][0]);
          o[ds][1] = mfma16(vf, pf[1][u], o[ds][1]);
        }
      }
    }
    if (MODE == 2 && active) {
#pragma unroll
      for (int qs = 0; qs < 2; ++qs) {
        f32x4 s1[4];
#pragma unroll
        for (int ks = 0; ks < 4; ++ks) s1[ks] = f32x4{0.f, 0.f, 0.f, 0.f};
#pragma unroll
        for (int st = 0; st < NST; ++st) {
#pragma unroll
          for (int ks = 0; ks < 4; ++ks) {
            bf16x8 kf = *(const bf16x8*)((const char*)Ks + st * 4096 + (ks * 16 + fr) * 64 + fqs);
            s1[ks] = mfma16(kf, qf[qs][st], s1[ks]);
          }
        }
        const int tq = q0 + w * 32 + qs * 16 + fr;
        float running = lrow[qs];
#pragma unroll
        for (int ks = 3; ks >= 0; --ks) {
          float l1[4], lb[4];
#pragma unroll
          for (int j = 0; j < 4; ++j) {
            const float z = s1[ks][j] * zscale;
            const float e = __expf(-fabsf(z));
            const float sp = fmaxf(z, 0.f) + __logf(1.f + e);
            const int key = t * 64 + ks * 16 + fq * 4 + j;
            l1[j] = (key < tq) ? -sp : 0.f;
            lb[j] = z - sp;
          }
          const float p4 = (l1[0] + l1[1]) + (l1[2] + l1[3]);
          const float x16 = __shfl_xor(p4, 16);
          const float a2 = p4 + x16;
          const float x32 = __shfl_xor(a2, 32);
          const float tot = a2 + x32;
          const float gt = ((fq & 1) == 0 ? x16 : 0.f) + ((fq & 2) == 0 ? x32 : 0.f);
          const float s3 = running + gt;
          const float s2 = s3 + l1[3];
          const float s1_ = s2 + l1[2];
          const float s0 = s1_ + l1[1];
          s1[ks][0] = (l1[0] < 0.f) ? __expf(lb[0] + s0) : 0.f;
          s1[ks][1] = (l1[1] < 0.f) ? __expf(lb[1] + s1_) : 0.f;
          s1[ks][2] = (l1[2] < 0.f) ? __expf(lb[2] + s2) : 0.f;
          s1[ks][3] = (l1[3] < 0.f) ? __expf(lb[3] + s3) : 0.f;
          running += tot;
        }
        lrow[qs] = running;
        if (qs == 0) {
          __builtin_amdgcn_sched_barrier(0);
          if (more) load_v(tn);
          __builtin_amdgcn_sched_barrier(0);
        }
#pragma unroll
        for (int u = 0; u < 2; ++u) {
          uint4 pk;
          pk.x = pack2(s1[2 * u][0], s1[2 * u][1]);
          pk.y = pack2(s1[2 * u][2], s1[2 * u][3]);
          pk.z = pack2(s1[2 * u + 1][0], s1[2 * u + 1][1]);
          pk.w = pack2(s1[2 * u + 1][2], s1[2 * u + 1][3]);
          bf16x8 pf1 = *(bf16x8*)&pk;
#pragma unroll
          for (int ds = 0; ds < NDS; ++ds) {
            const u16* vp = Vs + (ds * 16 + fr) * VST + u * 32 + fq * 4;
            uint2 lo = *(const uint2*)vp, hi = *(const uint2*)(vp + 16);
            uint4 vv = make_uint4(lo.x, lo.y, hi.x, hi.y);
            bf16x8 vf = *(bf16x8*)&vv;
            o[ds][qs] = mfma16(vf, pf1, o[ds][qs]);
          }
        }
        __builtin_amdgcn_sched_barrier(0);
      }
    }
    if (!active && more) { if (MODE != 2) load_k(tn); load_v(tn); }
    if (MODE == 2) {
      const int cont = (more && (lrow[0] >= -104.f || lrow[1] >= -104.f)) ? 1 : 0;
      if (!__syncthreads_or(cont)) break;
    } else {
      __syncthreads();
      if (!more) break;
    }
    t = tn;
  }
  int fr_e = fr, fq_e = fq;
  asm volatile("" : "+v"(fr_e), "+v"(fq_e));
#pragma unroll
  for (int qs = 0; qs < 2; ++qs) {
    float inv = 1.f;
    if (MODE != 2) {
      float lsum = lrow[qs];
      lsum += __shfl_xor(lsum, 16);
      lsum += __shfl_xor(lsum, 32);
      inv = 1.f / lsum;
    }
    const int row = w * 32 + qs * 16 + fr_e;
#pragma unroll
    for (int ds = 0; ds < NDS; ++ds) {
      const int dv = ds * 16 + fq_e * 4;
      uint2 g2 = *(const uint2*)(gate + (unsigned)(row * DIN + dv));
      float v0 = o[ds][qs][0] * inv * bflo(g2.x), v1 = o[ds][qs][1] * inv * bfhi(g2.x);
      float v2 = o[ds][qs][2] * inv * bflo(g2.y), v3 = o[ds][qs][3] * inv * bfhi(g2.y);
      *(uint2*)(outp + (unsigned)(row * DM + dv)) = make_uint2(pack2(v0, v1), pack2(v2, v3));
    }
  }
}

#undef KLOAD
#undef KSTORE
#undef VLOAD
#undef VSTORE
#undef load_k
#undef load_v
#undef store_tile

__device__ void gmlp_item(const Params& p, int l, int n, int g, char* smem) {
  constexpr int WST = 136;
  u16* Ws = (u16*)smem;
  u16* Bs = Ws + 128 * WST;
  float* s_mu = (float*)(Bs + 128 * WST);
  float* s_rs = s_mu + 128;
  int tid = threadIdx.x;
  asm volatile("" : "+v"(tid));
  const int w = __builtin_amdgcn_readfirstlane(tid >> 6), lane = tid & 63, fr = lane & 15, fq = lane >> 4;
  const int row0 = n * 128;
  {
    const int r = tid >> 1, half = tid & 1;
    const u16* src = p.h() + (size_t)(row0 + r) * DIN + C_SGV + half * 256;
    float s = 0.f, q = 0.f;
#pragma unroll 4
    for (int i = 0; i < 32; ++i) {
      uint4 v = *(const uint4*)(src + i * 8);
      const unsigned ww[4] = {v.x, v.y, v.z, v.w};
#pragma unroll
      for (int k = 0; k < 4; ++k) { float a = bflo(ww[k]), b = bfhi(ww[k]); s += a + b; q += a * a + b * b; }
    }
    s += __shfl_xor(s, 1);
    q += __shfl_xor(q, 1);
    const float mu = s * (1.f / 512.f);
    const float var = fmaxf(q * (1.f / 512.f) - mu * mu, 0.f);
    if (half == 0) { s_mu[r] = mu; s_rs[r] = rsqrtf(var + 1e-5f); }
  }
  {
    const float* wsrc = p.sg_w + (size_t)(l * 4 + g) * 128 * 128;
#pragma unroll 4
    for (int i = 0; i < 16; ++i) {
      int id = tid + 256 * i, tt = id >> 5, s4 = (id & 31) * 4;
      float4 v = *(const float4*)(wsrc + tt * 128 + s4);
      if (tt < 64 && s4 >= 64) v = make_float4(0.f, 0.f, 0.f, 0.f);
      *(uint2*)(Ws + tt * WST + s4) = make_uint2(pack2(v.x, v.y), pack2(v.z, v.w));
    }
  }
  __syncthreads();
  {
    const int c = tid & 127, sh = tid >> 7;
    const float lg = p.sg_ln_g[(size_t)l * 512 + g * 128 + c], lbv = p.sg_ln_b[(size_t)l * 512 + g * 128 + c];
    const u16* src = p.h() + (size_t)row0 * DIN + C_SGV + g * 128 + c;
#pragma unroll 2
    for (int s8 = 0; s8 < 8; ++s8) {
      const int so = (sh * 8 + s8) * 8;
      float v[8];
#pragma unroll
      for (int jj = 0; jj < 8; ++jj) {
        const int s = so + jj;
        v[jj] = (bf2f(src[(size_t)s * DIN]) - s_mu[s]) * s_rs[s] * lg + lbv;
      }
      *(uint4*)(Bs + c * WST + so) = make_uint4(pack2(v[0], v[1]), pack2(v[2], v[3]), pack2(v[4], v[5]), pack2(v[6], v[7]));
    }
  }
  __syncthreads();
  f32x4 acc[2][8];
#pragma unroll
  for (int mt = 0; mt < 2; ++mt)
#pragma unroll
    for (int ns = 0; ns < 8; ++ns) acc[mt][ns] = f32x4{0.f, 0.f, 0.f, 0.f};
#pragma unroll
  for (int st = 0; st < 4; ++st) {
    bf16x8 wf[2];
#pragma unroll
    for (int mt = 0; mt < 2; ++mt) wf[mt] = *(const bf16x8*)(Ws + (w * 32 + mt * 16 + fr) * WST + st * 32 + fq * 8);
#pragma unroll
    for (int ns = 0; ns < 8; ++ns) {
      bf16x8 bfv = *(const bf16x8*)(Bs + (ns * 16 + fr) * WST + st * 32 + fq * 8);
      acc[0][ns] = mfma16(bfv, wf[0], acc[0][ns]);
      acc[1][ns] = mfma16(bfv, wf[1], acc[1][ns]);
    }
  }
#pragma unroll
  for (int mt = 0; mt < 2; ++mt) {
    const int tt = w * 32 + mt * 16 + fr;
    const float bias = p.sg_b[(size_t)(l * 4 + g) * 128 + tt];
    const u16* hrow = p.h() + (size_t)(row0 + tt) * DIN;
#pragma unroll
    for (int ns = 0; ns < 8; ++ns) {
      const int c = g * 128 + ns * 16 + fq * 4;
      uint2 u2 = *(const uint2*)(hrow + C_SGU + c);
      uint2 g2 = *(const uint2*)(hrow + C_GB + c);
      float v0 = bflo(u2.x) * (acc[mt][ns][0] + bias) * bflo(g2.x);
      float v1 = bfhi(u2.x) * (acc[mt][ns][1] + bias) * bfhi(g2.x);
      float v2 = bflo(u2.y) * (acc[mt][ns][2] + bias) * bflo(g2.y);
      float v3 = bfhi(u2.y) * (acc[mt][ns][3] + bias) * bfhi(g2.y);
      *(uint2*)(p.yin() + (size_t)(row0 + tt) * DM + 768 + c) = make_uint2(pack2(v0, v1), pack2(v2, v3));
    }
  }
  __syncthreads();
}

__device__ void phaseC(const Params& p, int l, int ci, char* smem) {
  volatile int* ctl = (volatile int*)(smem + CTL_OFF);
  const int tid = threadIdx.x;
  constexpr int N_MLA = 384, N_SB = 256, N_MEM = 256, N_G = 256;
  constexpr int N_ALL = N_MLA + N_SB + N_MEM + N_G;
  while (true) {
    __syncthreads();
    if (tid == 0) ctl[0] = (int)atomicAdd(&p.ctr()[ci], 1u);
    __syncthreads();
    const int item = __builtin_amdgcn_readfirstlane(ctl[0]);
    if (item >= N_ALL) break;
    if (item < N_MLA) {
      const int qb = 63 - item / 6, hd = item % 6, q0 = qb * 128;
      attn_item<192, 128, 0>(p.q() + ((size_t)hd * SEQ + q0) * 192, 192, p.k() + (size_t)hd * SEQ * 192, 192,
                             p.vt() + (size_t)hd * 128 * SEQ, SEQ, 2 * qb + 1, 1.0f, q0,
                             p.h() + (size_t)q0 * DIN + C_GA + hd * 128, p.yin() + (size_t)q0 * DM + hd * 128, smem);
    } else if (item < N_MLA + N_SB) {
      const int it = item - N_MLA, qb = it >> 2, hd = it & 3, q0 = qb * 128;
      attn_item<128, 128, 2>(p.h() + (size_t)q0 * DIN + C_SBQ + hd * 128, DIN, p.h() + C_SBK + hd * 128, DIN,
                             p.vtsb() + (size_t)hd * 128 * SEQ, SEQ, 2 * qb + 1, 0.08838834764831845f, q0,
                             p.h() + (size_t)q0 * DIN + C_GC + hd * 128, p.yin() + (size_t)q0 * DM + 1280 + hd * 128, smem);
    } else if (item < N_MLA + N_SB + N_MEM) {
      const int it = item - N_MLA - N_SB, qb = it >> 2, hd = it & 3, q0 = qb * 128;
      attn_item<64, 64, 1>(p.h() + (size_t)q0 * DIN + C_MQ + hd * 64, DIN, p.mk() + (size_t)(l * 4 + hd) * 256 * 64, 64,
                           p.mvt() + (size_t)(l * 4 + hd) * 64 * 256, 256, 3, 0.125f * 1.4426950408889634f, q0,
                           p.h() + (size_t)q0 * DIN + C_GM + hd * 64, p.yin() + (size_t)q0 * DM + 1792 + hd * 64, smem);
    } else {
      const int it = item - N_MLA - N_SB - N_MEM;
      gmlp_item(p, l, it >> 2, it & 3, smem);
    }
  }
}

__global__ void __launch_bounds__(256, 2) fwd_megakernel(Params p) {
  extern __shared__ __attribute__((aligned(16))) char smem[];
  volatile LAS unsigned* xst = (volatile LAS unsigned*)(smem + CTL_OFF + 16);
  if (threadIdx.x == 0) { xst[0] = 0u; xst[1] = 0u; }
  __syncthreads();
  const XcdBarrier xb = xcd_barrier_post(p.bar(), xst);
#define grid_barrier() xcd_barrier(xb)
  phase_prep(p, smem);
  if (PROBE_DUP == 1) { grid_barrier(); phase_prep(p, smem); }
  cg::this_grid().sync();
  for (int l = 0; l < NL; ++l) {
    for (int rep = 0; rep < (PROBE_DUP == 2 ? 2 : 1); ++rep) {
      for (int t = blockIdx.x; t < 6 * 512; t += gridDim.x) {
        int tm, tn;
        if (tile_map(t, 45, tm, tn)) phaseA_tile(p, l, tm, tn, smem);
      }
      if (PROBE_DUP == 2 && rep == 0) grid_barrier();
    }
    if (l == 0) {
      for (int t = blockIdx.x; t < NL * 8; t += gridDim.x) memkv_tile(p, t >> 3, (t >> 2) & 1, t & 3, smem);
    }
    grid_barrier();
    for (int rep = 0; rep < (PROBE_DUP == 3 ? 2 : 1); ++rep) {
      for (int t = blockIdx.x; t < 3 * 512; t += gridDim.x) {
        int tm, tn;
        if (tile_map(t, 21, tm, tn)) phaseB_tile(p, l, tm, tn, smem);
      }
      if (PROBE_DUP == 3 && rep == 0) grid_barrier();
    }
    grid_barrier();
    phaseC(p, l, l, smem);
    if (PROBE_DUP == 4) { grid_barrier(); phaseC(p, l, l + 4, smem); }
    grid_barrier();
    for (int t = blockIdx.x; t < 2 * 512; t += gridDim.x) {
      int tm, tn;
      if (tile_map(t, 16, tm, tn)) phaseD_tile(p, l, tm, tn, smem);
    }
    grid_barrier();
    phaseE(p, l);
    if (l + 1 < NL) grid_barrier();
  }
}

extern "C" void kernel_launch(void* const* d_in, const int* in_sizes, int n_in, void* d_out, int out_size, void* d_ws,
                              size_t ws_size, hipStream_t stream) {
  static int grid_blocks = 0;
  if (!grid_blocks) {
    int dev = 0, cus = 0, per_cu = 0;
    hipGetDevice(&dev);
    hipDeviceGetAttribute(&cus, hipDeviceAttributeMultiprocessorCount, dev);
    hipFuncSetAttribute((const void*)fwd_megakernel, hipFuncAttributeMaxDynamicSharedMemorySize, LDS_BYTES);
    hipOccupancyMaxActiveBlocksPerMultiprocessor(&per_cu, fwd_megakernel, 256, LDS_BYTES);
    if (per_cu > 2) per_cu = 2;
    if (per_cu < 1) per_cu = 1;
    grid_blocks = cus * per_cu;
  }
  Params p{};
  p.x = (const float*)d_in[0]; p.mem = (const float*)d_in[1]; p.pos = (const int*)d_in[2]; p.w_in = (const float*)d_in[3];
  p.q_norm_g = (const float*)d_in[4]; p.w_uq = (const float*)d_in[5]; p.kv_norm_g = (const float*)d_in[6];
  p.w_ukv = (const float*)d_in[7]; p.sg_ln_g = (const float*)d_in[8]; p.sg_ln_b = (const float*)d_in[9];
  p.sg_w = (const float*)d_in[10]; p.sg_b = (const float*)d_in[11]; p.w_mem_k = (const float*)d_in[12];
  p.w_mem_v = (const float*)d_in[13]; p.w_out = (const float*)d_in[14]; p.ln_g = (const float*)d_in[15];
  p.ln_b = (const float*)d_in[16];
  p.out = (float*)d_out;
  p.ws = (char*)d_ws;
  hipMemsetAsync(p.ws + OFF_BAR, 0, 16384, stream);
  void* args[] = {&p};
  hipError_t e = hipLaunchCooperativeKernel((const void*)fwd_megakernel, dim3(grid_blocks), dim3(256), args, LDS_BYTES, stream);
  if (e != hipSuccess) fprintf(stderr, "cooperative launch failed: %s (grid %d)\n", hipGetErrorString(e), grid_blocks);
}
```

```cpp
#include <hip/hip_runtime.h>
#include <hip/hip_cooperative_groups.h>
#include <cstdio>
namespace cg = cooperative_groups;

typedef unsigned short u16;
using bf16x8 = __attribute__((ext_vector_type(8))) short;
using f32x4 = __attribute__((ext_vector_type(4))) float;
typedef __bf16 bf16x2_t __attribute__((ext_vector_type(2)));
typedef float f32x2_t __attribute__((ext_vector_type(2)));

#define SEQ 8192
#define DM 2048
#define DIN 5696
#define DINP 5888
#define UQP 1280
#define NL 4
#define NT 512

constexpr int GEMM_LDS = 131072;
constexpr int CTL_OFF = GEMM_LDS;
constexpr int LDS_BYTES = GEMM_LDS + 256;

constexpr int C_CQ = 0, C_CKV = 512, C_KPE = 768, C_GA = 832, C_SGU = 1600, C_SGV = 2112, C_GB = 2624,
              C_SBQ = 3136, C_SBK = 3648, C_SBV = 4160, C_GC = 4672, C_MQ = 5184, C_GM = 5440;

constexpr size_t al256(size_t x) { return (x + 255) & ~(size_t)255; }
constexpr size_t OFF_BAR = 0;
constexpr size_t OFF_CTR = OFF_BAR + al256(16384);
constexpr size_t OFF_SSQ = OFF_CTR + al256(256);
constexpr size_t OFF_WT_IN = OFF_SSQ + al256((size_t)2 * SEQ * 4);
constexpr size_t OFF_WT_OUT = OFF_WT_IN + al256((size_t)NL * DINP * DM * 2);
constexpr size_t OFF_WT_UQ = OFF_WT_OUT + al256((size_t)NL * DM * DM * 2);
constexpr size_t OFF_WT_UKV = OFF_WT_UQ + al256((size_t)NL * UQP * 512 * 2);
constexpr size_t OFF_WT_MEMKV = OFF_WT_UKV + al256((size_t)NL * 1536 * 256 * 2);
constexpr size_t OFF_MEMB = OFF_WT_MEMKV + al256((size_t)NL * 512 * DM * 2);
constexpr size_t OFF_XB = OFF_MEMB + al256((size_t)256 * DM * 2);
constexpr size_t OFF_H = OFF_XB + al256((size_t)SEQ * DM * 2);
constexpr size_t OFF_Q = OFF_H + al256((size_t)SEQ * DIN * 2);
constexpr size_t OFF_K = OFF_Q + al256((size_t)6 * SEQ * 192 * 2);
constexpr size_t OFF_VT = OFF_K + al256((size_t)6 * SEQ * 192 * 2);
constexpr size_t OFF_VTSB = OFF_VT + al256((size_t)6 * 128 * SEQ * 2);
constexpr size_t OFF_YIN = OFF_VTSB + al256((size_t)4 * 128 * SEQ * 2);
constexpr size_t OFF_MK = OFF_YIN + al256((size_t)SEQ * DM * 2);
constexpr size_t OFF_MVT = OFF_MK + al256((size_t)NL * 4 * 256 * 64 * 2);
constexpr size_t OFF_COST = OFF_MVT + al256((size_t)NL * 4 * 64 * 256 * 2);
constexpr size_t OFF_SINT = OFF_COST + al256((size_t)SEQ * 32 * 4);
constexpr size_t WS_TOTAL = OFF_SINT + al256((size_t)SEQ * 32 * 4);
struct Params {
  const float* x; const float* mem; const int* pos; const float* w_in; const float* q_norm_g; const float* w_uq;
  const float* kv_norm_g; const float* w_ukv; const float* sg_ln_g; const float* sg_ln_b; const float* sg_w; const float* sg_b;
  const float* w_mem_k; const float* w_mem_v; const float* w_out; const float* ln_g; const float* ln_b;
  float* out;
  char* ws;
  __device__ __forceinline__ unsigned* bar() const { return (unsigned*)(ws + OFF_BAR); }
  __device__ __forceinline__ unsigned* ctr() const { return (unsigned*)(ws + OFF_CTR); }
  __device__ __forceinline__ float* ssq() const { return (float*)(ws + OFF_SSQ); }
  __device__ __forceinline__ u16* wt_in() const { return (u16*)(ws + OFF_WT_IN); }
  __device__ __forceinline__ u16* wt_out() const { return (u16*)(ws + OFF_WT_OUT); }
  __device__ __forceinline__ u16* wt_uq() const { return (u16*)(ws + OFF_WT_UQ); }
  __device__ __forceinline__ u16* wt_ukv() const { return (u16*)(ws + OFF_WT_UKV); }
  __device__ __forceinline__ u16* wt_memkv() const { return (u16*)(ws + OFF_WT_MEMKV); }
  __device__ __forceinline__ u16* memb() const { return (u16*)(ws + OFF_MEMB); }
  __device__ __forceinline__ u16* xb() const { return (u16*)(ws + OFF_XB); }
  __device__ __forceinline__ u16* h() const { return (u16*)(ws + OFF_H); }
  __device__ __forceinline__ u16* q() const { return (u16*)(ws + OFF_Q); }
  __device__ __forceinline__ u16* k() const { return (u16*)(ws + OFF_K); }
  __device__ __forceinline__ u16* vt() const { return (u16*)(ws + OFF_VT); }
  __device__ __forceinline__ u16* vtsb() const { return (u16*)(ws + OFF_VTSB); }
  __device__ __forceinline__ u16* yin() const { return (u16*)(ws + OFF_YIN); }
  __device__ __forceinline__ u16* mk() const { return (u16*)(ws + OFF_MK); }
  __device__ __forceinline__ u16* mvt() const { return (u16*)(ws + OFF_MVT); }
  __device__ __forceinline__ float* cosT() const { return (float*)(ws + OFF_COST); }
  __device__ __forceinline__ float* sinT() const { return (float*)(ws + OFF_SINT); }
};

__device__ __forceinline__ unsigned pack2(float a, float b) {
  f32x2_t v = {a, b};
  bf16x2_t r = __builtin_convertvector(v, bf16x2_t);
  return *(unsigned*)&r;
}
__device__ __forceinline__ u16 f2bf(float a) { return (u16)(pack2(a, 0.f) & 0xffffu); }
__device__ __forceinline__ float bflo(unsigned w) { return __uint_as_float(w << 16); }
__device__ __forceinline__ float bfhi(unsigned w) { return __uint_as_float(w & 0xffff0000u); }
__device__ __forceinline__ float bf2f(u16 h) { return __uint_as_float(((unsigned)h) << 16); }
__device__ __forceinline__ float silu_f(float x) { return x / (1.f + __expf(-x)); }
__device__ __forceinline__ float gelu_f(float x) {
  float u = 0.7978845608028654f * (x + 0.044715f * x * x * x);
  float t = 1.f - 2.f / (__expf(2.f * u) + 1.f);
  return 0.5f * x * (1.f + t);
}
__device__ __forceinline__ f32x4 mfma16(bf16x8 a, bf16x8 b, f32x4 c) {
  return __builtin_amdgcn_mfma_f32_16x16x32_bf16(a, b, c, 0, 0, 0);
}
__device__ __forceinline__ int tid_of(int wv) {
  int lane;
  asm volatile("v_mbcnt_lo_u32_b32 %0, -1, 0\n\tv_mbcnt_hi_u32_b32 %0, -1, %0" : "=v"(lane));
  return wv * 64 + lane;
}

#define XB_TMO      128
#define XB_XCNT(j)  (256  + 64 * (j))
#define XB_XSUB(j)  (1280 + 64 * (j))
#define XB_XGEN(j)  (2304 + 64 * (j))
#define XB_TOP      3328
#define XB_TOPGEN   3392
#define XCD_BAR_WORDS 3456
#define XB_SPIN_CAP (1u << 22)
#define LAS __attribute__((address_space(3)))
__device__ __forceinline__ unsigned xb_ld(unsigned* p) { return __hip_atomic_load(p, __ATOMIC_RELAXED, __HIP_MEMORY_SCOPE_AGENT); }
__device__ __forceinline__ unsigned xb_add(unsigned* p, unsigned v) { return __hip_atomic_fetch_add(p, v, __ATOMIC_RELAXED, __HIP_MEMORY_SCOPE_AGENT); }
__device__ __forceinline__ unsigned xb_xcc_id() { return (unsigned)__builtin_amdgcn_s_getreg((3 << 11) | 20) & 0xFu; }
#define XB_SPIN(cond, bar) do { unsigned _sp = 0; while (cond) { __builtin_amdgcn_s_sleep(1); \
    if ((++_sp & 255u) == 0u) { if (xb_ld(&(bar)[XB_TMO])) break; if (_sp > XB_SPIN_CAP) { atomicAdd(&(bar)[XB_TMO], 1u); break; } } } } while (0)
struct XcdBarrier { unsigned* bar; unsigned x; volatile LAS unsigned* st; };
__device__ __forceinline__ XcdBarrier xcd_barrier_post(unsigned* bar, volatile LAS unsigned* st, int wv) {
  XcdBarrier b; b.bar = bar; b.x = xb_xcc_id(); b.st = st;
  if (tid_of(wv) == 0) (void)xb_add(&bar[XB_XCNT(b.x)], 1u);
  return b;
}
__device__ __forceinline__ void xcd_barrier_complete(unsigned* bar, unsigned x, unsigned& nloc, unsigned& nx) {
  const unsigned G = gridDim.x * gridDim.y * gridDim.z;
  unsigned sum, cnt, mine, sp = 0u;
  for (;;) {
    sum = 0u; cnt = 0u; mine = 0u;
#pragma unroll
    for (unsigned j = 0; j < 16; ++j) { const unsigned c = xb_ld(&bar[XB_XCNT(j)]); sum += c; cnt += (c > 0u) ? 1u : 0u; mine = (j == x) ? c : mine; }
    if (sum == G) break;
    __builtin_amdgcn_s_sleep(1);
    if ((++sp & 255u) == 0u) { if (xb_ld(&bar[XB_TMO])) break; if (sp > XB_SPIN_CAP) { atomicAdd(&bar[XB_TMO], 1u); break; } }
  }
  nloc = mine > 0u ? mine : 1u; nx = cnt > 0u ? cnt : 1u;
}
__device__ __forceinline__ void xcd_barrier(const XcdBarrier& b, int wv) {
  asm volatile("s_waitcnt vmcnt(0)" ::: "memory");
  __syncthreads();
  if (tid_of(wv) == 0) {
    unsigned* bar = b.bar;
    __builtin_amdgcn_s_waitcnt(0);
    unsigned nloc = b.st[0], nx = b.st[1];
    if (nloc == 0u) { xcd_barrier_complete(bar, b.x, nloc, nx); b.st[0] = nloc; b.st[1] = nx; }
    const unsigned old = xb_add(&bar[XB_XSUB(b.x)], 1u);
    const unsigned gen = old / nloc;
    if (old + 1u == (gen + 1u) * nloc) {
      __builtin_amdgcn_fence(__ATOMIC_RELEASE, "agent");
      asm volatile("s_waitcnt vmcnt(0)" ::: "memory");
      const unsigned og = xb_add(&bar[XB_TOP], 1u);
      const unsigned tg = og / nx;
      if (og + 1u == (tg + 1u) * nx) xb_add(&bar[XB_TOPGEN], 1u);
      else XB_SPIN(xb_ld(&bar[XB_TOPGEN]) == tg, bar);
      __builtin_amdgcn_fence(__ATOMIC_ACQUIRE, "agent");
      xb_add(&bar[XB_XGEN(b.x)], 1u);
      asm volatile("s_waitcnt vmcnt(0)" ::: "memory");
    } else {
      XB_SPIN(xb_ld(&bar[XB_XGEN(b.x)]) == gen, bar);
      __builtin_amdgcn_fence(__ATOMIC_ACQUIRE, "agent");
      asm volatile("s_waitcnt vmcnt(0)" ::: "memory");
    }
  }
  __syncthreads();
}

__device__ __forceinline__ int perm64(int g) { return ((g >> 4) & 1) * 32 + (g >> 5) * 16 + (g & 15); }

__device__ void tconv_all(const float* src, u16* dst, int K, int N, int Npad, size_t srcLS, size_t dstLS, int dstRowOff,
                          const float* g, int gS, int permMode, float* lds0, int wv) {
  const int tid = tid_of(wv);
  const int half = tid >> 8, ht = tid & 255;
  float* lds = lds0 + half * (64 * 65);
  const int nkt = K / 64, nnt = Npad / 64, per = nkt * nnt, total = NL * per;
  for (int t0 = blockIdx.x * 2; t0 < total; t0 += gridDim.x * 2) {
    const int t = t0 + half;
    const bool ok = t < total;
    const int l = t / per, r = t % per, kt = r / nnt, nt = r % nnt;
    const int k0 = kt * 64, n0 = nt * 64;
    const float* sp = src + (size_t)l * srcLS;
    u16* dp = dst + (size_t)l * dstLS + (size_t)dstRowOff * K;
    const float* gp = g ? g + (size_t)l * gS : nullptr;
    if (ok) {
#pragma unroll
      for (int i = 0; i < 4; ++i) {
        int rr = (ht >> 4) + 16 * i, c = (ht & 15) * 4;
        float4 v = make_float4(0.f, 0.f, 0.f, 0.f);
        if (n0 + c < N) v = *(const float4*)(sp + (size_t)(k0 + rr) * N + n0 + c);
        if (gp) { float sc = gp[k0 + rr]; v.x *= sc; v.y *= sc; v.z *= sc; v.w *= sc; }
        float* pp = lds + rr * 65 + c;
        pp[0] = v.x; pp[1] = v.y; pp[2] = v.z; pp[3] = v.w;
      }
    }
    __syncthreads();
    if (ok) {
      const bool perm = (permMode == 1) ? (n0 == C_KPE) : (permMode == 2) ? ((n0 % 192) == 128 && n0 < 1152) : false;
#pragma unroll
      for (int i = 0; i < 2; ++i) {
        int id = ht + 256 * i, n = id >> 3, kc = (id & 7) * 8;
        const int ns = perm ? perm64(n) : n;
        unsigned w0 = pack2(lds[(kc + 0) * 65 + ns], lds[(kc + 1) * 65 + ns]);
        unsigned w1 = pack2(lds[(kc + 2) * 65 + ns], lds[(kc + 3) * 65 + ns]);
        unsigned w2 = pack2(lds[(kc + 4) * 65 + ns], lds[(kc + 5) * 65 + ns]);
        unsigned w3 = pack2(lds[(kc + 6) * 65 + ns], lds[(kc + 7) * 65 + ns]);
        *(uint4*)(dp + (size_t)(n0 + n) * K + k0 + kc) = make_uint4(w0, w1, w2, w3);
      }
    }
    __syncthreads();
  }
}

__device__ void phase_prep(const Params& p, char* smem, int wv) {
  float* lds = (float*)smem;
  const int tid = tid_of(wv);
  const size_t gtid = (size_t)blockIdx.x * NT + tid, gsz = (size_t)gridDim.x * NT;
  if (blockIdx.x == 0 && tid < 64) p.ctr()[tid] = 0u;
  for (size_t c = gtid; c < (size_t)2 * SEQ; c += gsz) p.ssq()[c] = 0.f;
  for (size_t c = gtid; c < (size_t)SEQ * DM / 8; c += gsz) {
    float4 a = *(const float4*)(p.x + c * 8), b = *(const float4*)(p.x + c * 8 + 4);
    *(uint4*)(p.xb() + c * 8) = make_uint4(pack2(a.x, a.y), pack2(a.z, a.w), pack2(b.x, b.y), pack2(b.z, b.w));
  }
  for (size_t c = gtid; c < (size_t)256 * DM / 8; c += gsz) {
    float4 a = *(const float4*)(p.mem + c * 8), b = *(const float4*)(p.mem + c * 8 + 4);
    *(uint4*)(p.memb() + c * 8) = make_uint4(pack2(a.x, a.y), pack2(a.z, a.w), pack2(b.x, b.y), pack2(b.z, b.w));
  }
  for (size_t e = gtid; e < (size_t)SEQ * 32; e += gsz) {
    int s = (int)(e >> 5), i = (int)(e & 31);
    float invf = __builtin_amdgcn_exp2f(-(float)i * (13.287712379549449f / 32.0f));
    float ang = (float)p.pos[s] * invf;
    double rev = (double)ang * 0.15915494309189535;
    float fr = (float)(rev - floor(rev));
    p.cosT()[e] = __builtin_amdgcn_cosf(fr);
    p.sinT()[e] = __builtin_amdgcn_sinf(fr);
  }
  tconv_all(p.w_in, p.wt_in(), DM, DIN, DINP, (size_t)DM * DIN, (size_t)DINP * DM, 0, nullptr, 0, 1, lds, wv);
  tconv_all(p.w_out, p.wt_out(), DM, DM, DM, (size_t)DM * DM, (size_t)DM * DM, 0, nullptr, 0, 0, lds, wv);
  tconv_all(p.w_uq, p.wt_uq(), 512, 1152, UQP, (size_t)512 * 1152, (size_t)UQP * 512, 0, p.q_norm_g, 512, 2, lds, wv);
  tconv_all(p.w_ukv, p.wt_ukv(), 256, 1536, 1536, (size_t)256 * 1536, (size_t)1536 * 256, 0, p.kv_norm_g, 256, 0, lds, wv);
  tconv_all(p.w_mem_k, p.wt_memkv(), DM, 256, 256, (size_t)DM * 256, (size_t)512 * DM, 0, nullptr, 0, 0, lds, wv);
  tconv_all(p.w_mem_v, p.wt_memkv(), DM, 256, 256, (size_t)DM * 256, (size_t)512 * DM, 256, nullptr, 0, 0, lds, wv);
}

namespace pg8 {
constexpr int BM = 256, BK = 64, HALF = 128, HTB = HALF * BK * 2, NXCD = 8, WGM = 8;
__device__ __forceinline__ int lds_byte(int r, int c) { const int st = (r >> 4) * 2 + (c >> 5), rr = r & 15, cc = c & 31, ob = rr * 64 + cc * 2; return st * 1024 + (ob ^ (((ob >> 9) & 1) << 5)); }
__device__ __forceinline__ void stage_rc(int b, int& R, int& C) { const int st = b / 1024, sb = b % 1024, swz = sb ^ (((sb >> 9) & 1) << 5); R = (st >> 1) * 16 + swz / 64; C = (st & 1) * 32 + (swz % 64) / 2; }
struct Unit { int pm, pn; };
struct Gemm { const u16* A; const u16* Bt; int lda, ldb, K; };
struct StaticOrder {
  int nM, nN, nwg, G, c;
  __device__ void init(int M, int N, int G_, int c_) { nM = M / BM; nN = N / BM; nwg = nM * nN; G = G_; c = c_; }
  __device__ bool next(int i, Unit& u) const {
    const long L = (long)i * G + c; if (L >= nwg) return false;
    int wgid = (int)L; { const int q = nwg / NXCD, r = nwg % NXCD, xcd = wgid % NXCD, off = wgid / NXCD; wgid = (xcd < r ? xcd * (q + 1) : r * (q + 1) + (xcd - r) * q) + off; }
    const int nig = WGM * nN, gid = wgid / nig, fm = gid * WGM, gsz = (nM - fm) < WGM ? (nM - fm) : WGM;
    u.pm = __builtin_amdgcn_readfirstlane(fm + ((wgid % nig) % gsz)); u.pn = __builtin_amdgcn_readfirstlane((wgid % nig) / gsz); return true;
  }
};
struct StrideOrder {
  int first, stride, count, limit;
  __device__ bool next(int i, Unit& u) const { const int x = first + i * stride; if (i >= count || x >= limit) return false; u.pm = x & 31; u.pn = x >> 5; return true; }
};

template <class Epi, class Sched>
__device__ __forceinline__ void gemm_phase(LAS unsigned char* lds, const Gemm g, const Sched& S, const Epi& E, int wv) {
  const int tid = tid_of(wv);
  const int wid = wv, lane = tid & 63, wr = wid >> 2, wc = wid & 3, fr = lane & 15, fq = lane >> 4;
  const int K = g.K, nt = K / BK;
  unsigned voffA[2], voffB[2];
#pragma unroll
  for (int i = 0; i < 2; ++i) { int R, C; stage_rc(tid * 16 + i * 8192, R, C);
    voffA[i] = (unsigned)(R * g.lda + C) * 2u; voffB[i] = (unsigned)(R * g.ldb + C) * 2u; }
  const size_t kstep = (size_t)(BK * 2);
  const size_t hstepA = (size_t)HALF * g.lda * 2, hstepB = (size_t)HALF * g.ldb * 2;
  const size_t tstepA = 2 * hstepA, tstepB = 2 * hstepB;
  const unsigned ldsw = (unsigned)wid * 1024u;
  const int aoff = lds_byte(wr * 64 + fr, fq * 8), boff = lds_byte(wc * 32 + fr, fq * 8);
#define PG8_SA(b, h) (((b) * 2 + (h)) * HTB)
#define PG8_SB(b, h) ((4 + (b) * 2 + (h)) * HTB)
#define PG8_STAGE(bufoff, gbase, voff) do { _Pragma("unroll") for (int _i = 0; _i < 2; ++_i) \
    __builtin_amdgcn_global_load_lds((const unsigned*)((const char*)(gbase) + (voff)[_i]), (LAS unsigned*)(lds + (bufoff) + ldsw + _i * 8192), 16, 0, 0); } while (0)
#define PG8_LDA(dst, b, h) do { _Pragma("unroll") for (int m = 0; m < 4; ++m) _Pragma("unroll") for (int k = 0; k < 2; ++k) dst[m][k] = *(const LAS bf16x8*)(lds + PG8_SA(b, h) + aoff + m * 2048 + k * 1024); } while (0)
#define PG8_LDB(dst, b, h) do { _Pragma("unroll") for (int n = 0; n < 2; ++n) _Pragma("unroll") for (int k = 0; k < 2; ++k) dst[n][k] = *(const LAS bf16x8*)(lds + PG8_SB(b, h) + boff + n * 2048 + k * 1024); } while (0)
#define PG8_MMA(ai, bj, At, Bt) do { __builtin_amdgcn_s_setprio(1); _Pragma("unroll") for (int m = 0; m < 4; ++m) _Pragma("unroll") for (int n = 0; n < 2; ++n) _Pragma("unroll") for (int k = 0; k < 2; ++k) \
    acc[ai][bj][m][n] = __builtin_amdgcn_mfma_f32_16x16x32_bf16(Bt[n][k], At[m][k], acc[ai][bj][m][n], 0, 0, 0); __builtin_amdgcn_s_setprio(0); } while (0)
#define PG8_WAIT_V(n) asm volatile("s_waitcnt vmcnt(" #n ")" ::: "memory")
#define PG8_WAIT_L(n) asm volatile("s_waitcnt lgkmcnt(" #n ")" ::: "memory")
#define PG8_BAR __builtin_amdgcn_s_barrier()
#define PG8_SCHED __builtin_amdgcn_sched_barrier(0)
  Unit cur, nxt; int ui = 0;
  if (!S.next(0, cur)) return;
  f32x4 acc[2][2][4][2];
#pragma unroll
  for (int a = 0; a < 2; ++a)
#pragma unroll
    for (int b = 0; b < 2; ++b)
#pragma unroll
      for (int m = 0; m < 4; ++m)
#pragma unroll
        for (int n = 0; n < 2; ++n) acc[a][b][m][n] = (f32x4){0.f, 0.f, 0.f, 0.f};
  bf16x8 At[4][2], B0[2][2], B1[2][2];
  const char* cA = (const char*)g.A + (size_t)cur.pm * tstepA; const char* cB = (const char*)g.Bt + (size_t)cur.pn * tstepB;
  PG8_STAGE(PG8_SB(0, 0), cB, voffB); PG8_STAGE(PG8_SA(0, 0), cA, voffA); PG8_STAGE(PG8_SB(0, 1), cB + hstepB, voffB); PG8_STAGE(PG8_SA(0, 1), cA + hstepA, voffA);
  if (wr == 1) PG8_BAR;
  PG8_WAIT_V(4); PG8_BAR;
  PG8_STAGE(PG8_SB(1, 0), cB + kstep, voffB); PG8_STAGE(PG8_SA(1, 0), cA + kstep, voffA); PG8_STAGE(PG8_SB(1, 1), cB + hstepB + kstep, voffB);
  PG8_WAIT_V(6); PG8_BAR;
  for (;;) {
    const bool has_next = S.next(ui + 1, nxt);
    const char* nA = has_next ? (const char*)g.A + (size_t)nxt.pm * tstepA : cA; const char* nB = has_next ? (const char*)g.Bt + (size_t)nxt.pn * tstepB : cB;
    for (int t = 0; t < nt; t += 2) {
      const bool last = (t == nt - 2);
      const char* a1 = cA + (size_t)(t + 1) * kstep;
      const char* a2 = last ? nA : cA + (size_t)(t + 2) * kstep; const char* b2 = last ? nB : cB + (size_t)(t + 2) * kstep;
      const char* a3 = a2 + kstep; const char* b3 = b2 + kstep;
      PG8_LDB(B0, 0, 0); PG8_SCHED; PG8_LDA(At, 0, 0); PG8_STAGE(PG8_SA(1, 1), a1 + hstepA, voffA);
      PG8_WAIT_L(8); PG8_BAR; PG8_WAIT_L(0); PG8_MMA(0, 0, At, B0); PG8_BAR; PG8_SCHED;
      PG8_LDB(B1, 0, 1); PG8_STAGE(PG8_SB(0, 0), b2, voffB);
      PG8_BAR; PG8_WAIT_L(0); PG8_MMA(0, 1, At, B1); PG8_BAR;
      PG8_LDA(At, 0, 1); PG8_STAGE(PG8_SA(0, 0), a2, voffA);
      PG8_BAR; PG8_WAIT_L(0); PG8_MMA(1, 0, At, B0); PG8_BAR; PG8_SCHED;
      PG8_STAGE(PG8_SB(0, 1), b2 + hstepB, voffB);
      PG8_WAIT_V(6); PG8_BAR; PG8_MMA(1, 1, At, B1); PG8_BAR;
      PG8_LDB(B0, 1, 0); PG8_SCHED; PG8_LDA(At, 1, 0); PG8_STAGE(PG8_SA(0, 1), a2 + hstepA, voffA);
      PG8_WAIT_L(8); PG8_BAR; PG8_WAIT_L(0); PG8_MMA(0, 0, At, B0); PG8_BAR; PG8_SCHED;
      PG8_LDB(B1, 1, 1); PG8_STAGE(PG8_SB(1, 0), b3, voffB);
      PG8_BAR; PG8_WAIT_L(0); PG8_MMA(0, 1, At, B1); PG8_BAR;
      PG8_LDA(At, 1, 1); PG8_STAGE(PG8_SA(1, 0), a3, voffA);
      PG8_BAR; PG8_WAIT_L(0); PG8_MMA(1, 0, At, B0); PG8_BAR; PG8_SCHED;
      PG8_STAGE(PG8_SB(1, 1), b3 + hstepB, voffB);
      PG8_WAIT_V(6); PG8_BAR; PG8_MMA(1, 1, At, B1); PG8_BAR;
    }
    E(acc, cur, wr, wc, fr, fq);
    if (!has_next) break;
#pragma unroll
    for (int a = 0; a < 2; ++a)
#pragma unroll
      for (int b = 0; b < 2; ++b)
#pragma unroll
        for (int m = 0; m < 4; ++m)
#pragma unroll
          for (int n = 0; n < 2; ++n) acc[a][b][m][n] = (f32x4){0.f, 0.f, 0.f, 0.f};
    cur = nxt; cA = nA; cB = nB; ++ui;
  }
  PG8_WAIT_V(0);
  if (wr == 0) PG8_BAR;
  PG8_BAR;
#undef PG8_SA
#undef PG8_SB
#undef PG8_STAGE
#undef PG8_LDA
#undef PG8_LDB
#undef PG8_MMA
#undef PG8_WAIT_V
#undef PG8_WAIT_L
#undef PG8_BAR
#undef PG8_SCHED
}
}

typedef const f32x4 (&AccRef)[2][2][4][2];

struct EpiA {
  Params p; int l;
  __device__ __forceinline__ void operator()(AccRef acc, const pg8::Unit& u, int wr, int wc, int fr_, int fq_) const {
    const int lane_ = tid_of(wr * 4 + wc) & 63, fr = lane_ & 15, fq = lane_ >> 4;
    const int rowb = u.pm * 256 + wr * 64 + fr;
#pragma unroll
    for (int bj = 0; bj < 2; ++bj) {
      const int cs = u.pn * 256 + bj * 128 + wc * 32;
      int kind;
      if (cs < C_KPE) kind = 0; else if (cs < C_GA) kind = 3; else if (cs < C_SGU) kind = 1;
      else if (cs < C_GB) kind = 2; else if (cs < C_SBQ) kind = 1; else if (cs < C_SBV) kind = 0;
      else if (cs < C_GC) kind = 4; else if (cs < C_MQ) kind = 1; else if (cs < C_GM) kind = 0;
      else if (cs < DIN) kind = 1; else kind = 5;
      if (kind == 5) continue;
      if (kind <= 2) {
#pragma unroll
        for (int ai = 0; ai < 2; ++ai)
#pragma unroll
          for (int m = 0; m < 4; ++m) {
            const int row = rowb + ai * 128 + m * 16;
#pragma unroll
            for (int n = 0; n < 2; ++n) {
              f32x4 v = acc[ai][bj][m][n];
              if (kind == 1) { v[0] = silu_f(v[0]); v[1] = silu_f(v[1]); v[2] = silu_f(v[2]); v[3] = silu_f(v[3]); }
              else if (kind == 2) { v[0] = gelu_f(v[0]); v[1] = gelu_f(v[1]); v[2] = gelu_f(v[2]); v[3] = gelu_f(v[3]); }
              *(uint2*)(p.h() + (size_t)row * DIN + cs + n * 16 + fq * 4) = make_uint2(pack2(v[0], v[1]), pack2(v[2], v[3]));
            }
          }
      } else if (kind == 3) {
        const int i0 = ((cs >> 5) & 1) * 16 + fq * 4;
#pragma unroll
        for (int ai = 0; ai < 2; ++ai)
#pragma unroll
          for (int m = 0; m < 4; ++m) {
            const int row = rowb + ai * 128 + m * 16;
            float4 cs4 = *(const float4*)(p.cosT() + (size_t)row * 32 + i0);
            float4 sn = *(const float4*)(p.sinT() + (size_t)row * 32 + i0);
            f32x4 x1 = acc[ai][bj][m][0], x2 = acc[ai][bj][m][1];
            float a0 = x1[0] * cs4.x - x2[0] * sn.x, a1 = x1[1] * cs4.y - x2[1] * sn.y, a2 = x1[2] * cs4.z - x2[2] * sn.z, a3 = x1[3] * cs4.w - x2[3] * sn.w;
            float b0 = x1[0] * sn.x + x2[0] * cs4.x, b1 = x1[1] * sn.y + x2[1] * cs4.y, b2 = x1[2] * sn.z + x2[2] * cs4.z, b3 = x1[3] * sn.w + x2[3] * cs4.w;
            uint2 ua = make_uint2(pack2(a0, a1), pack2(a2, a3)), ub = make_uint2(pack2(b0, b1), pack2(b2, b3));
#pragma unroll
            for (int hd = 0; hd < 6; ++hd) {
              u16* kp = p.k() + ((size_t)hd * SEQ + row) * 192 + 128 + i0;
              *(uint2*)kp = ua;
              *(uint2*)(kp + 32) = ub;
            }
          }
      } else {
#pragma unroll
        for (int ai = 0; ai < 2; ++ai)
#pragma unroll
          for (int m = 0; m < 4; ++m) {
            const int row = rowb + ai * 128 + m * 16;
#pragma unroll
            for (int n = 0; n < 2; ++n) {
              const int c = cs - C_SBV + n * 16 + fq * 4;
#pragma unroll
              for (int j = 0; j < 4; ++j) p.vtsb()[(size_t)(c + j) * SEQ + row] = f2bf(acc[ai][bj][m][n][j]);
            }
          }
      }
    }
    if (u.pn < 3) {
      float* sq = p.ssq() + (u.pn == 2 ? SEQ : 0);
#pragma unroll
      for (int ai = 0; ai < 2; ++ai)
#pragma unroll
        for (int m = 0; m < 4; ++m) {
          float v = 0.f;
#pragma unroll
          for (int bj = 0; bj < 2; ++bj)
#pragma unroll
            for (int n = 0; n < 2; ++n)
#pragma unroll
              for (int j = 0; j < 4; ++j) { float a = acc[ai][bj][m][n][j]; v += a * a; }
          v += __shfl_xor(v, 16);
          v += __shfl_xor(v, 32);
          if (fq == 0) atomicAdd(sq + rowb + ai * 128 + m * 16, v);
        }
    }
  }
};

struct EpiMem {
  Params p;
  __device__ __forceinline__ void operator()(AccRef acc, const pg8::Unit& u, int wr, int wc, int fr_, int fq_) const {
    const int lane_ = tid_of(wr * 4 + wc) & 63, fr = lane_ & 15, fq = lane_ >> 4;
    const int l = u.pn >> 1, isv = u.pn & 1;
    const int rowb = wr * 64 + fr;
#pragma unroll
    for (int bj = 0; bj < 2; ++bj)
#pragma unroll
      for (int ai = 0; ai < 2; ++ai)
#pragma unroll
        for (int m = 0; m < 4; ++m) {
          const int row = rowb + ai * 128 + m * 16;
#pragma unroll
          for (int n = 0; n < 2; ++n) {
            const int c = bj * 128 + wc * 32 + n * 16 + fq * 4, hd = c >> 6, e = c & 63;
            if (!isv) {
              *(uint2*)(p.mk() + ((size_t)(l * 4 + hd) * 256 + row) * 64 + e) =
                  make_uint2(pack2(acc[ai][bj][m][n][0], acc[ai][bj][m][n][1]), pack2(acc[ai][bj][m][n][2], acc[ai][bj][m][n][3]));
            } else {
#pragma unroll
              for (int j = 0; j < 4; ++j) p.mvt()[((size_t)(l * 4 + hd) * 64 + e + j) * 256 + row] = f2bf(acc[ai][bj][m][n][j]);
            }
          }
        }
  }
};

struct EpiQ {
  Params p;
  __device__ __forceinline__ void operator()(AccRef acc, const pg8::Unit& u, int wr, int wc, int fr_, int fq_) const {
    const int lane_ = tid_of(wr * 4 + wc) & 63, fr = lane_ & 15, fq = lane_ >> 4;
    const float qs = 0.07216878364870322f * 1.4426950408889634f;
    const int rowb = u.pm * 256 + wr * 64 + fr;
#pragma unroll
    for (int ai = 0; ai < 2; ++ai)
#pragma unroll
      for (int m = 0; m < 4; ++m) {
        const int row = rowb + ai * 128 + m * 16;
        const float rs = rsqrtf(p.ssq()[row] * (1.f / 512.f) + 1e-6f) * qs;
#pragma unroll
        for (int bj = 0; bj < 2; ++bj) {
          const int cs = u.pn * 256 + bj * 128 + wc * 32;
          if (cs >= 1152) continue;
          const int hd = cs / 192, o = cs % 192;
          u16* qp = p.q() + ((size_t)hd * SEQ + row) * 192;
          if (o < 128) {
#pragma unroll
            for (int n = 0; n < 2; ++n) {
              f32x4 v = acc[ai][bj][m][n] * rs;
              *(uint2*)(qp + o + n * 16 + fq * 4) = make_uint2(pack2(v[0], v[1]), pack2(v[2], v[3]));
            }
          } else {
            const int i0 = ((cs >> 5) & 1) * 16 + fq * 4;
            float4 cs4 = *(const float4*)(p.cosT() + (size_t)row * 32 + i0);
            float4 sn = *(const float4*)(p.sinT() + (size_t)row * 32 + i0);
            f32x4 x1 = acc[ai][bj][m][0] * rs, x2 = acc[ai][bj][m][1] * rs;
            float a0 = x1[0] * cs4.x - x2[0] * sn.x, a1 = x1[1] * cs4.y - x2[1] * sn.y, a2 = x1[2] * cs4.z - x2[2] * sn.z, a3 = x1[3] * cs4.w - x2[3] * sn.w;
            float b0 = x1[0] * sn.x + x2[0] * cs4.x, b1 = x1[1] * sn.y + x2[1] * cs4.y, b2 = x1[2] * sn.z + x2[2] * cs4.z, b3 = x1[3] * sn.w + x2[3] * cs4.w;
            *(uint2*)(qp + 128 + i0) = make_uint2(pack2(a0, a1), pack2(a2, a3));
            *(uint2*)(qp + 160 + i0) = make_uint2(pack2(b0, b1), pack2(b2, b3));
          }
        }
      }
  }
};

struct EpiKV {
  Params p;
  __device__ __forceinline__ void operator()(AccRef acc, const pg8::Unit& u, int wr, int wc, int fr_, int fq_) const {
    const int lane_ = tid_of(wr * 4 + wc) & 63, fr = lane_ & 15, fq = lane_ >> 4;
    const int rowb = u.pm * 256 + wr * 64 + fr, hd = u.pn;
#pragma unroll
    for (int ai = 0; ai < 2; ++ai)
#pragma unroll
      for (int m = 0; m < 4; ++m) {
        const int row = rowb + ai * 128 + m * 16;
        const float rs = rsqrtf(p.ssq()[SEQ + row] * (1.f / 256.f) + 1e-6f);
        u16* kp = p.k() + ((size_t)hd * SEQ + row) * 192 + wc * 32;
#pragma unroll
        for (int n = 0; n < 2; ++n) {
          f32x4 v = acc[ai][0][m][n] * rs;
          *(uint2*)(kp + n * 16 + fq * 4) = make_uint2(pack2(v[0], v[1]), pack2(v[2], v[3]));
        }
#pragma unroll
        for (int n = 0; n < 2; ++n)
#pragma unroll
          for (int j = 0; j < 4; ++j)
            p.vt()[((size_t)hd * 128 + wc * 32 + n * 16 + fq * 4 + j) * SEQ + row] = f2bf(acc[ai][1][m][n][j] * rs);
      }
  }
};

struct EpiD {
  Params p; int l;
  __device__ __forceinline__ void operator()(AccRef acc, const pg8::Unit& u, int wr, int wc, int fr_, int fq_) const {
    const int lane_ = tid_of(wr * 4 + wc) & 63, fr = lane_ & 15, fq = lane_ >> 4;
    const float alpha = 1.681792830507429f;
    const float* xres = (l == 0) ? p.x : p.out;
    const int rowb = u.pm * 256 + wr * 64 + fr;
#pragma unroll
    for (int ai = 0; ai < 2; ++ai)
#pragma unroll
      for (int m = 0; m < 4; ++m) {
        const int row = rowb + ai * 128 + m * 16;
#pragma unroll
        for (int bj = 0; bj < 2; ++bj)
#pragma unroll
          for (int n = 0; n < 2; ++n) {
            const size_t off = (size_t)row * DM + u.pn * 256 + bj * 128 + wc * 32 + n * 16 + fq * 4;
            float4 xr = *(const float4*)(xres + off);
            f32x4 a = acc[ai][bj][m][n];
            *(float4*)(p.out + off) = make_float4(alpha * xr.x + a[0], alpha * xr.y + a[1], alpha * xr.z + a[2], alpha * xr.w + a[3]);
          }
      }
  }
};

__device__ void phaseE(const Params& p, int l, int wv) {
  const int tid = tid_of(wv);
  const int lane = tid & 63;
  const int gw = blockIdx.x * (NT / 64) + (tid >> 6), nw = gridDim.x * (NT / 64);
  for (size_t c = (size_t)blockIdx.x * NT + tid; c < (size_t)2 * SEQ; c += (size_t)gridDim.x * NT) p.ssq()[c] = 0.f;
  const float* g = p.ln_g + (size_t)l * DM;
  const float* b = p.ln_b + (size_t)l * DM;
  for (int row = gw; row < SEQ; row += nw) {
    float* zr = p.out + (size_t)row * DM;
    float4 v[8];
    float s = 0.f;
#pragma unroll
    for (int i = 0; i < 8; ++i) { v[i] = *(const float4*)(zr + (i * 64 + lane) * 4); s += v[i].x + v[i].y + v[i].z + v[i].w; }
#pragma unroll
    for (int o = 1; o < 64; o <<= 1) s += __shfl_xor(s, o);
    const float mu = s * (1.f / DM);
    float q = 0.f;
#pragma unroll
    for (int i = 0; i < 8; ++i) {
      v[i].x -= mu; v[i].y -= mu; v[i].z -= mu; v[i].w -= mu;
      q += v[i].x * v[i].x + v[i].y * v[i].y + v[i].z * v[i].z + v[i].w * v[i].w;
    }
#pragma unroll
    for (int o = 1; o < 64; o <<= 1) q += __shfl_xor(q, o);
    const float rstd = rsqrtf(q * (1.f / DM) + 1e-5f);
#pragma unroll
    for (int i = 0; i < 8; ++i) {
      const int c = (i * 64 + lane) * 4;
      float4 gg = *(const float4*)(g + c), bb = *(const float4*)(b + c);
      float4 r = make_float4(v[i].x * rstd * gg.x + bb.x, v[i].y * rstd * gg.y + bb.y, v[i].z * rstd * gg.z + bb.z, v[i].w * rstd * gg.w + bb.w);
      *(float4*)(zr + c) = r;
      *(uint2*)(p.xb() + (size_t)row * DM + c) = make_uint2(pack2(r.x, r.y), pack2(r.z, r.w));
    }
  }
}

template <int DK, int DV, int MODE, int QSN>
__device__ void attn_item(const u16* __restrict__ Qp, int ldq, const u16* __restrict__ Kp, int ldk, const u16* __restrict__ Vt, int ldv,
                          int t_last, float zscale, int q0, const u16* __restrict__ gate, u16* __restrict__ outp, char* smem, int wv) {
  constexpr int VST = 72, KCH = DK / 8;
  constexpr int NKR = (64 * KCH) / NT, NVR = (DV * 8) / NT, NST = DK / 32, NDS = DV / 16;
  u16* Ks = (u16*)smem;
  u16* Vs = Ks + 64 * DK;
  const int tid = tid_of(wv);
  asm volatile("" : "+s"(t_last));
  const int w = wv, lane = tid & 63, fr = lane & 15, fq = lane >> 4;

  const int fqs = (fq ^ ((fr >> 3) << 1)) * 16;
  constexpr int NSR = (MODE == 0) ? 4 : NST;
  bf16x8 qf[2][NSR];
  bf16x8* Qr = (bf16x8*)(Vs + DV * VST) + (w * 4) * 64 + lane;
#pragma unroll
  for (int qs = 0; qs < QSN; ++qs)
#pragma unroll
    for (int st = 0; st < NST; ++st) {
      bf16x8 v = *(const bf16x8*)(Qp + (unsigned)((w * (16 * QSN) + qs * 16 + fr) * ldq + st * 32 + fq * 8));
      if (st < NSR) qf[qs][st < NSR ? st : 0] = v;
      else Qr[(qs * 2 + (st - NSR)) * 64] = v;
    }

  f32x4 o[NDS][2];
#pragma unroll
  for (int ds = 0; ds < NDS; ++ds) { o[ds][0] = f32x4{0.f, 0.f, 0.f, 0.f}; o[ds][1] = f32x4{0.f, 0.f, 0.f, 0.f}; }
  float mrow[2] = {-1e30f, -1e30f};
  float lrow[2] = {0.f, 0.f};

  uint4 kk0, kk1, kk2, kk3, kk4, kk5, vv0, vv1, vv2, vv3;
#define KLOAD(i, T) if constexpr (NKR > i) { const int c_ = tid + NT * i, row_ = c_ / KCH, cc_ = c_ % KCH; kk##i = *(const uint4*)((Kp + (size_t)(T) * 64 * ldk) + (unsigned)(row_ * ldk + cc_ * 8)); }
#define KSTORE(i) if constexpr (NKR > i) { const int c_ = tid + NT * i, row_ = c_ / KCH, cc_ = c_ % KCH; \
    *(uint4*)((char*)Ks + (cc_ >> 2) * 4096 + row_ * 64 + (((cc_ & 3) ^ (((row_ >> 3) & 1) << 1)) * 16)) = kk##i; }
#define VLOAD(i, T) if constexpr (NVR > i) { const int c_ = tid + NT * i, dv_ = c_ >> 3, cc_ = c_ & 7; vv##i = *(const uint4*)((Vt + (T) * 64) + (unsigned)(dv_ * ldv + cc_ * 8)); }
#define VSTORE(i) if constexpr (NVR > i) { const int c_ = tid + NT * i, dv_ = c_ >> 3, cc_ = c_ & 7; *(uint4*)(Vs + dv_ * VST + cc_ * 8) = vv##i; }
#define load_k(T) do { KLOAD(0, T) KLOAD(1, T) KLOAD(2, T) KLOAD(3, T) KLOAD(4, T) KLOAD(5, T) } while (0)
#define load_v(T) do { VLOAD(0, T) VLOAD(1, T) VLOAD(2, T) VLOAD(3, T) } while (0)
#define store_tile() do { KSTORE(0) KSTORE(1) KSTORE(2) KSTORE(3) KSTORE(4) KSTORE(5) VSTORE(0) VSTORE(1) VSTORE(2) VSTORE(3) } while (0)

  volatile int* flg = (volatile int*)(smem + CTL_OFF) + 8;
  if (MODE == 2 && tid == 0) flg[0] = 0;
  int it = 0;
  int t = (MODE == 2) ? t_last : 0;
  load_k(t);
  load_v(t);
  while (true) {
    store_tile();
    __syncthreads();
    if (MODE == 2 && tid == 0) flg[(it & 1) ^ 1] = 0;
    const int tn = (MODE == 2) ? t - 1 : t + 1;
    const bool more = (MODE == 2) ? (t > 0) : (t < t_last);
    if (MODE != 2 && more) { load_k(tn); load_v(tn); }
    bool active = true;
    if (MODE == 0) active = (t <= t_last - 3 + (w >> 1));
    if (MODE == 2) active = (t <= t_last - 1 + (w >> 2));
    if (MODE != 2 && active) {
      f32x4 s[4][2];
#pragma unroll
      for (int ks = 0; ks < 4; ++ks) { s[ks][0] = f32x4{0.f, 0.f, 0.f, 0.f}; s[ks][1] = f32x4{0.f, 0.f, 0.f, 0.f}; }
#pragma unroll
      for (int st = 0; st < NST; ++st) {
#pragma unroll
        for (int ks = 0; ks < 4; ++ks) {
          bf16x8 kf = *(const bf16x8*)((const char*)Ks + st * 4096 + (ks * 16 + fr) * 64 + fqs);
          if (st < NSR) {
            s[ks][0] = mfma16(kf, qf[0][st < NSR ? st : 0], s[ks][0]);
            s[ks][1] = mfma16(kf, qf[1][st < NSR ? st : 0], s[ks][1]);
          } else {
            s[ks][0] = mfma16(kf, Qr[(st - NSR) * 64], s[ks][0]);
            s[ks][1] = mfma16(kf, Qr[(2 + st - NSR) * 64], s[ks][1]);
          }
        }
      }
      {
#pragma unroll
        for (int qs = 0; qs < 2; ++qs) {
          float mx = -1e30f;
#pragma unroll
          for (int ks = 0; ks < 4; ++ks)
#pragma unroll
            for (int j = 0; j < 4; ++j) mx = fmaxf(mx, s[ks][qs][j]);
          mx *= zscale;
          mx = fmaxf(mx, __shfl_xor(mx, 16));
          mx = fmaxf(mx, __shfl_xor(mx, 32));
          const float mn = fmaxf(mrow[qs], mx);
          const float alpha = __builtin_amdgcn_exp2f(mrow[qs] - mn);
          mrow[qs] = mn;
          float ls = 0.f;
#pragma unroll
          for (int ks = 0; ks < 4; ++ks)
#pragma unroll
            for (int j = 0; j < 4; ++j) {
              float pv = __builtin_amdgcn_exp2f(s[ks][qs][j] * zscale - mn);
              ls += pv;
              s[ks][qs][j] = pv;
            }
          lrow[qs] = lrow[qs] * alpha + ls;
#pragma unroll
          for (int ds = 0; ds < NDS; ++ds) o[ds][qs] *= alpha;
        }
      }
      bf16x8 pf[2][2];
#pragma unroll
      for (int qs = 0; qs < 2; ++qs)
#pragma unroll
        for (int u = 0; u < 2; ++u) {
          uint4 pk;
          pk.x = pack2(s[2 * u][qs][0], s[2 * u][qs][1]);
          pk.y = pack2(s[2 * u][qs][2], s[2 * u][qs][3]);
          pk.z = pack2(s[2 * u + 1][qs][0], s[2 * u + 1][qs][1]);
          pk.w = pack2(s[2 * u + 1][qs][2], s[2 * u + 1][qs][3]);
          pf[qs][u] = *(bf16x8*)&pk;
        }
#pragma unroll
      for (int u = 0; u < 2; ++u) {
#pragma unroll
        for (int ds = 0; ds < NDS; ++ds) {
          const u16* vp = Vs + (ds * 16 + fr) * VST + u * 32 + fq * 4;
          uint2 lo = *(const uint2*)vp, hi = *(const uint2*)(vp + 16);
          uint4 vv = make_uint4(lo.x, lo.y, hi.x, hi.y);
          bf16x8 vf = *(bf16x8*)&vv;
          o[ds][0] = mfma16(vf, pf[0][u], o[ds][0]);
          o[ds][1] = mfma16(vf, pf[1][u], o[ds][1]);
        }
      }
    }
    if (MODE == 2 && active) {
#pragma unroll
      for (int qs = 0; qs < QSN; ++qs) {
        f32x4 s1[4];
#pragma unroll
        for (int ks = 0; ks < 4; ++ks) s1[ks] = f32x4{0.f, 0.f, 0.f, 0.f};
#pragma unroll
        for (int st = 0; st < NST; ++st) {
#pragma unroll
          for (int ks = 0; ks < 4; ++ks) {
            bf16x8 kf = *(const bf16x8*)((const char*)Ks + st * 4096 + (ks * 16 + fr) * 64 + fqs);
            s1[ks] = mfma16(kf, qf[qs][st], s1[ks]);
          }
        }
        const int tq = q0 + w * (16 * QSN) + qs * 16 + fr;
        float running = lrow[qs];
#pragma unroll
        for (int ks = 3; ks >= 0; --ks) {
          float l1[4], lb[4];
#pragma unroll
          for (int j = 0; j < 4; ++j) {
            const float z = s1[ks][j] * zscale;
            const float e = __expf(-fabsf(z));
            const float sp = fmaxf(z, 0.f) + __logf(1.f + e);
            const int key = t * 64 + ks * 16 + fq * 4 + j;
            l1[j] = (key < tq) ? -sp : 0.f;
            lb[j] = z - sp;
          }
          const float p4 = (l1[0] + l1[1]) + (l1[2] + l1[3]);
          const float x16 = __shfl_xor(p4, 16);
          const float a2 = p4 + x16;
          const float x32 = __shfl_xor(a2, 32);
          const float tot = a2 + x32;
          const float gt = ((fq & 1) == 0 ? x16 : 0.f) + ((fq & 2) == 0 ? x32 : 0.f);
          const float s3 = running + gt;
          const float s2 = s3 + l1[3];
          const float s1_ = s2 + l1[2];
          const float s0 = s1_ + l1[1];
          s1[ks][0] = (l1[0] < 0.f) ? __expf(lb[0] + s0) : 0.f;
          s1[ks][1] = (l1[1] < 0.f) ? __expf(lb[1] + s1_) : 0.f;
          s1[ks][2] = (l1[2] < 0.f) ? __expf(lb[2] + s2) : 0.f;
          s1[ks][3] = (l1[3] < 0.f) ? __expf(lb[3] + s3) : 0.f;
          running += tot;
        }
        lrow[qs] = running;
        asm volatile("" ::: "memory");
#pragma unroll
        for (int u = 0; u < 2; ++u) {
          uint4 pk;
          pk.x = pack2(s1[2 * u][0], s1[2 * u][1]);
          pk.y = pack2(s1[2 * u][2], s1[2 * u][3]);
          pk.z = pack2(s1[2 * u + 1][0], s1[2 * u + 1][1]);
          pk.w = pack2(s1[2 * u + 1][2], s1[2 * u + 1][3]);
          bf16x8 pf1 = *(bf16x8*)&pk;
#pragma unroll
          for (int ds = 0; ds < NDS; ++ds) {
            const u16* vp = Vs + (ds * 16 + fr) * VST + u * 32 + fq * 4;
            uint2 lo = *(const uint2*)vp, hi = *(const uint2*)(vp + 16);
            uint4 vv = make_uint4(lo.x, lo.y, hi.x, hi.y);
            bf16x8 vf = *(bf16x8*)&vv;
            o[ds][qs] = mfma16(vf, pf1, o[ds][qs]);
          }
        }
        asm volatile("" ::: "memory");
        __builtin_amdgcn_sched_barrier(0);
      }
    }
    if (MODE == 2) {
      __builtin_amdgcn_sched_barrier(0);
      if (more) { load_k(tn); load_v(tn); }
      const int cont = (more && (lrow[0] >= -104.f || (QSN > 1 && lrow[1] >= -104.f))) ? 1 : 0;
      if (lane == 0 && __builtin_amdgcn_ballot_w64(cont != 0) != 0ull) flg[it & 1] = 1;
      __syncthreads();
      if (!flg[it & 1]) break;
      ++it;
    } else {
      __syncthreads();
      if (!more) break;
    }
    t = tn;
  }
  int fr_e = fr, fq_e = fq;
  asm volatile("" : "+v"(fr_e), "+v"(fq_e));
#pragma unroll
  for (int qs = 0; qs < QSN; ++qs) {
    float inv = 1.f;
    if (MODE != 2) {
      float lsum = lrow[qs];
      lsum += __shfl_xor(lsum, 16);
      lsum += __shfl_xor(lsum, 32);
      inv = 1.f / lsum;
    }
    const int row = w * (16 * QSN) + qs * 16 + fr_e;
#pragma unroll
    for (int ds = 0; ds < NDS; ++ds) {
      const int dv = ds * 16 + fq_e * 4;
      uint2 g2 = *(const uint2*)(gate + (unsigned)(row * DIN + dv));
      float v0 = o[ds][qs][0] * inv * bflo(g2.x), v1 = o[ds][qs][1] * inv * bfhi(g2.x);
      float v2 = o[ds][qs][2] * inv * bflo(g2.y), v3 = o[ds][qs][3] * inv * bfhi(g2.y);
      *(uint2*)(outp + (unsigned)(row * DM + dv)) = make_uint2(pack2(v0, v1), pack2(v2, v3));
    }
  }
}

#undef KLOAD
#undef KSTORE
#undef VLOAD
#undef VSTORE
#undef load_k
#undef load_v
#undef store_tile

#undef KLOAD
#undef KSTORE
#undef VLOAD
#undef VSTORE
#undef load_k
#undef load_v
#undef store_tile

__device__ void gmlp_item(const Params& p, int l, int n, int g, char* smem, int wv) {
  constexpr int WST = 136;
  u16* Ws = (u16*)smem;
  u16* Bs = Ws + 128 * WST;
  float* s_mu = (float*)(Bs + 128 * WST);
  float* s_rs = s_mu + 128;
  const int tid = tid_of(wv);
  const int w = wv, lane = tid & 63, fr = lane & 15, fq = lane >> 4;
  const int row0 = n * 128;
  {
    const int r = tid >> 2, qt = tid & 3;
    const u16* src = p.h() + (size_t)(row0 + r) * DIN + C_SGV + qt * 128;
    float s = 0.f, q = 0.f;
#pragma unroll 4
    for (int i = 0; i < 16; ++i) {
      uint4 v = *(const uint4*)(src + i * 8);
      const unsigned ww[4] = {v.x, v.y, v.z, v.w};
#pragma unroll
      for (int k = 0; k < 4; ++k) { float a = bflo(ww[k]), b = bfhi(ww[k]); s += a + b; q += a * a + b * b; }
    }
    s += __shfl_xor(s, 1); q += __shfl_xor(q, 1);
    s += __shfl_xor(s, 2); q += __shfl_xor(q, 2);
    const float mu = s * (1.f / 512.f);
    const float var = fmaxf(q * (1.f / 512.f) - mu * mu, 0.f);
    if (qt == 0) { s_mu[r] = mu; s_rs[r] = rsqrtf(var + 1e-5f); }
  }
  {
    const float* wsrc = p.sg_w + (size_t)(l * 4 + g) * 128 * 128;
#pragma unroll 4
    for (int i = 0; i < 8; ++i) {
      int id = tid + NT * i, tt = id >> 5, s4 = (id & 31) * 4;
      float4 v = *(const float4*)(wsrc + tt * 128 + s4);
      if (tt < 64 && s4 >= 64) v = make_float4(0.f, 0.f, 0.f, 0.f);
      *(uint2*)(Ws + tt * WST + s4) = make_uint2(pack2(v.x, v.y), pack2(v.z, v.w));
    }
  }
  __syncthreads();
  {
    const int c = tid & 127, sh = tid >> 7;
    const float lg = p.sg_ln_g[(size_t)l * 512 + g * 128 + c], lbv = p.sg_ln_b[(size_t)l * 512 + g * 128 + c];
    const u16* src = p.h() + (size_t)row0 * DIN + C_SGV + g * 128 + c;
#pragma unroll 2
    for (int s8 = 0; s8 < 4; ++s8) {
      const int so = (sh * 4 + s8) * 8;
      float v[8];
#pragma unroll
      for (int jj = 0; jj < 8; ++jj) {
        const int s = so + jj;
        v[jj] = (bf2f(src[(size_t)s * DIN]) - s_mu[s]) * s_rs[s] * lg + lbv;
      }
      *(uint4*)(Bs + c * WST + so) = make_uint4(pack2(v[0], v[1]), pack2(v[2], v[3]), pack2(v[4], v[5]), pack2(v[6], v[7]));
    }
  }
  __syncthreads();
  f32x4 acc[8];
#pragma unroll
  for (int ns = 0; ns < 8; ++ns) acc[ns] = f32x4{0.f, 0.f, 0.f, 0.f};
#pragma unroll
  for (int st = 0; st < 4; ++st) {
    const bf16x8 wf = *(const bf16x8*)(Ws + (w * 16 + fr) * WST + st * 32 + fq * 8);
#pragma unroll
    for (int ns = 0; ns < 8; ++ns) {
      bf16x8 bfv = *(const bf16x8*)(Bs + (ns * 16 + fr) * WST + st * 32 + fq * 8);
      acc[ns] = mfma16(bfv, wf, acc[ns]);
    }
  }
  {
    const int tt = w * 16 + fr;
    const float bias = p.sg_b[(size_t)(l * 4 + g) * 128 + tt];
    const u16* hrow = p.h() + (size_t)(row0 + tt) * DIN;
#pragma unroll
    for (int ns = 0; ns < 8; ++ns) {
      const int c = g * 128 + ns * 16 + fq * 4;
      uint2 u2 = *(const uint2*)(hrow + C_SGU + c);
      uint2 g2 = *(const uint2*)(hrow + C_GB + c);
      float v0 = bflo(u2.x) * (acc[ns][0] + bias) * bflo(g2.x);
      float v1 = bfhi(u2.x) * (acc[ns][1] + bias) * bfhi(g2.x);
      float v2 = bflo(u2.y) * (acc[ns][2] + bias) * bflo(g2.y);
      float v3 = bfhi(u2.y) * (acc[ns][3] + bias) * bfhi(g2.y);
      *(uint2*)(p.yin() + (size_t)(row0 + tt) * DM + 768 + c) = make_uint2(pack2(v0, v1), pack2(v2, v3));
    }
  }
  __syncthreads();
}

__device__ void phaseC(const Params& p, int l, int ci, char* smem, int wv) {
  volatile int* ctl = (volatile int*)(smem + CTL_OFF);
  constexpr int N_MLA = 192, N_SB = 256, N_MEM = 128, N_G = 256;
  constexpr int N_ALL = N_MLA + N_SB + N_MEM + N_G;
  while (true) {
    __syncthreads();
    if (tid_of(wv) == 0) ctl[0] = (int)atomicAdd(&p.ctr()[ci], 1u);
    __syncthreads();
    const int item = __builtin_amdgcn_readfirstlane(ctl[0]);
    if (item >= N_ALL) break;
    if (item < N_MLA) {
      const int qb = 31 - item / 6, hd = item % 6, q0 = qb * 256;
      attn_item<192, 128, 0, 2>(p.q() + ((size_t)hd * SEQ + q0) * 192, 192, p.k() + (size_t)hd * SEQ * 192, 192,
                             p.vt() + (size_t)hd * 128 * SEQ, SEQ, 4 * qb + 3, 1.0f, q0,
                             p.h() + (size_t)q0 * DIN + C_GA + hd * 128, p.yin() + (size_t)q0 * DM + hd * 128, smem, wv);
    } else if (item < N_MLA + N_SB) {
      const int it = item - N_MLA, qb = 63 - (it >> 2), hd = it & 3, q0 = qb * 128;
      attn_item<128, 128, 2, 1>(p.h() + (size_t)q0 * DIN + C_SBQ + hd * 128, DIN, p.h() + C_SBK + hd * 128, DIN,
                             p.vtsb() + (size_t)hd * 128 * SEQ, SEQ, 2 * qb + 1, 0.08838834764831845f, q0,
                             p.h() + (size_t)q0 * DIN + C_GC + hd * 128, p.yin() + (size_t)q0 * DM + 1280 + hd * 128, smem, wv);
    } else if (item < N_MLA + N_SB + N_MEM) {
      const int it = item - N_MLA - N_SB, qb = it >> 2, hd = it & 3, q0 = qb * 256;
      attn_item<64, 64, 1, 2>(p.h() + (size_t)q0 * DIN + C_MQ + hd * 64, DIN, p.mk() + (size_t)(l * 4 + hd) * 256 * 64, 64,
                           p.mvt() + (size_t)(l * 4 + hd) * 64 * 256, 256, 3, 0.125f * 1.4426950408889634f, q0,
                           p.h() + (size_t)q0 * DIN + C_GM + hd * 64, p.yin() + (size_t)q0 * DM + 1792 + hd * 64, smem, wv);
    } else {
      const int it = item - N_MLA - N_SB - N_MEM;
      gmlp_item(p, l, it >> 2, it & 3, smem, wv);
    }
  }
}

__global__ void __launch_bounds__(NT, 2) fwd_megakernel(Params p) {
  extern __shared__ __attribute__((aligned(16))) char smem[];
  volatile LAS unsigned* xst = (volatile LAS unsigned*)(smem + CTL_OFF + 16);
  const int wv = __builtin_amdgcn_readfirstlane(threadIdx.x >> 6);
  if (tid_of(wv) == 0) { xst[0] = 0u; xst[1] = 0u; }
  __syncthreads();
  const XcdBarrier xb = xcd_barrier_post(p.bar(), xst, wv);
#define grid_barrier() xcd_barrier(xb, wv)
  LAS unsigned char* glds = (LAS unsigned char*)smem;
  const int G = gridDim.x, B = blockIdx.x;
  phase_prep(p, smem, wv);
  cg::this_grid().sync();
  for (int l = 0; l < NL; ++l) {
    int Bl = B, Gl = G;
    asm volatile("" : "+s"(Bl), "+s"(Gl));
    {
      pg8::StaticOrder S; S.init(SEQ, DINP, Gl, Bl);
      pg8::Gemm g{p.xb(), p.wt_in() + (size_t)l * DINP * DM, DM, DM, DM};
      EpiA E{p, l};
      pg8::gemm_phase(glds, g, S, E, wv);
    }
    if (l == 0) {
      __syncthreads();
      pg8::StaticOrder S; S.init(256, NL * 512, Gl, (Bl + 128) % Gl);
      pg8::Gemm g{p.memb(), p.wt_memkv(), DM, DM, DM};
      EpiMem E{p};
      pg8::gemm_phase(glds, g, S, E, wv);
    }
    grid_barrier();
    {
      pg8::StrideOrder Sq, Skv;
      if (Gl == 256) { Sq = pg8::StrideOrder{Bl, 0, Bl < 160 ? 1 : 0, 160}; Skv = pg8::StrideOrder{(Bl - 160) * 2, 1, Bl >= 160 ? 2 : 0, 192}; }
      else { Sq = pg8::StrideOrder{Bl, Gl, 1 << 20, 160}; Skv = pg8::StrideOrder{Bl, Gl, 1 << 20, 192}; }
      {
        pg8::Gemm g{p.h() + C_CQ, p.wt_uq() + (size_t)l * UQP * 512, DIN, 512, 512};
        EpiQ E{p};
        pg8::gemm_phase(glds, g, Sq, E, wv);
      }
      __syncthreads();
      {
        pg8::Gemm g{p.h() + C_CKV, p.wt_ukv() + (size_t)l * 1536 * 256, DIN, 256, 256};
        EpiKV E{p};
        pg8::gemm_phase(glds, g, Skv, E, wv);
      }
    }
    grid_barrier();
    phaseC(p, l, l, smem, wv);
    grid_barrier();
    {
      pg8::StaticOrder S; S.init(SEQ, DM, Gl, Bl);
      pg8::Gemm g{p.yin(), p.wt_out() + (size_t)l * DM * DM, DM, DM, DM};
      EpiD E{p, l};
      pg8::gemm_phase(glds, g, S, E, wv);
    }
    grid_barrier();
    phaseE(p, l, wv);
    if (l + 1 < NL) grid_barrier();
  }
}

extern "C" void kernel_launch(void* const* d_in, const int* in_sizes, int n_in, void* d_out, int out_size, void* d_ws,
                              size_t ws_size, hipStream_t stream) {
  static int grid_blocks = 0;
  if (!grid_blocks) {
    int dev = 0, cus = 0, per_cu = 0;
    (void)hipGetDevice(&dev);
    (void)hipDeviceGetAttribute(&cus, hipDeviceAttributeMultiprocessorCount, dev);
    (void)hipFuncSetAttribute((const void*)fwd_megakernel, hipFuncAttributeMaxDynamicSharedMemorySize, LDS_BYTES);
    (void)hipOccupancyMaxActiveBlocksPerMultiprocessor(&per_cu, fwd_megakernel, NT, LDS_BYTES);
    if (per_cu > 1) per_cu = 1;
    if (per_cu < 1) per_cu = 1;
    grid_blocks = cus * per_cu;
  }
  Params p{};
  p.x = (const float*)d_in[0]; p.mem = (const float*)d_in[1]; p.pos = (const int*)d_in[2]; p.w_in = (const float*)d_in[3];
  p.q_norm_g = (const float*)d_in[4]; p.w_uq = (const float*)d_in[5]; p.kv_norm_g = (const float*)d_in[6];
  p.w_ukv = (const float*)d_in[7]; p.sg_ln_g = (const float*)d_in[8]; p.sg_ln_b = (const float*)d_in[9];
  p.sg_w = (const float*)d_in[10]; p.sg_b = (const float*)d_in[11]; p.w_mem_k = (const float*)d_in[12];
  p.w_mem_v = (const float*)d_in[13]; p.w_out = (const float*)d_in[14]; p.ln_g = (const float*)d_in[15];
  p.ln_b = (const float*)d_in[16];
  p.out = (float*)d_out;
  p.ws = (char*)d_ws;
  (void)hipMemsetAsync(p.ws + OFF_BAR, 0, 16384, stream);
  void* args[] = {&p};
  hipError_t e = hipLaunchCooperativeKernel((const void*)fwd_megakernel, dim3(grid_blocks), dim3(NT), args, LDS_BYTES, stream);
  if (e != hipSuccess) fprintf(stderr, "cooperative launch failed: %s (grid %d)\n", hipGetErrorString(e), grid_blocks);
}
```

```cpp
#include <hip/hip_runtime.h>
#include <hip/hip_cooperative_groups.h>
#include <cstdio>
namespace cg = cooperative_groups;

typedef unsigned short u16;
using bf16x8 = __attribute__((ext_vector_type(8))) short;
using f32x4 = __attribute__((ext_vector_type(4))) float;
typedef __bf16 bf16x2_t __attribute__((ext_vector_type(2)));
typedef float f32x2_t __attribute__((ext_vector_type(2)));

#define SEQ 8192
#define DM 2048
#define DIN 5696
#define DINP 5888
#define UQP 1280
#define NL 4
#define NT 512

constexpr int GEMM_LDS = 131072;
constexpr int MLA_V_OFF = 4 * 24576;
constexpr int MLA_QR_OFF = MLA_V_OFF + 3 * 16384;
constexpr int CTL_OFF = 155648;
constexpr int LDS_BYTES = CTL_OFF + 256;

constexpr int C_CQ = 0, C_CKV = 512, C_KPE = 768, C_GA = 832, C_SGU = 1600, C_SGV = 2112, C_GB = 2624,
              C_SBQ = 3136, C_SBK = 3648, C_SBV = 4160, C_GC = 4672, C_MQ = 5184, C_GM = 5440;

constexpr size_t al256(size_t x) { return (x + 255) & ~(size_t)255; }
constexpr size_t OFF_BAR = 0;
constexpr size_t OFF_CTR = OFF_BAR + al256(16384);
constexpr size_t OFF_SSQ = OFF_CTR + al256(8192);
constexpr size_t OFF_WT_IN = OFF_SSQ + al256((size_t)2 * SEQ * 4);
constexpr size_t OFF_WT_OUT = OFF_WT_IN + al256((size_t)NL * DINP * DM * 2);
constexpr size_t OFF_WT_UQ = OFF_WT_OUT + al256((size_t)NL * DM * DM * 2);
constexpr size_t OFF_WT_UKV = OFF_WT_UQ + al256((size_t)NL * UQP * 512 * 2);
constexpr size_t OFF_WT_MEMKV = OFF_WT_UKV + al256((size_t)NL * 1536 * 256 * 2);
constexpr size_t OFF_MEMB = OFF_WT_MEMKV + al256((size_t)NL * 512 * DM * 2);
constexpr size_t OFF_XB = OFF_MEMB + al256((size_t)256 * DM * 2);
constexpr size_t OFF_H = OFF_XB + al256((size_t)SEQ * DM * 2);
constexpr size_t OFF_Q = OFF_H + al256((size_t)SEQ * DIN * 2);
constexpr size_t OFF_K = OFF_Q + al256((size_t)6 * SEQ * 192 * 2);
constexpr size_t OFF_VT = OFF_K + al256((size_t)6 * SEQ * 192 * 2);
constexpr size_t OFF_VTSB = OFF_VT + al256((size_t)6 * 128 * SEQ * 2);
constexpr size_t OFF_YIN = OFF_VTSB + al256((size_t)4 * 128 * SEQ * 2);
constexpr size_t OFF_MK = OFF_YIN + al256((size_t)SEQ * DM * 2);
constexpr size_t OFF_MVT = OFF_MK + al256((size_t)NL * 4 * 256 * 64 * 2);
constexpr size_t OFF_COST = OFF_MVT + al256((size_t)NL * 4 * 64 * 256 * 2);
constexpr size_t OFF_SINT = OFF_COST + al256((size_t)SEQ * 32 * 4);
constexpr size_t OFF_LNSTAT = OFF_SINT + al256((size_t)SEQ * 32 * 4);
constexpr size_t OFF_LNX = OFF_LNSTAT + al256((size_t)SEQ * 2 * 4);
constexpr size_t OFF_PART = OFF_LNX + al256((size_t)32 * 8 * 256 * 8);
constexpr size_t PART_BYTES = 139264;
constexpr size_t WS_TOTAL = OFF_PART + al256((size_t)192 * PART_BYTES);
struct Params {
  const float* x; const float* mem; const int* pos; const float* w_in; const float* q_norm_g; const float* w_uq;
  const float* kv_norm_g; const float* w_ukv; const float* sg_ln_g; const float* sg_ln_b; const float* sg_w; const float* sg_b;
  const float* w_mem_k; const float* w_mem_v; const float* w_out; const float* ln_g; const float* ln_b;
  float* out;
  char* ws;
  __device__ __forceinline__ unsigned* bar() const { return (unsigned*)(ws + OFF_BAR); }
  __device__ __forceinline__ unsigned* ctr() const { return (unsigned*)(ws + OFF_CTR); }
  __device__ __forceinline__ float* ssq() const { return (float*)(ws + OFF_SSQ); }
  __device__ __forceinline__ u16* wt_in() const { return (u16*)(ws + OFF_WT_IN); }
  __device__ __forceinline__ u16* wt_out() const { return (u16*)(ws + OFF_WT_OUT); }
  __device__ __forceinline__ u16* wt_uq() const { return (u16*)(ws + OFF_WT_UQ); }
  __device__ __forceinline__ u16* wt_ukv() const { return (u16*)(ws + OFF_WT_UKV); }
  __device__ __forceinline__ u16* wt_memkv() const { return (u16*)(ws + OFF_WT_MEMKV); }
  __device__ __forceinline__ u16* memb() const { return (u16*)(ws + OFF_MEMB); }
  __device__ __forceinline__ u16* xb() const { return (u16*)(ws + OFF_XB); }
  __device__ __forceinline__ u16* h() const { return (u16*)(ws + OFF_H); }
  __device__ __forceinline__ u16* q() const { return (u16*)(ws + OFF_Q); }
  __device__ __forceinline__ u16* k() const { return (u16*)(ws + OFF_K); }
  __device__ __forceinline__ u16* vt() const { return (u16*)(ws + OFF_VT); }
  __device__ __forceinline__ u16* vtsb() const { return (u16*)(ws + OFF_VTSB); }
  __device__ __forceinline__ u16* yin() const { return (u16*)(ws + OFF_YIN); }
  __device__ __forceinline__ u16* mk() const { return (u16*)(ws + OFF_MK); }
  __device__ __forceinline__ u16* mvt() const { return (u16*)(ws + OFF_MVT); }
  __device__ __forceinline__ float* cosT() const { return (float*)(ws + OFF_COST); }
  __device__ __forceinline__ float* sinT() const { return (float*)(ws + OFF_SINT); }
  __device__ __forceinline__ float* part() const { return (float*)(ws + OFF_PART); }
  __device__ __forceinline__ float* lnstat() const { return (float*)(ws + OFF_LNSTAT); }
  __device__ __forceinline__ unsigned long long* lnx() const { return (unsigned long long*)(ws + OFF_LNX); }
};

__device__ __forceinline__ unsigned pack2(float a, float b) {
  f32x2_t v = {a, b};
  bf16x2_t r = __builtin_convertvector(v, bf16x2_t);
  return *(unsigned*)&r;
}
__device__ __forceinline__ u16 f2bf(float a) { return (u16)(pack2(a, 0.f) & 0xffffu); }
__device__ __forceinline__ float bflo(unsigned w) { return __uint_as_float(w << 16); }
__device__ __forceinline__ float bfhi(unsigned w) { return __uint_as_float(w & 0xffff0000u); }
__device__ __forceinline__ float bf2f(u16 h) { return __uint_as_float(((unsigned)h) << 16); }
__device__ __forceinline__ float silu_f(float x) { return x * __builtin_amdgcn_rcpf(1.f + __expf(-x)); }
__device__ __forceinline__ float gelu_f(float x) {
  float u = 0.7978845608028654f * (x + 0.044715f * x * x * x);
  float t = 1.f - 2.f * __builtin_amdgcn_rcpf(__expf(2.f * u) + 1.f);
  return 0.5f * x * (1.f + t);
}
__device__ __forceinline__ f32x4 mfma16(bf16x8 a, bf16x8 b, f32x4 c) {
  return __builtin_amdgcn_mfma_f32_16x16x32_bf16(a, b, c, 0, 0, 0);
}
__device__ __forceinline__ int vperm(int s) { return (s & 32) | (((s >> 2) & 3) << 3) | (((s >> 4) & 1) << 2) | (s & 3); }
__device__ __forceinline__ float xmax16(float v) { auto r = __builtin_amdgcn_permlane16_swap(__float_as_uint(v), __float_as_uint(v), false, false); return fmaxf(__uint_as_float(r[0]), __uint_as_float(r[1])); }
__device__ __forceinline__ float xmax32(float v) { auto r = __builtin_amdgcn_permlane32_swap(__float_as_uint(v), __float_as_uint(v), false, false); return fmaxf(__uint_as_float(r[0]), __uint_as_float(r[1])); }
__device__ __forceinline__ float xsum16(float v) { auto r = __builtin_amdgcn_permlane16_swap(__float_as_uint(v), __float_as_uint(v), false, false); return __uint_as_float(r[0]) + __uint_as_float(r[1]); }
__device__ __forceinline__ float xsum32(float v) { auto r = __builtin_amdgcn_permlane32_swap(__float_as_uint(v), __float_as_uint(v), false, false); return __uint_as_float(r[0]) + __uint_as_float(r[1]); }
__device__ __forceinline__ float shx(float v, int lane, int m) { return __uint_as_float(__builtin_amdgcn_ds_bpermute((lane ^ m) << 2, __float_as_uint(v))); }
__device__ __forceinline__ int tid_of(int wv) {
  int lane;
  asm volatile("v_mbcnt_lo_u32_b32 %0, -1, 0\n\tv_mbcnt_hi_u32_b32 %0, -1, %0" : "=v"(lane));
  return wv * 64 + lane;
}

#define XB_TMO      128
#define XB_XCNT(j)  (256  + 64 * (j))
#define XB_XSUB(j)  (1280 + 64 * (j))
#define XB_XGEN(j)  (2304 + 64 * (j))
#define XB_TOP      3328
#define XB_TOPGEN   3392
#define XCD_BAR_WORDS 3456
#define XB_SPIN_CAP (1u << 22)
#define LAS __attribute__((address_space(3)))
__device__ __forceinline__ unsigned xb_ld(unsigned* p) { return __hip_atomic_load(p, __ATOMIC_RELAXED, __HIP_MEMORY_SCOPE_AGENT); }
__device__ __forceinline__ unsigned xb_add(unsigned* p, unsigned v) { return __hip_atomic_fetch_add(p, v, __ATOMIC_RELAXED, __HIP_MEMORY_SCOPE_AGENT); }
__device__ __forceinline__ unsigned xb_xcc_id() { return (unsigned)__builtin_amdgcn_s_getreg((3 << 11) | 20) & 0xFu; }
#define XB_SPIN(cond, bar) do { unsigned _sp = 0; while (cond) { __builtin_amdgcn_s_sleep(1); \
    if ((++_sp & 255u) == 0u) { if (xb_ld(&(bar)[XB_TMO])) break; if (_sp > XB_SPIN_CAP) { atomicAdd(&(bar)[XB_TMO], 1u); break; } } } } while (0)
struct XcdBarrier { unsigned* bar; unsigned x; volatile LAS unsigned* st; };
__device__ __forceinline__ XcdBarrier xcd_barrier_post(unsigned* bar, volatile LAS unsigned* st, int wv) {
  XcdBarrier b; b.bar = bar; b.x = xb_xcc_id(); b.st = st;
  if (tid_of(wv) == 0) (void)xb_add(&bar[XB_XCNT(b.x)], 1u);
  return b;
}
__device__ __forceinline__ void xcd_barrier_complete(unsigned* bar, unsigned x, unsigned& nloc, unsigned& nx) {
  const unsigned G = gridDim.x * gridDim.y * gridDim.z;
  unsigned sum, cnt, mine, sp = 0u;
  for (;;) {
    sum = 0u; cnt = 0u; mine = 0u;
#pragma unroll
    for (unsigned j = 0; j < 16; ++j) { const unsigned c = xb_ld(&bar[XB_XCNT(j)]); sum += c; cnt += (c > 0u) ? 1u : 0u; mine = (j == x) ? c : mine; }
    if (sum == G) break;
    __builtin_amdgcn_s_sleep(1);
    if ((++sp & 255u) == 0u) { if (xb_ld(&bar[XB_TMO])) break; if (sp > XB_SPIN_CAP) { atomicAdd(&bar[XB_TMO], 1u); break; } }
  }
  nloc = mine > 0u ? mine : 1u; nx = cnt > 0u ? cnt : 1u;
}
__device__ __forceinline__ void xcd_barrier(const XcdBarrier& b, int wv) {
  asm volatile("s_waitcnt vmcnt(0)" ::: "memory");
  __syncthreads();
  if (tid_of(wv) == 0) {
    unsigned* bar = b.bar;
    __builtin_amdgcn_s_waitcnt(0);
    unsigned nloc = b.st[0], nx = b.st[1];
    if (nloc == 0u) { xcd_barrier_complete(bar, b.x, nloc, nx); b.st[0] = nloc; b.st[1] = nx; }
    const unsigned old = xb_add(&bar[XB_XSUB(b.x)], 1u);
    const unsigned gen = old / nloc;
    if (old + 1u == (gen + 1u) * nloc) {
      __builtin_amdgcn_fence(__ATOMIC_RELEASE, "agent");
      asm volatile("s_waitcnt vmcnt(0)" ::: "memory");
      const unsigned og = xb_add(&bar[XB_TOP], 1u);
      const unsigned tg = og / nx;
      if (og + 1u == (tg + 1u) * nx) xb_add(&bar[XB_TOPGEN], 1u);
      else XB_SPIN(xb_ld(&bar[XB_TOPGEN]) == tg, bar);
      __builtin_amdgcn_fence(__ATOMIC_ACQUIRE, "agent");
      xb_add(&bar[XB_XGEN(b.x)], 1u);
      asm volatile("s_waitcnt vmcnt(0)" ::: "memory");
    } else {
      XB_SPIN(xb_ld(&bar[XB_XGEN(b.x)]) == gen, bar);
      __builtin_amdgcn_fence(__ATOMIC_ACQUIRE, "agent");
      asm volatile("s_waitcnt vmcnt(0)" ::: "memory");
    }
  }
  __syncthreads();
}

__device__ __forceinline__ int perm64(int g) { return ((g >> 4) & 1) * 32 + (g >> 5) * 16 + (g & 15); }

__device__ void tconv_all(const float* src, u16* dst, int K, int N, int Npad, size_t srcLS, size_t dstLS, int dstRowOff,
                          const float* g, int gS, int permMode, float* lds0, int wv) {
  const int tid = tid_of(wv);
  const int half = tid >> 8, ht = tid & 255;
  float* lds = lds0 + half * (2 * 64 * 65);
  const int nkt = K / 64, nnt = Npad / 64, per = nkt * nnt, total = NL * per;
  for (int t0 = blockIdx.x * 4; t0 < total; t0 += gridDim.x * 4) {
    float4 v[2][4];
    bool ok[2];
    int n0s[2], k0s[2], ls[2];
#pragma unroll
    for (int j = 0; j < 2; ++j) {
      const int t = t0 + half * 2 + j;
      ok[j] = t < total;
      const int l = t / per, r = t % per, kt = r / nnt, nt = r % nnt;
      ls[j] = l; k0s[j] = kt * 64; n0s[j] = nt * 64;
      const float* sp = src + (size_t)l * srcLS;
#pragma unroll
      for (int i = 0; i < 4; ++i) {
        const int rr = (ht >> 4) + 16 * i, c = (ht & 15) * 4;
        v[j][i] = make_float4(0.f, 0.f, 0.f, 0.f);
        if (ok[j] && n0s[j] + c < N) v[j][i] = *(const float4*)(sp + (size_t)(k0s[j] + rr) * N + n0s[j] + c);
      }
    }
#pragma unroll
    for (int j = 0; j < 2; ++j) {
      const float* gp = g ? g + (size_t)ls[j] * gS : nullptr;
#pragma unroll
      for (int i = 0; i < 4; ++i) {
        const int rr = (ht >> 4) + 16 * i, c = (ht & 15) * 4;
        float4 x = v[j][i];
        if (gp && ok[j]) { const float sc = gp[k0s[j] + rr]; x.x *= sc; x.y *= sc; x.z *= sc; x.w *= sc; }
        float* pp = lds + j * (64 * 65) + rr * 65 + c;
        pp[0] = x.x; pp[1] = x.y; pp[2] = x.z; pp[3] = x.w;
      }
    }
    __syncthreads();
#pragma unroll
    for (int j = 0; j < 2; ++j) {
      if (ok[j]) {
        const int n0 = n0s[j], k0 = k0s[j];
        u16* dp = dst + (size_t)ls[j] * dstLS + (size_t)dstRowOff * K;
        const float* lj = lds + j * (64 * 65);
        const bool perm = (permMode == 1) ? (n0 == C_KPE) : (permMode == 2) ? ((n0 % 192) == 128 && n0 < 1152) : false;
#pragma unroll
        for (int i = 0; i < 2; ++i) {
          const int id = ht + 256 * i, n = id >> 3, kc = (id & 7) * 8;
          const int ns = perm ? perm64(n) : n;
          unsigned w0 = pack2(lj[(kc + 0) * 65 + ns], lj[(kc + 1) * 65 + ns]);
          unsigned w1 = pack2(lj[(kc + 2) * 65 + ns], lj[(kc + 3) * 65 + ns]);
          unsigned w2 = pack2(lj[(kc + 4) * 65 + ns], lj[(kc + 5) * 65 + ns]);
          unsigned w3 = pack2(lj[(kc + 6) * 65 + ns], lj[(kc + 7) * 65 + ns]);
          *(uint4*)(dp + (size_t)(n0 + n) * K + k0 + kc) = make_uint4(w0, w1, w2, w3);
        }
      }
    }
    __syncthreads();
  }
}

__device__ void phase_prep(const Params& p, char* smem, int wv) {
  float* lds = (float*)smem;
  const int tid = tid_of(wv);
  const size_t gtid = (size_t)blockIdx.x * NT + tid, gsz = (size_t)gridDim.x * NT;
  if (blockIdx.x == 0) { p.ctr()[tid] = 0u; p.ctr()[tid + NT] = 0u; p.ctr()[tid + 2 * NT] = 0u; p.ctr()[tid + 3 * NT] = 0u; }
  for (size_t c = gtid; c < (size_t)2 * SEQ; c += gsz) p.ssq()[c] = 0.f;
  for (size_t c = gtid; c < (size_t)SEQ * DM / 8; c += gsz) {
    float4 a = *(const float4*)(p.x + c * 8), b = *(const float4*)(p.x + c * 8 + 4);
    *(uint4*)(p.xb() + c * 8) = make_uint4(pack2(a.x, a.y), pack2(a.z, a.w), pack2(b.x, b.y), pack2(b.z, b.w));
  }
  for (size_t c = gtid; c < (size_t)256 * DM / 8; c += gsz) {
    float4 a = *(const float4*)(p.mem + c * 8), b = *(const float4*)(p.mem + c * 8 + 4);
    *(uint4*)(p.memb() + c * 8) = make_uint4(pack2(a.x, a.y), pack2(a.z, a.w), pack2(b.x, b.y), pack2(b.z, b.w));
  }
  for (size_t e = gtid; e < (size_t)SEQ * 32; e += gsz) {
    int s = (int)(e >> 5), i = (int)(e & 31);
    float invf = __builtin_amdgcn_exp2f(-(float)i * (13.287712379549449f / 32.0f));
    float ang = (float)p.pos[s] * invf;
    double rev = (double)ang * 0.15915494309189535;
    float fr = (float)(rev - floor(rev));
    p.cosT()[e] = __builtin_amdgcn_cosf(fr);
    p.sinT()[e] = __builtin_amdgcn_sinf(fr);
  }
  tconv_all(p.w_in, p.wt_in(), DM, DIN, DINP, (size_t)DM * DIN, (size_t)DINP * DM, 0, nullptr, 0, 1, lds, wv);
  tconv_all(p.w_out, p.wt_out(), DM, DM, DM, (size_t)DM * DM, (size_t)DM * DM, 0, nullptr, 0, 0, lds, wv);
  tconv_all(p.w_uq, p.wt_uq(), 512, 1152, UQP, (size_t)512 * 1152, (size_t)UQP * 512, 0, p.q_norm_g, 512, 2, lds, wv);
  tconv_all(p.w_ukv, p.wt_ukv(), 256, 1536, 1536, (size_t)256 * 1536, (size_t)1536 * 256, 0, p.kv_norm_g, 256, 0, lds, wv);
  tconv_all(p.w_mem_k, p.wt_memkv(), DM, 256, 256, (size_t)DM * 256, (size_t)512 * DM, 0, nullptr, 0, 0, lds, wv);
  tconv_all(p.w_mem_v, p.wt_memkv(), DM, 256, 256, (size_t)DM * 256, (size_t)512 * DM, 256, nullptr, 0, 0, lds, wv);
}

namespace pg8 {
constexpr int BM = 256, BK = 64, HALF = 128, HTB = HALF * BK * 2, NXCD = 8, WGM = 8;
__device__ __forceinline__ int lds_byte(int r, int c) { const int st = (r >> 4) * 2 + (c >> 5), rr = r & 15, cc = c & 31, ob = rr * 64 + cc * 2; return st * 1024 + (ob ^ (((ob >> 9) & 1) << 5)); }
__device__ __forceinline__ void stage_rc(int b, int& R, int& C) { const int st = b / 1024, sb = b % 1024, swz = sb ^ (((sb >> 9) & 1) << 5); R = (st >> 1) * 16 + swz / 64; C = (st & 1) * 32 + (swz % 64) / 2; }
struct Unit { int pm, pn; };
struct Gemm { const u16* A; const u16* Bt; int lda, ldb, K; };
struct StaticOrder {
  int nM, nN, nwg, G, c;
  __device__ void init(int M, int N, int G_, int c_) { nM = M / BM; nN = N / BM; nwg = nM * nN; G = G_; c = c_; }
  __device__ bool next(int i, Unit& u) const {
    const long L = (long)i * G + c; if (L >= nwg) return false;
    int wgid = (int)L; { const int q = nwg / NXCD, r = nwg % NXCD, xcd = wgid % NXCD, off = wgid / NXCD; wgid = (xcd < r ? xcd * (q + 1) : r * (q + 1) + (xcd - r) * q) + off; }
    const int nig = WGM * nN, gid = wgid / nig, fm = gid * WGM, gsz = (nM - fm) < WGM ? (nM - fm) : WGM;
    u.pm = __builtin_amdgcn_readfirstlane(fm + ((wgid % nig) % gsz)); u.pn = __builtin_amdgcn_readfirstlane((wgid % nig) / gsz); return true;
  }
};
struct StrideOrder {
  int first, stride, count, limit;
  __device__ bool next(int i, Unit& u) const { const int x = first + i * stride; if (i >= count || x >= limit) return false; u.pm = x & 31; u.pn = x >> 5; return true; }
};

template <class Epi, class Sched>
__device__ __forceinline__ void gemm_phase(LAS unsigned char* lds, const Gemm g, const Sched& S, const Epi& E, int wv) {
  const int tid = tid_of(wv);
  const int wid = wv, lane = tid & 63, wr = wid >> 2, wc = wid & 3, fr = lane & 15, fq = lane >> 4;
  const int K = g.K, nt = K / BK;
  unsigned voffA[2], voffB[2];
#pragma unroll
  for (int i = 0; i < 2; ++i) { int R, C; stage_rc(tid * 16 + i * 8192, R, C);
    voffA[i] = (unsigned)(R * g.lda + C) * 2u; voffB[i] = (unsigned)(R * g.ldb + C) * 2u; }
  const size_t kstep = (size_t)(BK * 2);
  const size_t hstepA = (size_t)HALF * g.lda * 2, hstepB = (size_t)HALF * g.ldb * 2;
  const size_t tstepA = 2 * hstepA, tstepB = 2 * hstepB;
  const unsigned ldsw = (unsigned)wid * 1024u;
  const int aoff = lds_byte(wr * 64 + fr, fq * 8), boff = lds_byte(wc * 32 + fr, fq * 8);
#define PG8_SA(b, h) (((b) * 2 + (h)) * HTB)
#define PG8_SB(b, h) ((4 + (b) * 2 + (h)) * HTB)
#define PG8_STAGE(bufoff, gbase, voff) do { _Pragma("unroll") for (int _i = 0; _i < 2; ++_i) \
    __builtin_amdgcn_global_load_lds((const unsigned*)((const char*)(gbase) + (voff)[_i]), (LAS unsigned*)(lds + (bufoff) + ldsw + _i * 8192), 16, 0, 0); } while (0)
#define PG8_LDA(dst, b, h) do { _Pragma("unroll") for (int m = 0; m < 4; ++m) _Pragma("unroll") for (int k = 0; k < 2; ++k) dst[m][k] = *(const LAS bf16x8*)(lds + PG8_SA(b, h) + aoff + m * 2048 + k * 1024); } while (0)
#define PG8_LDB(dst, b, h) do { _Pragma("unroll") for (int n = 0; n < 2; ++n) _Pragma("unroll") for (int k = 0; k < 2; ++k) dst[n][k] = *(const LAS bf16x8*)(lds + PG8_SB(b, h) + boff + n * 2048 + k * 1024); } while (0)
#define PG8_MMA(ai, bj, At, Bt) do { __builtin_amdgcn_s_setprio(1); _Pragma("unroll") for (int m = 0; m < 4; ++m) _Pragma("unroll") for (int n = 0; n < 2; ++n) _Pragma("unroll") for (int k = 0; k < 2; ++k) \
    acc[ai][bj][m][n] = __builtin_amdgcn_mfma_f32_16x16x32_bf16(Bt[n][k], At[m][k], acc[ai][bj][m][n], 0, 0, 0); __builtin_amdgcn_s_setprio(0); } while (0)
#define PG8_WAIT_V(n) asm volatile("s_waitcnt vmcnt(" #n ")" ::: "memory")
#define PG8_WAIT_L(n) asm volatile("s_waitcnt lgkmcnt(" #n ")" ::: "memory")
#define PG8_BAR __builtin_amdgcn_s_barrier()
#define PG8_SCHED __builtin_amdgcn_sched_barrier(0)
  Unit cur, nxt; int ui = 0;
  if (!S.next(0, cur)) return;
  f32x4 acc[2][2][4][2];
#pragma unroll
  for (int a = 0; a < 2; ++a)
#pragma unroll
    for (int b = 0; b < 2; ++b)
#pragma unroll
      for (int m = 0; m < 4; ++m)
#pragma unroll
        for (int n = 0; n < 2; ++n) acc[a][b][m][n] = (f32x4){0.f, 0.f, 0.f, 0.f};
  bf16x8 At[4][2], B0[2][2], B1[2][2];
  const char* cA = (const char*)g.A + (size_t)cur.pm * tstepA; const char* cB = (const char*)g.Bt + (size_t)cur.pn * tstepB;
  PG8_STAGE(PG8_SB(0, 0), cB, voffB); PG8_STAGE(PG8_SA(0, 0), cA, voffA); PG8_STAGE(PG8_SB(0, 1), cB + hstepB, voffB); PG8_STAGE(PG8_SA(0, 1), cA + hstepA, voffA);
  if (wr == 1) PG8_BAR;
  PG8_WAIT_V(4); PG8_BAR;
  PG8_STAGE(PG8_SB(1, 0), cB + kstep, voffB); PG8_STAGE(PG8_SA(1, 0), cA + kstep, voffA); PG8_STAGE(PG8_SB(1, 1), cB + hstepB + kstep, voffB);
  PG8_WAIT_V(6); PG8_BAR;
  for (;;) {
    const bool has_next = S.next(ui + 1, nxt);
    const char* nA = has_next ? (const char*)g.A + (size_t)nxt.pm * tstepA : cA; const char* nB = has_next ? (const char*)g.Bt + (size_t)nxt.pn * tstepB : cB;
    for (int t = 0; t < nt; t += 2) {
      const bool last = (t == nt - 2);
      const char* a1 = cA + (size_t)(t + 1) * kstep;
      const char* a2 = last ? nA : cA + (size_t)(t + 2) * kstep; const char* b2 = last ? nB : cB + (size_t)(t + 2) * kstep;
      const char* a3 = a2 + kstep; const char* b3 = b2 + kstep;
      PG8_LDB(B0, 0, 0); PG8_SCHED; PG8_LDA(At, 0, 0); PG8_STAGE(PG8_SA(1, 1), a1 + hstepA, voffA);
      PG8_WAIT_L(8); PG8_BAR; PG8_WAIT_L(0); PG8_MMA(0, 0, At, B0); PG8_BAR; PG8_SCHED;
      PG8_LDB(B1, 0, 1); PG8_STAGE(PG8_SB(0, 0), b2, voffB);
      PG8_BAR; PG8_WAIT_L(0); PG8_MMA(0, 1, At, B1); PG8_BAR;
      PG8_LDA(At, 0, 1); PG8_STAGE(PG8_SA(0, 0), a2, voffA);
      PG8_BAR; PG8_WAIT_L(0); PG8_MMA(1, 0, At, B0); PG8_BAR; PG8_SCHED;
      PG8_STAGE(PG8_SB(0, 1), b2 + hstepB, voffB);
      PG8_WAIT_V(6); PG8_BAR; PG8_MMA(1, 1, At, B1); PG8_BAR;
      PG8_LDB(B0, 1, 0); PG8_SCHED; PG8_LDA(At, 1, 0); PG8_STAGE(PG8_SA(0, 1), a2 + hstepA, voffA);
      PG8_WAIT_L(8); PG8_BAR; PG8_WAIT_L(0); PG8_MMA(0, 0, At, B0); PG8_BAR; PG8_SCHED;
      PG8_LDB(B1, 1, 1); PG8_STAGE(PG8_SB(1, 0), b3, voffB);
      PG8_BAR; PG8_WAIT_L(0); PG8_MMA(0, 1, At, B1); PG8_BAR;
      PG8_LDA(At, 1, 1); PG8_STAGE(PG8_SA(1, 0), a3, voffA);
      PG8_BAR; PG8_WAIT_L(0); PG8_MMA(1, 0, At, B0); PG8_BAR; PG8_SCHED;
      PG8_STAGE(PG8_SB(1, 1), b3 + hstepB, voffB);
      PG8_WAIT_V(6); PG8_BAR; PG8_MMA(1, 1, At, B1); PG8_BAR;
    }
    if constexpr (!Epi::AFTER_DRAIN) E(acc, cur, wr, wc, fr, fq);
    if (!has_next) break;
#pragma unroll
    for (int a = 0; a < 2; ++a)
#pragma unroll
      for (int b = 0; b < 2; ++b)
#pragma unroll
        for (int m = 0; m < 4; ++m)
#pragma unroll
          for (int n = 0; n < 2; ++n) acc[a][b][m][n] = (f32x4){0.f, 0.f, 0.f, 0.f};
    cur = nxt; cA = nA; cB = nB; ++ui;
  }
  PG8_WAIT_V(0);
  if (wr == 0) PG8_BAR;
  PG8_BAR;
  if constexpr (Epi::AFTER_DRAIN) E.fused(acc, cur, wr, wc);
#undef PG8_SA
#undef PG8_SB
#undef PG8_STAGE
#undef PG8_LDA
#undef PG8_LDB
#undef PG8_MMA
#undef PG8_WAIT_V
#undef PG8_WAIT_L
#undef PG8_BAR
#undef PG8_SCHED
}
}

typedef const f32x4 (&AccRef)[2][2][4][2];

struct EpiA {
  static constexpr bool AFTER_DRAIN = false;
  Params p; int l;
  __device__ __forceinline__ void operator()(AccRef acc, const pg8::Unit& u, int wr, int wc, int fr_, int fq_) const {
    const int lane_ = tid_of(wr * 4 + wc) & 63, fr = lane_ & 15, fq = lane_ >> 4;
    const int rowb = u.pm * 256 + wr * 64 + fr;
#pragma unroll
    for (int bj = 0; bj < 2; ++bj) {
      const int cs = u.pn * 256 + bj * 128 + wc * 32;
      int kind;
      if (cs < C_KPE) kind = 0; else if (cs < C_GA) kind = 3; else if (cs < C_SGU) kind = 1;
      else if (cs < C_GB) kind = 2; else if (cs < C_SBQ) kind = 1; else if (cs < C_SBV) kind = 0;
      else if (cs < C_GC) kind = 4; else if (cs < C_MQ) kind = 1; else if (cs < C_GM) kind = 0;
      else if (cs < DIN) kind = 1; else kind = 5;
      if (kind == 5) continue;
      if (kind <= 2) {
#pragma unroll
        for (int ai = 0; ai < 2; ++ai)
#pragma unroll
          for (int m = 0; m < 4; ++m) {
            const int row = rowb + ai * 128 + m * 16;
#pragma unroll
            for (int n = 0; n < 2; ++n) {
              f32x4 v = acc[ai][bj][m][n];
              if (kind == 1) { v[0] = silu_f(v[0]); v[1] = silu_f(v[1]); v[2] = silu_f(v[2]); v[3] = silu_f(v[3]); }
              else if (kind == 2) { v[0] = gelu_f(v[0]); v[1] = gelu_f(v[1]); v[2] = gelu_f(v[2]); v[3] = gelu_f(v[3]); }
              *(uint2*)(p.h() + (size_t)row * DIN + cs + n * 16 + fq * 4) = make_uint2(pack2(v[0], v[1]), pack2(v[2], v[3]));
            }
          }
      } else if (kind == 3) {
        const int i0 = ((cs >> 5) & 1) * 16 + fq * 4;
#pragma unroll
        for (int ai = 0; ai < 2; ++ai)
#pragma unroll
          for (int m = 0; m < 4; ++m) {
            const int row = rowb + ai * 128 + m * 16;
            float4 cs4 = *(const float4*)(p.cosT() + (size_t)row * 32 + i0);
            float4 sn = *(const float4*)(p.sinT() + (size_t)row * 32 + i0);
            f32x4 x1 = acc[ai][bj][m][0], x2 = acc[ai][bj][m][1];
            float a0 = x1[0] * cs4.x - x2[0] * sn.x, a1 = x1[1] * cs4.y - x2[1] * sn.y, a2 = x1[2] * cs4.z - x2[2] * sn.z, a3 = x1[3] * cs4.w - x2[3] * sn.w;
            float b0 = x1[0] * sn.x + x2[0] * cs4.x, b1 = x1[1] * sn.y + x2[1] * cs4.y, b2 = x1[2] * sn.z + x2[2] * cs4.z, b3 = x1[3] * sn.w + x2[3] * cs4.w;
            uint2 ua = make_uint2(pack2(a0, a1), pack2(a2, a3)), ub = make_uint2(pack2(b0, b1), pack2(b2, b3));
#pragma unroll
            for (int hd = 0; hd < 6; ++hd) {
              u16* kp = p.k() + ((size_t)hd * SEQ + row) * 192 + 128 + i0;
              *(uint2*)kp = ua;
              *(uint2*)(kp + 32) = ub;
            }
          }
      } else {
#pragma unroll
        for (int ai = 0; ai < 2; ++ai)
#pragma unroll
          for (int m = 0; m < 4; ++m) {
            const int row = rowb + ai * 128 + m * 16;
#pragma unroll
            for (int n = 0; n < 2; ++n) {
              const int c = cs - C_SBV + n * 16 + fq * 4;
#pragma unroll
              for (int j = 0; j < 4; ++j) (p.vtsb() + (size_t)(c >> 7) * 128 * SEQ)[(unsigned)((row >> 6) * 8192 + vperm(row & 63) + ((c & 127) + j) * 64)] = f2bf(acc[ai][bj][m][n][j]);
            }
          }
      }
    }
    if (u.pn < 3) {
      float* sq = p.ssq() + (u.pn == 2 ? SEQ : 0);
#pragma unroll
      for (int ai = 0; ai < 2; ++ai)
#pragma unroll
        for (int m = 0; m < 4; ++m) {
          float v = 0.f;
#pragma unroll
          for (int bj = 0; bj < 2; ++bj)
#pragma unroll
            for (int n = 0; n < 2; ++n)
#pragma unroll
              for (int j = 0; j < 4; ++j) { float a = acc[ai][bj][m][n][j]; v += a * a; }
          v = xsum16(v);
          v = xsum32(v);
          if (fq == 0) atomicAdd(sq + rowb + ai * 128 + m * 16, v);
        }
    }
  }
};

struct EpiMem {
  static constexpr bool AFTER_DRAIN = false;
  Params p;
  __device__ __forceinline__ void operator()(AccRef acc, const pg8::Unit& u, int wr, int wc, int fr_, int fq_) const {
    const int lane_ = tid_of(wr * 4 + wc) & 63, fr = lane_ & 15, fq = lane_ >> 4;
    const int l = u.pn >> 1, isv = u.pn & 1;
    const int rowb = wr * 64 + fr;
#pragma unroll
    for (int bj = 0; bj < 2; ++bj)
#pragma unroll
      for (int ai = 0; ai < 2; ++ai)
#pragma unroll
        for (int m = 0; m < 4; ++m) {
          const int row = rowb + ai * 128 + m * 16;
#pragma unroll
          for (int n = 0; n < 2; ++n) {
            const int c = bj * 128 + wc * 32 + n * 16 + fq * 4, hd = c >> 6, e = c & 63;
            if (!isv) {
              *(uint2*)(p.mk() + ((size_t)(l * 4 + hd) * 256 + row) * 64 + e) =
                  make_uint2(pack2(acc[ai][bj][m][n][0], acc[ai][bj][m][n][1]), pack2(acc[ai][bj][m][n][2], acc[ai][bj][m][n][3]));
            } else {
#pragma unroll
              for (int j = 0; j < 4; ++j) p.mvt()[(unsigned)((((l * 4 + hd) * 4 + (row >> 6)) * 64 + e + j) * 64 + vperm(row & 63))] = f2bf(acc[ai][bj][m][n][j]);
            }
          }
        }
  }
};

struct EpiQ {
  static constexpr bool AFTER_DRAIN = false;
  Params p;
  __device__ __forceinline__ void operator()(AccRef acc, const pg8::Unit& u, int wr, int wc, int fr_, int fq_) const {
    const int lane_ = tid_of(wr * 4 + wc) & 63, fr = lane_ & 15, fq = lane_ >> 4;
    const float qs = 0.07216878364870322f * 1.4426950408889634f;
    const int rowb = u.pm * 256 + wr * 64 + fr;
#pragma unroll
    for (int ai = 0; ai < 2; ++ai)
#pragma unroll
      for (int m = 0; m < 4; ++m) {
        const int row = rowb + ai * 128 + m * 16;
        const float rs = rsqrtf(p.ssq()[row] * (1.f / 512.f) + 1e-6f) * qs;
#pragma unroll
        for (int bj = 0; bj < 2; ++bj) {
          const int cs = u.pn * 256 + bj * 128 + wc * 32;
          if (cs >= 1152) continue;
          const int hd = cs / 192, o = cs % 192;
          u16* qp = p.q() + ((size_t)hd * SEQ + row) * 192;
          if (o < 128) {
#pragma unroll
            for (int n = 0; n < 2; ++n) {
              f32x4 v = acc[ai][bj][m][n] * rs;
              *(uint2*)(qp + o + n * 16 + fq * 4) = make_uint2(pack2(v[0], v[1]), pack2(v[2], v[3]));
            }
          } else {
            const int i0 = ((cs >> 5) & 1) * 16 + fq * 4;
            float4 cs4 = *(const float4*)(p.cosT() + (size_t)row * 32 + i0);
            float4 sn = *(const float4*)(p.sinT() + (size_t)row * 32 + i0);
            f32x4 x1 = acc[ai][bj][m][0] * rs, x2 = acc[ai][bj][m][1] * rs;
            float a0 = x1[0] * cs4.x - x2[0] * sn.x, a1 = x1[1] * cs4.y - x2[1] * sn.y, a2 = x1[2] * cs4.z - x2[2] * sn.z, a3 = x1[3] * cs4.w - x2[3] * sn.w;
            float b0 = x1[0] * sn.x + x2[0] * cs4.x, b1 = x1[1] * sn.y + x2[1] * cs4.y, b2 = x1[2] * sn.z + x2[2] * cs4.z, b3 = x1[3] * sn.w + x2[3] * cs4.w;
            *(uint2*)(qp + 128 + i0) = make_uint2(pack2(a0, a1), pack2(a2, a3));
            *(uint2*)(qp + 160 + i0) = make_uint2(pack2(b0, b1), pack2(b2, b3));
          }
        }
      }
  }
};

struct EpiKV {
  static constexpr bool AFTER_DRAIN = false;
  Params p;
  __device__ __forceinline__ void operator()(AccRef acc, const pg8::Unit& u, int wr, int wc, int fr_, int fq_) const {
    const int lane_ = tid_of(wr * 4 + wc) & 63, fr = lane_ & 15, fq = lane_ >> 4;
    const int rowb = u.pm * 256 + wr * 64 + fr, hd = u.pn;
#pragma unroll
    for (int ai = 0; ai < 2; ++ai)
#pragma unroll
      for (int m = 0; m < 4; ++m) {
        const int row = rowb + ai * 128 + m * 16;
        const float rs = rsqrtf(p.ssq()[SEQ + row] * (1.f / 256.f) + 1e-6f);
        u16* kp = p.k() + ((size_t)hd * SEQ + row) * 192 + wc * 32;
#pragma unroll
        for (int n = 0; n < 2; ++n) {
          f32x4 v = acc[ai][0][m][n] * rs;
          *(uint2*)(kp + n * 16 + fq * 4) = make_uint2(pack2(v[0], v[1]), pack2(v[2], v[3]));
        }
#pragma unroll
        for (int n = 0; n < 2; ++n)
#pragma unroll
          for (int j = 0; j < 4; ++j)
            (p.vt() + (size_t)hd * 128 * SEQ)[(unsigned)((row >> 6) * 8192 + vperm(row & 63) + (wc * 32 + n * 16 + fq * 4 + j) * 64)] = f2bf(acc[ai][1][m][n][j] * rs);
      }
  }
};

struct EpiD {
  static constexpr bool AFTER_DRAIN = false;
  Params p; int l;
  __device__ __forceinline__ void operator()(AccRef acc, const pg8::Unit& u, int wr, int wc, int fr_, int fq_) const {
    const int lane_ = tid_of(wr * 4 + wc) & 63, fr = lane_ & 15, fq = lane_ >> 4;
    const float alpha = 1.681792830507429f;
    const float* xres = (l == 0) ? p.x : p.out;
    const int rowb = u.pm * 256 + wr * 64 + fr;
#pragma unroll
    for (int ai = 0; ai < 2; ++ai)
#pragma unroll
      for (int m = 0; m < 4; ++m) {
        const int row = rowb + ai * 128 + m * 16;
#pragma unroll
        for (int bj = 0; bj < 2; ++bj)
#pragma unroll
          for (int n = 0; n < 2; ++n) {
            const size_t off = (size_t)row * DM + u.pn * 256 + bj * 128 + wc * 32 + n * 16 + fq * 4;
            float4 xr = *(const float4*)(xres + off);
            f32x4 a = acc[ai][bj][m][n];
            *(float4*)(p.out + off) = make_float4(alpha * xr.x + a[0], alpha * xr.y + a[1], alpha * xr.z + a[2], alpha * xr.w + a[3]);
          }
      }
  }
};

struct EpiDF {
  static constexpr bool PERM = false, AFTER_DRAIN = true;
  Params p; int l; char* sm;
  __device__ __forceinline__ void operator()(AccRef, const pg8::Unit&, int, int, int, int) const {}
  __device__ __forceinline__ void fused(f32x4 (&z)[2][2][4][2], const pg8::Unit& u, int wr, int wc) const {
    typedef unsigned long long u64;
    const int wv = wr * 4 + wc, tid = tid_of(wv), lane = tid & 63, fr = lane & 15, fq = lane >> 4;
    const float alpha = 1.681792830507429f;
    const float* xres = (l == 0) ? p.x : p.out;
    float* P = (float*)(sm + GEMM_LDS);
    float* S = P + 2048;
    const int rlb = wr * 64 + fr, colb = u.pn * 256 + wc * 32 + fq * 4;
    for (size_t c = (size_t)blockIdx.x * NT + tid; c < (size_t)2 * SEQ; c += (size_t)gridDim.x * NT) p.ssq()[c] = 0.f;
#pragma unroll
    for (int ai = 0; ai < 2; ++ai) {
      float4 xr[4][2][2];
#pragma unroll
      for (int m = 0; m < 4; ++m)
#pragma unroll
        for (int bj = 0; bj < 2; ++bj)
#pragma unroll
          for (int n = 0; n < 2; ++n)
            xr[m][bj][n] = *(const float4*)(xres + (size_t)(u.pm * 256 + rlb + ai * 128 + m * 16) * DM + colb + bj * 128 + n * 16);
#pragma unroll
      for (int m = 0; m < 4; ++m) {
        float s1 = 0.f, s2 = 0.f;
#pragma unroll
        for (int bj = 0; bj < 2; ++bj)
#pragma unroll
          for (int n = 0; n < 2; ++n) {
            const float4 x4 = xr[m][bj][n];
            f32x4 v = z[ai][bj][m][n];
            v[0] = alpha * x4.x + v[0]; v[1] = alpha * x4.y + v[1]; v[2] = alpha * x4.z + v[2]; v[3] = alpha * x4.w + v[3];
            z[ai][bj][m][n] = v;
            s1 += (v[0] + v[1]) + (v[2] + v[3]);
            s2 += (v[0] * v[0] + v[1] * v[1]) + (v[2] * v[2] + v[3] * v[3]);
          }
        s1 = xsum32(xsum16(s1)); s2 = xsum32(xsum16(s2));
        if (fq == 0) { float* pp = P + ((rlb + ai * 128 + m * 16) * 4 + wc) * 2; pp[0] = s1; pp[1] = s2; }
      }
    }
    __syncthreads();
    u64* X = p.lnx() + (size_t)(u.pm * 8) * 256;
    if (tid < 256) {
      const float4 a = *(const float4*)(P + tid * 8), b = *(const float4*)(P + tid * 8 + 4);
      const float s1 = (a.x + a.z) + (b.x + b.z), s2 = (a.y + a.w) + (b.y + b.w);
      __hip_atomic_store(X + u.pn * 256 + tid, ((u64)__float_as_uint(s2) << 32) | __float_as_uint(s1), __ATOMIC_RELAXED, __HIP_MEMORY_SCOPE_AGENT);
    }
    asm volatile("s_waitcnt vmcnt(0)" ::: "memory");
    __syncthreads();
    if (tid == 0) {
      unsigned* cnt = p.ctr() + 1024 + l * 32 + u.pm;
      __hip_atomic_fetch_add(cnt, 1u, __ATOMIC_RELAXED, __HIP_MEMORY_SCOPE_AGENT);
      unsigned sp = 0;
      while (__hip_atomic_load(cnt, __ATOMIC_RELAXED, __HIP_MEMORY_SCOPE_AGENT) < 8u) { __builtin_amdgcn_s_sleep(2); if (++sp > (1u << 24)) break; }
    }
    __syncthreads();
    if (tid < 256) {
      float s1 = 0.f, s2 = 0.f;
#pragma unroll
      for (int j = 0; j < 8; ++j) {
        const u64 w = __hip_atomic_load(X + j * 256 + tid, __ATOMIC_RELAXED, __HIP_MEMORY_SCOPE_AGENT);
        s1 += __uint_as_float((unsigned)w); s2 += __uint_as_float((unsigned)(w >> 32));
      }
      const float mu = s1 * (1.f / DM);
      const float var = fmaxf(s2 * (1.f / DM) - mu * mu, 0.f);
      S[tid * 2] = mu; S[tid * 2 + 1] = rsqrtf(var + 1e-5f);
    }
    __syncthreads();
    const float* lg = p.ln_g + (size_t)l * DM;
    const float* lb = p.ln_b + (size_t)l * DM;
#pragma unroll
    for (int bj = 0; bj < 2; ++bj)
#pragma unroll
      for (int n = 0; n < 2; ++n) {
        const int col = colb + bj * 128 + n * 16;
        const float4 gg = *(const float4*)(lg + col), bb = *(const float4*)(lb + col);
#pragma unroll
        for (int ai = 0; ai < 2; ++ai)
#pragma unroll
          for (int m = 0; m < 4; ++m) {
            const int rl = rlb + ai * 128 + m * 16;
            const float mu = S[rl * 2], rs = S[rl * 2 + 1];
            const f32x4 v = z[ai][bj][m][n];
            const float r0 = (v[0] - mu) * rs * gg.x + bb.x, r1 = (v[1] - mu) * rs * gg.y + bb.y;
            const float r2 = (v[2] - mu) * rs * gg.z + bb.z, r3 = (v[3] - mu) * rs * gg.w + bb.w;
            const size_t off = (size_t)(u.pm * 256 + rl) * DM + col;
            *(float4*)(p.out + off) = make_float4(r0, r1, r2, r3);
            *(uint2*)(p.xb() + off) = make_uint2(pack2(r0, r1), pack2(r2, r3));
          }
      }
  }
};

__device__ void phaseE(const Params& p, int l, int wv) {
  const int tid = tid_of(wv);
  const int lane = tid & 63;
  const int gw = blockIdx.x * (NT / 64) + (tid >> 6), nw = gridDim.x * (NT / 64);
  for (size_t c = (size_t)blockIdx.x * NT + tid; c < (size_t)2 * SEQ; c += (size_t)gridDim.x * NT) p.ssq()[c] = 0.f;
  const float* g = p.ln_g + (size_t)l * DM;
  const float* b = p.ln_b + (size_t)l * DM;
  for (int row = gw; row < SEQ; row += nw) {
    float* zr = p.out + (size_t)row * DM;
    float4 v[8];
    float s = 0.f;
#pragma unroll
    for (int i = 0; i < 8; ++i) { v[i] = *(const float4*)(zr + (i * 64 + lane) * 4); s += v[i].x + v[i].y + v[i].z + v[i].w; }
#pragma unroll
    for (int o = 1; o < 16; o <<= 1) s += shx(s, lane, o);
    s = xsum16(s); s = xsum32(s);
    const float mu = s * (1.f / DM);
    float q = 0.f;
#pragma unroll
    for (int i = 0; i < 8; ++i) {
      v[i].x -= mu; v[i].y -= mu; v[i].z -= mu; v[i].w -= mu;
      q += v[i].x * v[i].x + v[i].y * v[i].y + v[i].z * v[i].z + v[i].w * v[i].w;
    }
#pragma unroll
    for (int o = 1; o < 16; o <<= 1) q += shx(q, lane, o);
    q = xsum16(q); q = xsum32(q);
    const float rstd = rsqrtf(q * (1.f / DM) + 1e-5f);
#pragma unroll
    for (int i = 0; i < 8; ++i) {
      const int c = (i * 64 + lane) * 4;
      float4 gg = *(const float4*)(g + c), bb = *(const float4*)(b + c);
      float4 r = make_float4(v[i].x * rstd * gg.x + bb.x, v[i].y * rstd * gg.y + bb.y, v[i].z * rstd * gg.z + bb.z, v[i].w * rstd * gg.w + bb.w);
      *(float4*)(zr + c) = r;
      *(uint2*)(p.xb() + (size_t)row * DM + c) = make_uint2(pack2(r.x, r.y), pack2(r.z, r.w));
    }
  }
}

template <int DK, int DV, int MODE, int QSN>
__device__ void attn_item(const u16* __restrict__ Qp, int ldq, const u16* __restrict__ Kp, int ldk, const u16* __restrict__ Vt, int ldv,
                          int t_first, int t_last, int t_diag, float zscale, int q0, const u16* __restrict__ gate, u16* __restrict__ outp,
                          char* smem, int wv, int nseg = 1, int seg = 0, float* part = nullptr, unsigned* cnt = nullptr) {
  constexpr int VST = 72, KCH = DK / 8;
  constexpr int NKR = (64 * KCH) / NT, NVR = (DV * 8) / NT, NST = DK / 32, NDS = DV / 16;
  u16* Ks = (u16*)smem;
  u16* Vs = Ks + 64 * DK;
  const int tid = tid_of(wv);
  asm volatile("" : "+s"(t_last));
  const int w = wv, lane = tid & 63, fr = lane & 15, fq = lane >> 4;

  const int fqs = (fq ^ ((fr >> 3) << 1)) * 16;
  constexpr int NSR = NST;
  bf16x8 qf[2][NSR];
  bf16x8* Qr = (bf16x8*)(smem + MLA_QR_OFF) + (w * 4) * 64 + lane;
#pragma unroll
  for (int qs = 0; qs < QSN; ++qs)
#pragma unroll
    for (int st = 0; st < NST; ++st) {
      bf16x8 v = *(const bf16x8*)(Qp + (unsigned)((w * (16 * QSN) + qs * 16 + fr) * ldq + st * 32 + fq * 8));
      if (st < NSR) qf[qs][st < NSR ? st : 0] = v;
      else Qr[(qs * 2 + (st - NSR)) * 64] = v;
    }

  f32x4 o[NDS][2];
#pragma unroll
  for (int ds = 0; ds < NDS; ++ds) { o[ds][0] = f32x4{0.f, 0.f, 0.f, 0.f}; o[ds][1] = f32x4{0.f, 0.f, 0.f, 0.f}; }
  float mrow[2] = {-1e30f, -1e30f};
  float lrow[2] = {0.f, 0.f};

  uint4 kk0, kk1, kk2, kk3, kk4, kk5, vv0, vv1, vv2, vv3;
#define KLOAD(i, T) if constexpr (NKR > i) { const int c_ = tid + NT * i, row_ = c_ / KCH, cc_ = c_ % KCH; kk##i = *(const uint4*)((Kp + (size_t)(T) * 64 * ldk) + (unsigned)(row_ * ldk + cc_ * 8)); }
#define KSTORE(i) if constexpr (NKR > i) { const int c_ = tid + NT * i, row_ = c_ / KCH, cc_ = c_ % KCH; \
    *(uint4*)((char*)Ks + (cc_ >> 2) * 4096 + row_ * 64 + (((cc_ & 3) ^ (((row_ >> 3) & 1) << 1)) * 16)) = kk##i; }
#define VLOAD(i, T) if constexpr (NVR > i) { const int c_ = tid + NT * i, dv_ = c_ >> 3, cc_ = c_ & 7; vv##i = *(const uint4*)((Vt + (size_t)(T) * (DV * 64)) + (unsigned)(dv_ * 64 + cc_ * 8)); }
#define VSTORE(i) if constexpr (NVR > i) { const int c_ = tid + NT * i, dv_ = c_ >> 3, cc_ = c_ & 7; *(uint4*)(Vs + dv_ * VST + cc_ * 8) = vv##i; }
#define load_k(T) do { KLOAD(0, T) KLOAD(1, T) KLOAD(2, T) KLOAD(3, T) KLOAD(4, T) KLOAD(5, T) } while (0)
#define load_v(T) do { VLOAD(0, T) VLOAD(1, T) VLOAD(2, T) VLOAD(3, T) } while (0)
#define store_tile() do { KSTORE(0) KSTORE(1) KSTORE(2) KSTORE(3) KSTORE(4) KSTORE(5) VSTORE(0) VSTORE(1) VSTORE(2) VSTORE(3) } while (0)

#define MLA_ISSUE_K(T, KB) do { char* kb_ = smem + (KB) * 24576; \
    _Pragma("unroll") for (int i_ = 0; i_ < 3; ++i_) { const int P_ = tid + NT * i_, st_ = P_ >> 8, r_ = (P_ >> 2) & 63, q_ = (P_ & 3) ^ (((r_ >> 3) & 1) << 1); \
      __builtin_amdgcn_global_load_lds((const unsigned*)((Kp + (size_t)(T) * 64 * ldk) + (unsigned)(r_ * ldk + (st_ * 4 + q_) * 8)), (LAS unsigned*)(kb_ + P_ * 16), 16, 0, 0); } } while (0)
#define MLA_ISSUE_V(T, VB) do { char* vb_ = smem + MLA_V_OFF + (VB) * 16384; \
    _Pragma("unroll") for (int i_ = 0; i_ < 2; ++i_) { const int P_ = tid + NT * i_, dv_ = P_ >> 3, c_ = (P_ & 7) ^ ((dv_ >> 1) & 7); \
      __builtin_amdgcn_global_load_lds((const unsigned*)((Vt + (size_t)(T) * 8192) + (unsigned)(dv_ * 64 + c_ * 8)), (LAS unsigned*)(vb_ + P_ * 16), 16, 0, 0); } } while (0)

  volatile int* flg = (volatile int*)(smem + CTL_OFF) + 8;
  if (MODE == 2 && tid == 0) flg[0] = 0;
  int it = 0;
  int t = (MODE == 2) ? t_last : t_first;
  int buf = 0, vbuf = 0;
  if constexpr (MODE == 0) {
    MLA_ISSUE_K(t, 0); MLA_ISSUE_V(t, 0);
    if (t < t_last) { MLA_ISSUE_K(t + 1, 1); MLA_ISSUE_V(t + 1, 1); }
  } else {
    load_k(t);
    load_v(t);
  }
  while (true) {
    const int tn = (MODE == 2) ? t - 1 : t + 1;
    const bool more = (MODE == 2) ? (t > 0) : (t < t_last);
    if constexpr (MODE == 0) {
      if (more) asm volatile("s_waitcnt vmcnt(5)" ::: "memory"); else asm volatile("s_waitcnt vmcnt(0)" ::: "memory");
      if (t + 2 <= t_last) MLA_ISSUE_K(t + 2, (buf + 2) & 3);
      __builtin_amdgcn_s_barrier();
      asm volatile("" ::: "memory");
      if (t + 2 <= t_last) MLA_ISSUE_V(t + 2, vbuf == 0 ? 2 : vbuf - 1);
    } else {
      store_tile();
      __syncthreads();
      if (MODE == 2 && tid == 0) flg[(it & 1) ^ 1] = 0;
      if (MODE != 2 && more) { load_k(tn); load_v(tn); }
    }
    const char* Kc = (MODE == 0) ? (const char*)(smem + (buf & 3) * 24576) : (const char*)Ks;
    const char* Vc = (const char*)(smem + MLA_V_OFF + vbuf * 16384);
    bool active = true;
    if (MODE == 0) active = (t <= t_diag + (w >> 1));
    if (MODE == 2) active = (t <= t_diag + (w >> 2));
    if (MODE != 2 && active) {
      f32x4 s[4][2];
#pragma unroll
      for (int ks = 0; ks < 4; ++ks) { s[ks][0] = f32x4{0.f, 0.f, 0.f, 0.f}; s[ks][1] = f32x4{0.f, 0.f, 0.f, 0.f}; }
#pragma unroll
      for (int st = 0; st < NST; ++st) {
#pragma unroll
        for (int ks = 0; ks < 4; ++ks) {
          bf16x8 kf = *(const bf16x8*)(Kc + st * 4096 + (ks * 16 + fr) * 64 + fqs);
          if (st < NSR) {
            s[ks][0] = mfma16(kf, qf[0][st < NSR ? st : 0], s[ks][0]);
            s[ks][1] = mfma16(kf, qf[1][st < NSR ? st : 0], s[ks][1]);
          } else {
            s[ks][0] = mfma16(kf, Qr[(st - NSR) * 64], s[ks][0]);
            s[ks][1] = mfma16(kf, Qr[(2 + st - NSR) * 64], s[ks][1]);
          }
        }
      }
      {
#pragma unroll
        for (int qs = 0; qs < 2; ++qs) {
          float mx = -1e30f;
#pragma unroll
          for (int ks = 0; ks < 4; ++ks)
#pragma unroll
            for (int j = 0; j < 4; ++j) mx = fmaxf(mx, s[ks][qs][j]);
          mx *= zscale;
          mx = xmax16(mx);
          mx = xmax32(mx);
          const bool bump = __builtin_amdgcn_ballot_w64(mx > mrow[qs] + 8.0f) != 0ull;
          float ls = 0.f;
          if (bump) {
            const float mn = fmaxf(mrow[qs], mx);
            const float alpha = __builtin_amdgcn_exp2f(mrow[qs] - mn);
            mrow[qs] = mn;
            lrow[qs] *= alpha;
#pragma unroll
            for (int ds = 0; ds < NDS; ++ds) o[ds][qs] *= alpha;
          }
          const float mref = mrow[qs];
#pragma unroll
          for (int ks = 0; ks < 4; ++ks)
#pragma unroll
            for (int j = 0; j < 4; ++j) {
              float pv = __builtin_amdgcn_exp2f(s[ks][qs][j] * zscale - mref);
              ls += pv;
              s[ks][qs][j] = pv;
            }
          lrow[qs] += ls;
        }
      }
      bf16x8 pf[2][2];
#pragma unroll
      for (int qs = 0; qs < 2; ++qs)
#pragma unroll
        for (int u = 0; u < 2; ++u) {
          uint4 pk;
          pk.x = pack2(s[2 * u][qs][0], s[2 * u][qs][1]);
          pk.y = pack2(s[2 * u][qs][2], s[2 * u][qs][3]);
          pk.z = pack2(s[2 * u + 1][qs][0], s[2 * u + 1][qs][1]);
          pk.w = pack2(s[2 * u + 1][qs][2], s[2 * u + 1][qs][3]);
          pf[qs][u] = *(bf16x8*)&pk;
        }
#pragma unroll
      for (int u = 0; u < 2; ++u) {
        bf16x8 vfr[NDS];
#pragma unroll
        for (int ds = 0; ds < NDS; ++ds) {
          if constexpr (MODE == 0) vfr[ds] = *(const bf16x8*)(Vc + (ds * 16 + fr) * 128 + (((u * 4 + fq) ^ ((fr >> 1) & 7)) * 16));
          else vfr[ds] = *(const bf16x8*)(Vs + (ds * 16 + fr) * VST + u * 32 + fq * 8);
        }
#pragma unroll
        for (int ds = 0; ds < NDS; ++ds) {
          o[ds][0] = mfma16(vfr[ds], pf[0][u], o[ds][0]);
          o[ds][1] = mfma16(vfr[ds], pf[1][u], o[ds][1]);
        }
      }
    }
    if (MODE == 2 && active) {
#pragma unroll
      for (int qs = 0; qs < QSN; ++qs) {
        f32x4 s1[4];
#pragma unroll
        for (int ks = 0; ks < 4; ++ks) s1[ks] = f32x4{0.f, 0.f, 0.f, 0.f};
#pragma unroll
        for (int st = 0; st < NST; ++st) {
#pragma unroll
          for (int ks = 0; ks < 4; ++ks) {
            bf16x8 kf = *(const bf16x8*)(Kc + st * 4096 + (ks * 16 + fr) * 64 + fqs);
            s1[ks] = mfma16(kf, qf[qs][st], s1[ks]);
          }
        }
        const int tq = q0 + w * (16 * QSN) + qs * 16 + fr;
        float running = lrow[qs];
#pragma unroll
        for (int ks = 3; ks >= 0; --ks) {
          float l1[4], lb[4];
#pragma unroll
          for (int j = 0; j < 4; ++j) {
            const float z = s1[ks][j] * zscale;
            const float e = __expf(-fabsf(z));
            const float sp = fmaxf(z, 0.f) + __logf(1.f + e);
            const int key = t * 64 + ks * 16 + fq * 4 + j;
            l1[j] = (key < tq) ? -sp : 0.f;
            lb[j] = z - sp;
          }
          const float p4 = (l1[0] + l1[1]) + (l1[2] + l1[3]);
          const float x16 = shx(p4, lane, 16);
          const float a2 = p4 + x16;
          const float x32 = shx(a2, lane, 32);
          const float tot = a2 + x32;
          const float gt = ((fq & 1) == 0 ? x16 : 0.f) + ((fq & 2) == 0 ? x32 : 0.f);
          const float s3 = running + gt;
          const float s2 = s3 + l1[3];
          const float s1_ = s2 + l1[2];
          const float s0 = s1_ + l1[1];
          s1[ks][0] = (l1[0] < 0.f) ? __expf(lb[0] + s0) : 0.f;
          s1[ks][1] = (l1[1] < 0.f) ? __expf(lb[1] + s1_) : 0.f;
          s1[ks][2] = (l1[2] < 0.f) ? __expf(lb[2] + s2) : 0.f;
          s1[ks][3] = (l1[3] < 0.f) ? __expf(lb[3] + s3) : 0.f;
          running += tot;
        }
        lrow[qs] = running;
        asm volatile("" ::: "memory");
#pragma unroll
        for (int u = 0; u < 2; ++u) {
          uint4 pk;
          pk.x = pack2(s1[2 * u][0], s1[2 * u][1]);
          pk.y = pack2(s1[2 * u][2], s1[2 * u][3]);
          pk.z = pack2(s1[2 * u + 1][0], s1[2 * u + 1][1]);
          pk.w = pack2(s1[2 * u + 1][2], s1[2 * u + 1][3]);
          bf16x8 pf1 = *(bf16x8*)&pk;
          bf16x8 vfr[NDS];
#pragma unroll
          for (int ds = 0; ds < NDS; ++ds) vfr[ds] = *(const bf16x8*)(Vs + (ds * 16 + fr) * VST + u * 32 + fq * 8);
#pragma unroll
          for (int ds = 0; ds < NDS; ++ds) o[ds][qs] = mfma16(vfr[ds], pf1, o[ds][qs]);
        }
        asm volatile("" ::: "memory");
        __builtin_amdgcn_sched_barrier(0);
      }
    }
    if (MODE == 2) {
      __builtin_amdgcn_sched_barrier(0);
      if (more) { load_k(tn); load_v(tn); }
      const int cont = (more && (lrow[0] >= -104.f || (QSN > 1 && lrow[1] >= -104.f))) ? 1 : 0;
      if (lane == 0 && __builtin_amdgcn_ballot_w64(cont != 0) != 0ull) flg[it & 1] = 1;
      __syncthreads();
      if (!flg[it & 1]) break;
      ++it;
    } else if (MODE == 1) {
      __syncthreads();
      if (!more) break;
    } else {
      if (!more) break;
      ++buf;
      vbuf = (vbuf == 2) ? 0 : vbuf + 1;
    }
    t = tn;
  }
  if (MODE == 0 && nseg > 1) {
    typedef unsigned long long u64;
    volatile int* ctlw = (volatile int*)(smem + CTL_OFF);
    {
      u64* po = (u64*)(part + (size_t)seg * (6 * (PART_BYTES / 4))) + (size_t)(w * 34) * 64 + lane;
#pragma unroll
      for (int ds = 0; ds < NDS; ++ds)
#pragma unroll
        for (int qs = 0; qs < 2; ++qs) {
          const f32x4 v = o[ds][qs];
          const u64 lo = ((u64)__float_as_uint(v[1]) << 32) | __float_as_uint(v[0]), hi = ((u64)__float_as_uint(v[3]) << 32) | __float_as_uint(v[2]);
          __hip_atomic_store(po + ((ds * 2 + qs) * 2 + 0) * 64, lo, __ATOMIC_RELAXED, __HIP_MEMORY_SCOPE_AGENT);
          __hip_atomic_store(po + ((ds * 2 + qs) * 2 + 1) * 64, hi, __ATOMIC_RELAXED, __HIP_MEMORY_SCOPE_AGENT);
        }
      __hip_atomic_store(po + 32 * 64, ((u64)__float_as_uint(mrow[1]) << 32) | __float_as_uint(mrow[0]), __ATOMIC_RELAXED, __HIP_MEMORY_SCOPE_AGENT);
      __hip_atomic_store(po + 33 * 64, ((u64)__float_as_uint(lrow[1]) << 32) | __float_as_uint(lrow[0]), __ATOMIC_RELAXED, __HIP_MEMORY_SCOPE_AGENT);
    }
    asm volatile("s_waitcnt vmcnt(0)" ::: "memory");
    __syncthreads();
    if (tid == 0) ctlw[1] = (int)atomicAdd(cnt, 1u);
    __syncthreads();
    const int rank = __builtin_amdgcn_readfirstlane(ctlw[1]);
    if (rank != nseg - 1) return;
    for (int s2 = 0; s2 < nseg; ++s2) {
      if (s2 == seg) continue;
      u64* po = (u64*)(part + (size_t)s2 * (6 * (PART_BYTES / 4))) + (size_t)(w * 34) * 64 + lane;
      const u64 m2p = __hip_atomic_load(po + 32 * 64, __ATOMIC_RELAXED, __HIP_MEMORY_SCOPE_AGENT);
      const u64 l2p = __hip_atomic_load(po + 33 * 64, __ATOMIC_RELAXED, __HIP_MEMORY_SCOPE_AGENT);
#pragma unroll
      for (int qs = 0; qs < 2; ++qs) {
        const float m2 = __uint_as_float((unsigned)(m2p >> (32 * qs))), l2 = __uint_as_float((unsigned)(l2p >> (32 * qs)));
        const float mn = fmaxf(mrow[qs], m2);
        const float ca = __builtin_amdgcn_exp2f(mrow[qs] - mn), cb = __builtin_amdgcn_exp2f(m2 - mn);
        mrow[qs] = mn;
        lrow[qs] = lrow[qs] * ca + l2 * cb;
        u64 plo[NDS], phi[NDS];
#pragma unroll
        for (int ds = 0; ds < NDS; ++ds) {
          plo[ds] = __hip_atomic_load(po + ((ds * 2 + qs) * 2 + 0) * 64, __ATOMIC_RELAXED, __HIP_MEMORY_SCOPE_AGENT);
          phi[ds] = __hip_atomic_load(po + ((ds * 2 + qs) * 2 + 1) * 64, __ATOMIC_RELAXED, __HIP_MEMORY_SCOPE_AGENT);
        }
#pragma unroll
        for (int ds = 0; ds < NDS; ++ds) {
          f32x4 o2;
          o2[0] = __uint_as_float((unsigned)plo[ds]); o2[1] = __uint_as_float((unsigned)(plo[ds] >> 32));
          o2[2] = __uint_as_float((unsigned)phi[ds]); o2[3] = __uint_as_float((unsigned)(phi[ds] >> 32));
          o[ds][qs] = o[ds][qs] * ca + o2 * cb;
        }
      }
    }
  }
  int fr_e = fr, fq_e = fq;
  asm volatile("" : "+v"(fr_e), "+v"(fq_e));
#pragma unroll
  for (int qs = 0; qs < QSN; ++qs) {
    float inv = 1.f;
    if (MODE != 2) {
      float lsum = lrow[qs];
      lsum = xsum16(lsum);
      lsum = xsum32(lsum);
      inv = 1.f / lsum;
    }
    const int row = w * (16 * QSN) + qs * 16 + fr_e;
#pragma unroll
    for (int ds = 0; ds < NDS; ++ds) {
      const int dv = ds * 16 + fq_e * 4;
      uint2 g2 = *(const uint2*)(gate + (unsigned)(row * DIN + dv));
      float v0 = o[ds][qs][0] * inv * bflo(g2.x), v1 = o[ds][qs][1] * inv * bfhi(g2.x);
      float v2 = o[ds][qs][2] * inv * bflo(g2.y), v3 = o[ds][qs][3] * inv * bfhi(g2.y);
      *(uint2*)(outp + (unsigned)(row * DM + dv)) = make_uint2(pack2(v0, v1), pack2(v2, v3));
    }
  }
}

#undef KLOAD
#undef KSTORE
#undef VLOAD
#undef VSTORE
#undef load_k
#undef load_v
#undef store_tile

#undef KLOAD
#undef KSTORE
#undef VLOAD
#undef VSTORE
#undef load_k
#undef load_v
#undef store_tile
#undef MLA_ISSUE_K
#undef MLA_ISSUE_V

__device__ void gmlp_item(const Params& p, int l, int n, int g, char* smem, int wv) {
  constexpr int WST = 136;
  u16* Ws = (u16*)smem;
  u16* Bs = Ws + 128 * WST;
  float* s_mu = (float*)(Bs + 128 * WST);
  float* s_rs = s_mu + 128;
  const int tid = tid_of(wv);
  const int w = wv, lane = tid & 63, fr = lane & 15, fq = lane >> 4;
  const int row0 = n * 128;
  {
    const int r = tid >> 2, qt = tid & 3;
    const u16* src = p.h() + (size_t)(row0 + r) * DIN + C_SGV + qt * 128;
    uint4 v[16];
#pragma unroll
    for (int i = 0; i < 16; ++i) v[i] = *(const uint4*)(src + i * 8);
    float s = 0.f, q = 0.f;
#pragma unroll
    for (int i = 0; i < 16; ++i) {
      const unsigned ww[4] = {v[i].x, v[i].y, v[i].z, v[i].w};
#pragma unroll
      for (int k = 0; k < 4; ++k) { float a = bflo(ww[k]), b = bfhi(ww[k]); s += a + b; q += a * a + b * b; }
    }
    s += shx(s, lane, 1); q += shx(q, lane, 1);
    s += shx(s, lane, 2); q += shx(q, lane, 2);
    const float mu = s * (1.f / 512.f);
    const float var = fmaxf(q * (1.f / 512.f) - mu * mu, 0.f);
    if (qt == 0) { s_mu[r] = mu; s_rs[r] = rsqrtf(var + 1e-5f); }
  }
  {
    const float* wsrc = p.sg_w + (size_t)(l * 4 + g) * 128 * 128;
    float4 wv4[8];
#pragma unroll
    for (int i = 0; i < 8; ++i) { int id = tid + NT * i; wv4[i] = *(const float4*)(wsrc + (id >> 5) * 128 + (id & 31) * 4); }
#pragma unroll
    for (int i = 0; i < 8; ++i) {
      int id = tid + NT * i, tt = id >> 5, s4 = (id & 31) * 4;
      float4 v = wv4[i];
      if (tt < 64 && s4 >= 64) v = make_float4(0.f, 0.f, 0.f, 0.f);
      *(uint2*)(Ws + tt * WST + s4) = make_uint2(pack2(v.x, v.y), pack2(v.z, v.w));
    }
  }
  const int bs_ = tid >> 2, bc_ = (tid & 3) * 32;
  uint4 bch[4];
#pragma unroll
  for (int i = 0; i < 4; ++i) bch[i] = *(const uint4*)(p.h() + (size_t)(row0 + bs_) * DIN + C_SGV + g * 128 + bc_ + i * 8);
  float4 lgv[8], lbv[8];
#pragma unroll
  for (int i = 0; i < 8; ++i) { lgv[i] = *(const float4*)(p.sg_ln_g + (size_t)l * 512 + g * 128 + bc_ + i * 4); lbv[i] = *(const float4*)(p.sg_ln_b + (size_t)l * 512 + g * 128 + bc_ + i * 4); }
  const int tt_e = w * 16 + fr;
  const float bias_e = p.sg_b[(size_t)(l * 4 + g) * 128 + tt_e];
  uint2 u2e[8], g2e[8];
#pragma unroll
  for (int ns = 0; ns < 8; ++ns) {
    const u16* hr = p.h() + (size_t)(row0 + tt_e) * DIN + g * 128 + ns * 16 + fq * 4;
    u2e[ns] = *(const uint2*)(hr + C_SGU); g2e[ns] = *(const uint2*)(hr + C_GB);
  }
  __syncthreads();
  {
    const float mu = s_mu[bs_], rs = s_rs[bs_];
#pragma unroll
    for (int i = 0; i < 4; ++i) {
      const int c0 = bc_ + i * 8;
      const float4 g0 = lgv[2 * i], g1 = lgv[2 * i + 1], b0 = lbv[2 * i], b1 = lbv[2 * i + 1];
      const unsigned ww[4] = {bch[i].x, bch[i].y, bch[i].z, bch[i].w};
      const float gg[8] = {g0.x, g0.y, g0.z, g0.w, g1.x, g1.y, g1.z, g1.w}, bb[8] = {b0.x, b0.y, b0.z, b0.w, b1.x, b1.y, b1.z, b1.w};
#pragma unroll
      for (int k = 0; k < 4; ++k) {
        const float v0 = (bflo(ww[k]) - mu) * rs * gg[2 * k] + bb[2 * k], v1 = (bfhi(ww[k]) - mu) * rs * gg[2 * k + 1] + bb[2 * k + 1];
        const unsigned pk = pack2(v0, v1);
        Bs[(c0 + 2 * k) * WST + bs_] = (u16)(pk & 0xffffu);
        Bs[(c0 + 2 * k + 1) * WST + bs_] = (u16)(pk >> 16);
      }
    }
  }
  __syncthreads();
  f32x4 acc[8];
#pragma unroll
  for (int ns = 0; ns < 8; ++ns) acc[ns] = f32x4{0.f, 0.f, 0.f, 0.f};
#pragma unroll
  for (int st = 0; st < 4; ++st) {
    const bf16x8 wf = *(const bf16x8*)(Ws + (w * 16 + fr) * WST + st * 32 + fq * 8);
#pragma unroll
    for (int ns = 0; ns < 8; ++ns) {
      bf16x8 bfv = *(const bf16x8*)(Bs + (ns * 16 + fr) * WST + st * 32 + fq * 8);
      acc[ns] = mfma16(bfv, wf, acc[ns]);
    }
  }
  {
    const int tt = w * 16 + fr;
    const float bias = bias_e;
    const u16* hrow = p.h() + (size_t)(row0 + tt) * DIN;
#pragma unroll
    for (int ns = 0; ns < 8; ++ns) {
      const int c = g * 128 + ns * 16 + fq * 4;
      const uint2 u2 = u2e[ns], g2 = g2e[ns];
      float v0 = bflo(u2.x) * (acc[ns][0] + bias) * bflo(g2.x);
      float v1 = bfhi(u2.x) * (acc[ns][1] + bias) * bfhi(g2.x);
      float v2 = bflo(u2.y) * (acc[ns][2] + bias) * bflo(g2.y);
      float v3 = bfhi(u2.y) * (acc[ns][3] + bias) * bfhi(g2.y);
      *(uint2*)(p.yin() + (size_t)(row0 + tt) * DM + 768 + c) = make_uint2(pack2(v0, v1), pack2(v2, v3));
    }
  }
  __syncthreads();
}

__device__ const unsigned g_mla_items[288] = {
  0x7e0101fu, 0x7e0103fu, 0x7e0105fu, 0x7e0107fu, 0x7e0109fu, 0x7e010bfu, 0xff0111fu, 0xff0113fu, 0xff0115fu, 0xff0117fu, 0xff0119fu, 0xff011bfu,
  0x7e0080fu, 0x7e0082fu, 0x7e0084fu, 0x7e0086fu, 0x7e0088fu, 0x7e008afu, 0x7a0101eu, 0x7a0103eu, 0x7a0105eu, 0x7a0107eu, 0x7a0109eu, 0x7a010beu,
  0xf6f911eu, 0xf6f913eu, 0xf6f915eu, 0xf6f917eu, 0xf6f919eu, 0xf6f91beu, 0x760101du, 0x760103du, 0x760105du, 0x760107du, 0x760109du, 0x76010bdu,
  0xeef111du, 0xeef113du, 0xeef115du, 0xeef117du, 0xeef119du, 0xeef11bdu, 0x760080eu, 0x760082eu, 0x760084eu, 0x760086eu, 0x760088eu, 0x76008aeu,
  0x720101cu, 0x720103cu, 0x720105cu, 0x720107cu, 0x720109cu, 0x72010bcu, 0xe6e911cu, 0xe6e913cu, 0xe6e915cu, 0xe6e917cu, 0xe6e919cu, 0xe6e91bcu,
  0x6e0101bu, 0x6e0103bu, 0x6e0105bu, 0x6e0107bu, 0x6e0109bu, 0x6e010bbu, 0xdee111bu, 0xdee113bu, 0xdee115bu, 0xdee117bu, 0xdee119bu, 0xdee11bbu,
  0x6e0080du, 0x6e0082du, 0x6e0084du, 0x6e0086du, 0x6e0088du, 0x6e008adu, 0x6a0101au, 0x6a0103au, 0x6a0105au, 0x6a0107au, 0x6a0109au, 0x6a010bau,
  0xd6d911au, 0xd6d913au, 0xd6d915au, 0xd6d917au, 0xd6d919au, 0xd6d91bau, 0x6601019u, 0x6601039u, 0x6601059u, 0x6601079u, 0x6601099u, 0x66010b9u,
  0xced1119u, 0xced1139u, 0xced1159u, 0xced1179u, 0xced1199u, 0xced11b9u, 0x660080cu, 0x660082cu, 0x660084cu, 0x660086cu, 0x660088cu, 0x66008acu,
  0x6201018u, 0x6201038u, 0x6201058u, 0x6201078u, 0x6201098u, 0x62010b8u, 0xc6c9118u, 0xc6c9138u, 0xc6c9158u, 0xc6c9178u, 0xc6c9198u, 0xc6c91b8u,
  0x5e01017u, 0x5e01037u, 0x5e01057u, 0x5e01077u, 0x5e01097u, 0x5e010b7u, 0xbec1117u, 0xbec1137u, 0xbec1157u, 0xbec1177u, 0xbec1197u, 0xbec11b7u,
  0x5e0080bu, 0x5e0082bu, 0x5e0084bu, 0x5e0086bu, 0x5e0088bu, 0x5e008abu, 0x5a01016u, 0x5a01036u, 0x5a01056u, 0x5a01076u, 0x5a01096u, 0x5a010b6u,
  0xb6b9116u, 0xb6b9136u, 0xb6b9156u, 0xb6b9176u, 0xb6b9196u, 0xb6b91b6u, 0x5601015u, 0x5601035u, 0x5601055u, 0x5601075u, 0x5601095u, 0x56010b5u,
  0xaeb1115u, 0xaeb1135u, 0xaeb1155u, 0xaeb1175u, 0xaeb1195u, 0xaeb11b5u, 0x560080au, 0x560082au, 0x560084au, 0x560086au, 0x560088au, 0x56008aau,
  0x5201014u, 0x5201034u, 0x5201054u, 0x5201074u, 0x5201094u, 0x52010b4u, 0xa6a9114u, 0xa6a9134u, 0xa6a9154u, 0xa6a9174u, 0xa6a9194u, 0xa6a91b4u,
  0x4e01013u, 0x4e01033u, 0x4e01053u, 0x4e01073u, 0x4e01093u, 0x4e010b3u, 0x9ea1113u, 0x9ea1133u, 0x9ea1153u, 0x9ea1173u, 0x9ea1193u, 0x9ea11b3u,
  0x4e00809u, 0x4e00829u, 0x4e00849u, 0x4e00869u, 0x4e00889u, 0x4e008a9u, 0x4a01012u, 0x4a01032u, 0x4a01052u, 0x4a01072u, 0x4a01092u, 0x4a010b2u,
  0x9699112u, 0x9699132u, 0x9699152u, 0x9699172u, 0x9699192u, 0x96991b2u, 0x4601011u, 0x4601031u, 0x4601051u, 0x4601071u, 0x4601091u, 0x46010b1u,
  0x8e91111u, 0x8e91131u, 0x8e91151u, 0x8e91171u, 0x8e91191u, 0x8e911b1u, 0x4600808u, 0x4600828u, 0x4600848u, 0x4600868u, 0x4600888u, 0x46008a8u,
  0x4201010u, 0x4201030u, 0x4201050u, 0x4201070u, 0x4201090u, 0x42010b0u, 0x8689110u, 0x8689130u, 0x8689150u, 0x8689170u, 0x8689190u, 0x86891b0u,
  0x3e00807u, 0x3e00827u, 0x3e00847u, 0x3e00867u, 0x3e00887u, 0x3e008a7u, 0x3600806u, 0x3600826u, 0x3600846u, 0x3600866u, 0x3600886u, 0x36008a6u,
  0x2e00805u, 0x2e00825u, 0x2e00845u, 0x2e00865u, 0x2e00885u, 0x2e008a5u, 0x2600804u, 0x2600824u, 0x2600844u, 0x2600864u, 0x2600884u, 0x26008a4u,
  0x1e00803u, 0x1e00823u, 0x1e00843u, 0x1e00863u, 0x1e00883u, 0x1e008a3u, 0x1600802u, 0x1600822u, 0x1600842u, 0x1600862u, 0x1600882u, 0x16008a2u,
  0xe00801u, 0xe00821u, 0xe00841u, 0xe00861u, 0xe00881u, 0xe008a1u, 0x600800u, 0x600820u, 0x600840u, 0x600860u, 0x600880u, 0x6008a0u,
};
__device__ const unsigned char g_slot_base[32] = {0, 0, 0, 0, 0, 0, 0, 0, 0, 0, 0, 0, 0, 0, 0, 0, 0, 2, 4, 6, 8, 10, 12, 14, 16, 18, 20, 22, 24, 26, 28, 30};

#ifndef PROBE_PHASE
#define PROBE_PHASE 0
#endif
#define PROBE_BEGIN(k) unsigned long long pt0_##k = 0; if (PROBE_PHASE == k) pt0_##k = __builtin_amdgcn_s_memrealtime();
#define PROBE_END(k) if (PROBE_PHASE == k) { const unsigned long long dt_ = __builtin_amdgcn_s_memrealtime() - pt0_##k, t1_ = __builtin_amdgcn_s_memrealtime(); \
    while (__builtin_amdgcn_s_memrealtime() - t1_ < dt_) __builtin_amdgcn_s_sleep(8); }
__device__ void phaseC(const Params& p, int l, int ci, char* smem, int wv) {
  volatile int* ctl = (volatile int*)(smem + CTL_OFF);
  constexpr int N_MLA = 288, N_SB = 256, N_MEM = 128, N_G = 256;
  constexpr int N_ALL = N_MLA + N_SB + N_MEM + N_G;
  while (true) {
    __syncthreads();
    if (tid_of(wv) == 0) ctl[0] = (int)atomicAdd(&p.ctr()[ci], 1u);
    __syncthreads();
    const int qi = __builtin_amdgcn_readfirstlane(ctl[0]);
    if (qi >= N_ALL) break;
    const int item = qi < N_MLA ? qi : qi < N_MLA + N_G ? qi + N_SB + N_MEM : qi - N_G;
    const int kind_ = item < N_MLA ? 7 : item < N_MLA + N_SB ? 8 : item < N_MLA + N_SB + N_MEM ? 9 : 10;
    unsigned long long it0_ = 0; if (PROBE_PHASE == kind_) it0_ = __builtin_amdgcn_s_memrealtime();
    if (item < N_MLA) {
      const unsigned wd = g_mla_items[item];
      const int qb = wd & 31, hd = (wd >> 5) & 7, seg = (wd >> 8) & 7, nseg = (wd >> 11) & 7, t0 = (wd >> 14) & 127, t1 = (wd >> 21) & 127;
      const int q0 = qb * 256;
      const int sbase = g_slot_base[qb];
      attn_item<192, 128, 0, 2>(p.q() + ((size_t)hd * SEQ + q0) * 192, 192, p.k() + (size_t)hd * SEQ * 192, 192,
                                p.vt() + (size_t)hd * 128 * SEQ, SEQ, t0, t1, 4 * qb, 1.0f, q0,
                                p.h() + (size_t)q0 * DIN + C_GA + hd * 128, p.yin() + (size_t)q0 * DM + hd * 128, smem, wv,
                                nseg, seg, p.part() + (size_t)(sbase * 6 + hd) * (PART_BYTES / 4), p.ctr() + 64 + (l * 32 + qb) * 6 + hd);
    } else if (item < N_MLA + N_SB) {
      const int it = item - N_MLA, qb = 63 - (it >> 2), hd = it & 3, q0 = qb * 128;
      attn_item<128, 128, 2, 1>(p.h() + (size_t)q0 * DIN + C_SBQ + hd * 128, DIN, p.h() + C_SBK + hd * 128, DIN,
                             p.vtsb() + (size_t)hd * 128 * SEQ, SEQ, 0, 2 * qb + 1, 2 * qb, 0.08838834764831845f, q0,
                             p.h() + (size_t)q0 * DIN + C_GC + hd * 128, p.yin() + (size_t)q0 * DM + 1280 + hd * 128, smem, wv);
    } else if (item < N_MLA + N_SB + N_MEM) {
      const int it = item - N_MLA - N_SB, qb = it >> 2, hd = it & 3, q0 = qb * 256;
      attn_item<64, 64, 1, 2>(p.h() + (size_t)q0 * DIN + C_MQ + hd * 64, DIN, p.mk() + (size_t)(l * 4 + hd) * 256 * 64, 64,
                           p.mvt() + (size_t)(l * 4 + hd) * 64 * 256, 256, 0, 3, 0, 0.125f * 1.4426950408889634f, q0,
                           p.h() + (size_t)q0 * DIN + C_GM + hd * 64, p.yin() + (size_t)q0 * DM + 1792 + hd * 64, smem, wv);
    } else {
      const int it = item - N_MLA - N_SB - N_MEM;
      gmlp_item(p, l, it >> 2, it & 3, smem, wv);
    }
    if (PROBE_PHASE == kind_) { const unsigned long long dt_ = __builtin_amdgcn_s_memrealtime() - it0_, t1_ = __builtin_amdgcn_s_memrealtime();
      while (__builtin_amdgcn_s_memrealtime() - t1_ < dt_) __builtin_amdgcn_s_sleep(8); }
  }
}

__global__ void __launch_bounds__(NT, 2) fwd_megakernel(Params p) {
  extern __shared__ __attribute__((aligned(16))) char smem[];
  volatile LAS unsigned* xst = (volatile LAS unsigned*)(smem + CTL_OFF + 16);
  const int wv = __builtin_amdgcn_readfirstlane(threadIdx.x >> 6);
  if (tid_of(wv) == 0) { xst[0] = 0u; xst[1] = 0u; }
  __syncthreads();
  const XcdBarrier xb = xcd_barrier_post(p.bar(), xst, wv);
#define grid_barrier() xcd_barrier(xb, wv)
  LAS unsigned char* glds = (LAS unsigned char*)smem;
  const int G = gridDim.x, B = blockIdx.x;
  PROBE_BEGIN(1)
  phase_prep(p, smem, wv);
  if (p.ws == nullptr) cg::this_grid().sync(); else grid_barrier();
  PROBE_END(1)
  for (int l = 0; l < NL; ++l) {
    int Bl = B, Gl = G, wvl = wv;
    asm volatile("" : "+s"(Bl), "+s"(Gl), "+s"(wvl));
    Params pl = p;
    { char* w_ = pl.ws; asm volatile("" : "+s"(w_)); pl.ws = w_; }
    PROBE_BEGIN(2)
    {
      pg8::StaticOrder S; S.init(SEQ, DINP, Gl, Bl);
      pg8::Gemm g{pl.xb(), pl.wt_in() + (size_t)l * DINP * DM, DM, DM, DM};
      EpiA E{pl, l};
      pg8::gemm_phase(glds, g, S, E, wvl);
    }
    if (l == 0) {
      __syncthreads();
      pg8::StaticOrder S; S.init(256, NL * 512, Gl, (Bl + 32) % Gl);
      pg8::Gemm g{pl.memb(), pl.wt_memkv(), DM, DM, DM};
      EpiMem E{pl};
      pg8::gemm_phase(glds, g, S, E, wvl);
    }
    grid_barrier();
    PROBE_END(2)
    PROBE_BEGIN(3)
    {
      pg8::StrideOrder Sq, Skv;
      if (Gl == 256) { Sq = pg8::StrideOrder{Bl, 0, Bl < 160 ? 1 : 0, 160}; Skv = pg8::StrideOrder{(Bl - 160) * 2, 1, Bl >= 160 ? 2 : 0, 192}; }
      else { Sq = pg8::StrideOrder{Bl, Gl, 1 << 20, 160}; Skv = pg8::StrideOrder{Bl, Gl, 1 << 20, 192}; }
      {
        pg8::Gemm g{pl.h() + C_CQ, pl.wt_uq() + (size_t)l * UQP * 512, DIN, 512, 512};
        EpiQ E{pl};
        pg8::gemm_phase(glds, g, Sq, E, wvl);
      }
      __syncthreads();
      {
        pg8::Gemm g{pl.h() + C_CKV, pl.wt_ukv() + (size_t)l * 1536 * 256, DIN, 256, 256};
        EpiKV E{pl};
        pg8::gemm_phase(glds, g, Skv, E, wvl);
      }
    }
    grid_barrier();
    PROBE_END(3)
    PROBE_BEGIN(4)
    phaseC(pl, l, l, smem, wvl);
    grid_barrier();
    PROBE_END(4)
    PROBE_BEGIN(5)
    {
      pg8::StaticOrder S; S.init(SEQ, DM, Gl, Bl);
      pg8::Gemm g{pl.yin(), pl.wt_out() + (size_t)l * DM * DM, DM, DM, DM};
      EpiDF E{pl, l, smem};
      pg8::gemm_phase(glds, g, S, E, wvl);
    }
    if (l + 1 < NL) grid_barrier();
    PROBE_END(5)
  }
}

extern "C" void kernel_launch(void* const* d_in, const int* in_sizes, int n_in, void* d_out, int out_size, void* d_ws,
                              size_t ws_size, hipStream_t stream) {
  static int grid_blocks = 0;
  if (!grid_blocks) {
    int dev = 0, cus = 0, per_cu = 0;
    (void)hipGetDevice(&dev);
    (void)hipDeviceGetAttribute(&cus, hipDeviceAttributeMultiprocessorCount, dev);
    (void)hipFuncSetAttribute((const void*)fwd_megakernel, hipFuncAttributeMaxDynamicSharedMemorySize, LDS_BYTES);
    (void)hipOccupancyMaxActiveBlocksPerMultiprocessor(&per_cu, fwd_megakernel, NT, LDS_BYTES);
    if (per_cu > 1) per_cu = 1;
    if (per_cu < 1) per_cu = 1;
    grid_blocks = cus * per_cu;
  }
  Params p{};
  p.x = (const float*)d_in[0]; p.mem = (const float*)d_in[1]; p.pos = (const int*)d_in[2]; p.w_in = (const float*)d_in[3];
  p.q_norm_g = (const float*)d_in[4]; p.w_uq = (const float*)d_in[5]; p.kv_norm_g = (const float*)d_in[6];
  p.w_ukv = (const float*)d_in[7]; p.sg_ln_g = (const float*)d_in[8]; p.sg_ln_b = (const float*)d_in[9];
  p.sg_w = (const float*)d_in[10]; p.sg_b = (const float*)d_in[11]; p.w_mem_k = (const float*)d_in[12];
  p.w_mem_v = (const float*)d_in[13]; p.w_out = (const float*)d_in[14]; p.ln_g = (const float*)d_in[15];
  p.ln_b = (const float*)d_in[16];
  p.out = (float*)d_out;
  p.ws = (char*)d_ws;
  (void)hipMemsetAsync(p.ws + OFF_BAR, 0, 16384, stream);
  void* args[] = {&p};
  hipError_t e = hipLaunchCooperativeKernel((const void*)fwd_megakernel, dim3(grid_blocks), dim3(NT), args, LDS_BYTES, stream);
  if (e != hipSuccess) fprintf(stderr, "cooperative launch failed: %s (grid %d)\n", hipGetErrorString(e), grid_blocks);
}
```

```cpp
#include <hip/hip_runtime.h>
#include <hip/hip_cooperative_groups.h>
#include <cstdio>
namespace cg = cooperative_groups;

typedef unsigned short u16;
using bf16x8 = __attribute__((ext_vector_type(8))) short;
using f32x4 = __attribute__((ext_vector_type(4))) float;
typedef __bf16 bf16x2_t __attribute__((ext_vector_type(2)));
typedef float f32x2_t __attribute__((ext_vector_type(2)));

#define SEQ 8192
#define DM 2048
#define DIN 5696
#define DINP 5888
#define UQP 1280
#define NL 4
#define NT 512

constexpr int GEMM_LDS = 131072;
constexpr int MLA_STAGE = 40960;
constexpr int MLA_QR_OFF = 3 * MLA_STAGE;
constexpr int CTL_OFF = MLA_QR_OFF + 32768;
constexpr int LDS_BYTES = CTL_OFF + 256;

constexpr int C_CQ = 0, C_CKV = 512, C_KPE = 768, C_GA = 832, C_SGU = 1600, C_SGV = 2112, C_GB = 2624,
              C_SBQ = 3136, C_SBK = 3648, C_SBV = 4160, C_GC = 4672, C_MQ = 5184, C_GM = 5440;

constexpr size_t al256(size_t x) { return (x + 255) & ~(size_t)255; }
constexpr size_t OFF_BAR = 0;
constexpr size_t OFF_CTR = OFF_BAR + al256(16384);
constexpr size_t OFF_SSQ = OFF_CTR + al256(8192);
constexpr size_t OFF_WT_IN = OFF_SSQ + al256((size_t)2 * SEQ * 4);
constexpr size_t OFF_WT_OUT = OFF_WT_IN + al256((size_t)NL * DINP * DM * 2);
constexpr size_t OFF_WT_UQ = OFF_WT_OUT + al256((size_t)NL * DM * DM * 2);
constexpr size_t OFF_WT_UKV = OFF_WT_UQ + al256((size_t)NL * UQP * 512 * 2);
constexpr size_t OFF_WT_MEMKV = OFF_WT_UKV + al256((size_t)NL * 1536 * 256 * 2);
constexpr size_t OFF_MEMB = OFF_WT_MEMKV + al256((size_t)NL * 512 * DM * 2);
constexpr size_t OFF_XB = OFF_MEMB + al256((size_t)256 * DM * 2);
constexpr size_t OFF_H = OFF_XB + al256((size_t)SEQ * DM * 2);
constexpr size_t OFF_Q = OFF_H + al256((size_t)SEQ * DIN * 2);
constexpr size_t OFF_K = OFF_Q + al256((size_t)6 * SEQ * 192 * 2);
constexpr size_t OFF_VT = OFF_K + al256((size_t)6 * SEQ * 192 * 2);
constexpr size_t OFF_VTSB = OFF_VT + al256((size_t)6 * 128 * SEQ * 2);
constexpr size_t OFF_YIN = OFF_VTSB + al256((size_t)4 * 128 * SEQ * 2);
constexpr size_t OFF_MK = OFF_YIN + al256((size_t)SEQ * DM * 2);
constexpr size_t OFF_MVT = OFF_MK + al256((size_t)NL * 4 * 256 * 64 * 2);
constexpr size_t OFF_COST = OFF_MVT + al256((size_t)NL * 4 * 64 * 256 * 2);
constexpr size_t OFF_SINT = OFF_COST + al256((size_t)SEQ * 32 * 4);
constexpr size_t OFF_LNSTAT = OFF_SINT + al256((size_t)SEQ * 32 * 4);
constexpr size_t OFF_LNX = OFF_LNSTAT + al256((size_t)SEQ * 2 * 4);
constexpr size_t OFF_PART = OFF_LNX + al256((size_t)32 * 8 * 256 * 8);
constexpr size_t PART_BYTES = 139264;
constexpr size_t WS_TOTAL = OFF_PART + al256((size_t)192 * PART_BYTES);
struct Params {
  const float* x; const float* mem; const int* pos; const float* w_in; const float* q_norm_g; const float* w_uq;
  const float* kv_norm_g; const float* w_ukv; const float* sg_ln_g; const float* sg_ln_b; const float* sg_w; const float* sg_b;
  const float* w_mem_k; const float* w_mem_v; const float* w_out; const float* ln_g; const float* ln_b;
  float* out;
  char* ws;
  __device__ __forceinline__ unsigned* bar() const { return (unsigned*)(ws + OFF_BAR); }
  __device__ __forceinline__ unsigned* ctr() const { return (unsigned*)(ws + OFF_CTR); }
  __device__ __forceinline__ float* ssq() const { return (float*)(ws + OFF_SSQ); }
  __device__ __forceinline__ u16* wt_in() const { return (u16*)(ws + OFF_WT_IN); }
  __device__ __forceinline__ u16* wt_out() const { return (u16*)(ws + OFF_WT_OUT); }
  __device__ __forceinline__ u16* wt_uq() const { return (u16*)(ws + OFF_WT_UQ); }
  __device__ __forceinline__ u16* wt_ukv() const { return (u16*)(ws + OFF_WT_UKV); }
  __device__ __forceinline__ u16* wt_memkv() const { return (u16*)(ws + OFF_WT_MEMKV); }
  __device__ __forceinline__ u16* memb() const { return (u16*)(ws + OFF_MEMB); }
  __device__ __forceinline__ u16* xb() const { return (u16*)(ws + OFF_XB); }
  __device__ __forceinline__ u16* h() const { return (u16*)(ws + OFF_H); }
  __device__ __forceinline__ u16* q() const { return (u16*)(ws + OFF_Q); }
  __device__ __forceinline__ u16* k() const { return (u16*)(ws + OFF_K); }
  __device__ __forceinline__ u16* vt() const { return (u16*)(ws + OFF_VT); }
  __device__ __forceinline__ u16* vtsb() const { return (u16*)(ws + OFF_VTSB); }
  __device__ __forceinline__ u16* yin() const { return (u16*)(ws + OFF_YIN); }
  __device__ __forceinline__ u16* mk() const { return (u16*)(ws + OFF_MK); }
  __device__ __forceinline__ u16* mvt() const { return (u16*)(ws + OFF_MVT); }
  __device__ __forceinline__ float* cosT() const { return (float*)(ws + OFF_COST); }
  __device__ __forceinline__ float* sinT() const { return (float*)(ws + OFF_SINT); }
  __device__ __forceinline__ float* part() const { return (float*)(ws + OFF_PART); }
  __device__ __forceinline__ float* lnstat() const { return (float*)(ws + OFF_LNSTAT); }
  __device__ __forceinline__ unsigned long long* lnx() const { return (unsigned long long*)(ws + OFF_LNX); }
};

__device__ __forceinline__ unsigned pack2(float a, float b) {
  f32x2_t v = {a, b};
  bf16x2_t r = __builtin_convertvector(v, bf16x2_t);
  return *(unsigned*)&r;
}
__device__ __forceinline__ u16 f2bf(float a) { return (u16)(pack2(a, 0.f) & 0xffffu); }
__device__ __forceinline__ float bflo(unsigned w) { return __uint_as_float(w << 16); }
__device__ __forceinline__ float bfhi(unsigned w) { return __uint_as_float(w & 0xffff0000u); }
__device__ __forceinline__ float bf2f(u16 h) { return __uint_as_float(((unsigned)h) << 16); }
__device__ __forceinline__ float silu_f(float x) { return x * __builtin_amdgcn_rcpf(1.f + __expf(-x)); }
__device__ __forceinline__ float gelu_f(float x) {
  float u = 0.7978845608028654f * (x + 0.044715f * x * x * x);
  float t = 1.f - 2.f * __builtin_amdgcn_rcpf(__expf(2.f * u) + 1.f);
  return 0.5f * x * (1.f + t);
}
__device__ __forceinline__ f32x4 mfma16(bf16x8 a, bf16x8 b, f32x4 c) {
  return __builtin_amdgcn_mfma_f32_16x16x32_bf16(a, b, c, 0, 0, 0);
}
__device__ __forceinline__ int vperm(int s) { return (s & 32) | (((s >> 2) & 3) << 3) | (((s >> 4) & 1) << 2) | (s & 3); }
__device__ __forceinline__ float xmax16(float v) { auto r = __builtin_amdgcn_permlane16_swap(__float_as_uint(v), __float_as_uint(v), false, false); return fmaxf(__uint_as_float(r[0]), __uint_as_float(r[1])); }
__device__ __forceinline__ float xmax32(float v) { auto r = __builtin_amdgcn_permlane32_swap(__float_as_uint(v), __float_as_uint(v), false, false); return fmaxf(__uint_as_float(r[0]), __uint_as_float(r[1])); }
__device__ __forceinline__ float xsum16(float v) { auto r = __builtin_amdgcn_permlane16_swap(__float_as_uint(v), __float_as_uint(v), false, false); return __uint_as_float(r[0]) + __uint_as_float(r[1]); }
__device__ __forceinline__ float xsum32(float v) { auto r = __builtin_amdgcn_permlane32_swap(__float_as_uint(v), __float_as_uint(v), false, false); return __uint_as_float(r[0]) + __uint_as_float(r[1]); }
__device__ __forceinline__ float shx(float v, int lane, int m) { return __uint_as_float(__builtin_amdgcn_ds_bpermute((lane ^ m) << 2, __float_as_uint(v))); }
__device__ __forceinline__ int tid_of(int wv) {
  int lane;
  asm volatile("v_mbcnt_lo_u32_b32 %0, -1, 0\n\tv_mbcnt_hi_u32_b32 %0, -1, %0" : "=v"(lane));
  return wv * 64 + lane;
}

#define XB_TMO      128
#define XB_XCNT(j)  (256  + 64 * (j))
#define XB_XSUB(j)  (1280 + 64 * (j))
#define XB_XGEN(j)  (2304 + 64 * (j))
#define XB_TOP      3328
#define XB_TOPGEN   3392
#define XCD_BAR_WORDS 3456
#define XB_SPIN_CAP (1u << 22)
#define LAS __attribute__((address_space(3)))
__device__ __forceinline__ unsigned xb_ld(unsigned* p) { return __hip_atomic_load(p, __ATOMIC_RELAXED, __HIP_MEMORY_SCOPE_AGENT); }
__device__ __forceinline__ unsigned xb_add(unsigned* p, unsigned v) { return __hip_atomic_fetch_add(p, v, __ATOMIC_RELAXED, __HIP_MEMORY_SCOPE_AGENT); }
__device__ __forceinline__ unsigned xb_xcc_id() { return (unsigned)__builtin_amdgcn_s_getreg((3 << 11) | 20) & 0xFu; }
#define XB_SPIN(cond, bar) do { unsigned _sp = 0; while (cond) { __builtin_amdgcn_s_sleep(1); \
    if ((++_sp & 255u) == 0u) { if (xb_ld(&(bar)[XB_TMO])) break; if (_sp > XB_SPIN_CAP) { atomicAdd(&(bar)[XB_TMO], 1u); break; } } } } while (0)
struct XcdBarrier { unsigned* bar; unsigned x; volatile LAS unsigned* st; };
__device__ __forceinline__ XcdBarrier xcd_barrier_post(unsigned* bar, volatile LAS unsigned* st, int wv) {
  XcdBarrier b; b.bar = bar; b.x = xb_xcc_id(); b.st = st;
  if (tid_of(wv) == 0) (void)xb_add(&bar[XB_XCNT(b.x)], 1u);
  return b;
}
__device__ __forceinline__ void xcd_barrier_complete(unsigned* bar, unsigned x, unsigned& nloc, unsigned& nx) {
  const unsigned G = gridDim.x * gridDim.y * gridDim.z;
  unsigned sum, cnt, mine, sp = 0u;
  for (;;) {
    sum = 0u; cnt = 0u; mine = 0u;
#pragma unroll
    for (unsigned j = 0; j < 16; ++j) { const unsigned c = xb_ld(&bar[XB_XCNT(j)]); sum += c; cnt += (c > 0u) ? 1u : 0u; mine = (j == x) ? c : mine; }
    if (sum == G) break;
    __builtin_amdgcn_s_sleep(1);
    if ((++sp & 255u) == 0u) { if (xb_ld(&bar[XB_TMO])) break; if (sp > XB_SPIN_CAP) { atomicAdd(&bar[XB_TMO], 1u); break; } }
  }
  nloc = mine > 0u ? mine : 1u; nx = cnt > 0u ? cnt : 1u;
}
__device__ __forceinline__ void xcd_barrier(const XcdBarrier& b, int wv) {
  asm volatile("s_waitcnt vmcnt(0)" ::: "memory");
  __syncthreads();
  if (tid_of(wv) == 0) {
    unsigned* bar = b.bar;
    __builtin_amdgcn_s_waitcnt(0);
    unsigned nloc = b.st[0], nx = b.st[1];
    if (nloc == 0u) { xcd_barrier_complete(bar, b.x, nloc, nx); b.st[0] = nloc; b.st[1] = nx; }
    const unsigned old = xb_add(&bar[XB_XSUB(b.x)], 1u);
    const unsigned gen = old / nloc;
    if (old + 1u == (gen + 1u) * nloc) {
      __builtin_amdgcn_fence(__ATOMIC_RELEASE, "agent");
      asm volatile("s_waitcnt vmcnt(0)" ::: "memory");
      const unsigned og = xb_add(&bar[XB_TOP], 1u);
      const unsigned tg = og / nx;
      if (og + 1u == (tg + 1u) * nx) xb_add(&bar[XB_TOPGEN], 1u);
      else XB_SPIN(xb_ld(&bar[XB_TOPGEN]) == tg, bar);
      __builtin_amdgcn_fence(__ATOMIC_ACQUIRE, "agent");
      xb_add(&bar[XB_XGEN(b.x)], 1u);
      asm volatile("s_waitcnt vmcnt(0)" ::: "memory");
    } else {
      XB_SPIN(xb_ld(&bar[XB_XGEN(b.x)]) == gen, bar);
      __builtin_amdgcn_fence(__ATOMIC_ACQUIRE, "agent");
      asm volatile("s_waitcnt vmcnt(0)" ::: "memory");
    }
  }
  __syncthreads();
}

__device__ __forceinline__ int perm64(int g) { return ((g >> 4) & 1) * 32 + (g >> 5) * 16 + (g & 15); }

__device__ void tconv_all(const float* src, u16* dst, int K, int N, int Npad, size_t srcLS, size_t dstLS, int dstRowOff,
                          const float* g, int gS, int permMode, float* lds0, int wv) {
  const int tid = tid_of(wv);
  const int half = tid >> 8, ht = tid & 255;
  float* lds = lds0 + half * (2 * 64 * 65);
  const int nkt = K / 64, nnt = Npad / 64, per = nkt * nnt, total = NL * per;
  for (int t0 = blockIdx.x * 4; t0 < total; t0 += gridDim.x * 4) {
    float4 v[2][4];
    bool ok[2];
    int n0s[2], k0s[2], ls[2];
#pragma unroll
    for (int j = 0; j < 2; ++j) {
      const int t = t0 + half * 2 + j;
      ok[j] = t < total;
      const int l = t / per, r = t % per, kt = r / nnt, nt = r % nnt;
      ls[j] = l; k0s[j] = kt * 64; n0s[j] = nt * 64;
      const float* sp = src + (size_t)l * srcLS;
#pragma unroll
      for (int i = 0; i < 4; ++i) {
        const int rr = (ht >> 4) + 16 * i, c = (ht & 15) * 4;
        v[j][i] = make_float4(0.f, 0.f, 0.f, 0.f);
        if (ok[j] && n0s[j] + c < N) v[j][i] = *(const float4*)(sp + (size_t)(k0s[j] + rr) * N + n0s[j] + c);
      }
    }
#pragma unroll
    for (int j = 0; j < 2; ++j) {
      const float* gp = g ? g + (size_t)ls[j] * gS : nullptr;
#pragma unroll
      for (int i = 0; i < 4; ++i) {
        const int rr = (ht >> 4) + 16 * i, c = (ht & 15) * 4;
        float4 x = v[j][i];
        if (gp && ok[j]) { const float sc = gp[k0s[j] + rr]; x.x *= sc; x.y *= sc; x.z *= sc; x.w *= sc; }
        float* pp = lds + j * (64 * 65) + rr * 65 + c;
        pp[0] = x.x; pp[1] = x.y; pp[2] = x.z; pp[3] = x.w;
      }
    }
    __syncthreads();
#pragma unroll
    for (int j = 0; j < 2; ++j) {
      if (ok[j]) {
        const int n0 = n0s[j], k0 = k0s[j];
        u16* dp = dst + (size_t)ls[j] * dstLS + (size_t)dstRowOff * K;
        const float* lj = lds + j * (64 * 65);
        const bool perm = (permMode == 1) ? (n0 == C_KPE) : (permMode == 2) ? ((n0 % 192) == 128 && n0 < 1152) : false;
#pragma unroll
        for (int i = 0; i < 2; ++i) {
          const int id = ht + 256 * i, n = id >> 3, kc = (id & 7) * 8;
          const int ns = perm ? perm64(n) : n;
          unsigned w0 = pack2(lj[(kc + 0) * 65 + ns], lj[(kc + 1) * 65 + ns]);
          unsigned w1 = pack2(lj[(kc + 2) * 65 + ns], lj[(kc + 3) * 65 + ns]);
          unsigned w2 = pack2(lj[(kc + 4) * 65 + ns], lj[(kc + 5) * 65 + ns]);
          unsigned w3 = pack2(lj[(kc + 6) * 65 + ns], lj[(kc + 7) * 65 + ns]);
          *(uint4*)(dp + (size_t)(n0 + n) * K + k0 + kc) = make_uint4(w0, w1, w2, w3);
        }
      }
    }
    __syncthreads();
  }
}

__device__ void phase_prep(const Params& p, char* smem, int wv) {
  float* lds = (float*)smem;
  const int tid = tid_of(wv);
  const size_t gtid = (size_t)blockIdx.x * NT + tid, gsz = (size_t)gridDim.x * NT;
  if (blockIdx.x == 0) { p.ctr()[tid] = (tid < 8) ? gridDim.x : 0u; p.ctr()[tid + NT] = 0u; p.ctr()[tid + 2 * NT] = 0u; p.ctr()[tid + 3 * NT] = 0u; }
  for (size_t c = gtid; c < (size_t)2 * SEQ; c += gsz) p.ssq()[c] = 0.f;
  for (size_t c = gtid; c < (size_t)SEQ * DM / 8; c += gsz) {
    float4 a = *(const float4*)(p.x + c * 8), b = *(const float4*)(p.x + c * 8 + 4);
    *(uint4*)(p.xb() + c * 8) = make_uint4(pack2(a.x, a.y), pack2(a.z, a.w), pack2(b.x, b.y), pack2(b.z, b.w));
  }
  for (size_t c = gtid; c < (size_t)256 * DM / 8; c += gsz) {
    float4 a = *(const float4*)(p.mem + c * 8), b = *(const float4*)(p.mem + c * 8 + 4);
    *(uint4*)(p.memb() + c * 8) = make_uint4(pack2(a.x, a.y), pack2(a.z, a.w), pack2(b.x, b.y), pack2(b.z, b.w));
  }
  for (size_t e = gtid; e < (size_t)SEQ * 32; e += gsz) {
    int s = (int)(e >> 5), i = (int)(e & 31);
    float invf = __builtin_amdgcn_exp2f(-(float)i * (13.287712379549449f / 32.0f));
    float ang = (float)p.pos[s] * invf;
    double rev = (double)ang * 0.15915494309189535;
    float fr = (float)(rev - floor(rev));
    p.cosT()[e] = __builtin_amdgcn_cosf(fr);
    p.sinT()[e] = __builtin_amdgcn_sinf(fr);
  }
  tconv_all(p.w_in, p.wt_in(), DM, DIN, DINP, (size_t)DM * DIN, (size_t)DINP * DM, 0, nullptr, 0, 1, lds, wv);
  tconv_all(p.w_out, p.wt_out(), DM, DM, DM, (size_t)DM * DM, (size_t)DM * DM, 0, nullptr, 0, 0, lds, wv);
  tconv_all(p.w_uq, p.wt_uq(), 512, 1152, UQP, (size_t)512 * 1152, (size_t)UQP * 512, 0, p.q_norm_g, 512, 2, lds, wv);
  tconv_all(p.w_ukv, p.wt_ukv(), 256, 1536, 1536, (size_t)256 * 1536, (size_t)1536 * 256, 0, p.kv_norm_g, 256, 0, lds, wv);
  tconv_all(p.w_mem_k, p.wt_memkv(), DM, 256, 256, (size_t)DM * 256, (size_t)512 * DM, 0, nullptr, 0, 0, lds, wv);
  tconv_all(p.w_mem_v, p.wt_memkv(), DM, 256, 256, (size_t)DM * 256, (size_t)512 * DM, 256, nullptr, 0, 0, lds, wv);
}

namespace pg8 {
constexpr int BM = 256, BK = 64, HALF = 128, HTB = HALF * BK * 2, NXCD = 8, WGM = 8;
__device__ __forceinline__ int lds_byte(int r, int c) { const int st = (r >> 4) * 2 + (c >> 5), rr = r & 15, cc = c & 31, ob = rr * 64 + cc * 2; return st * 1024 + (ob ^ (((ob >> 9) & 1) << 5)); }
__device__ __forceinline__ void stage_rc(int b, int& R, int& C) { const int st = b / 1024, sb = b % 1024, swz = sb ^ (((sb >> 9) & 1) << 5); R = (st >> 1) * 16 + swz / 64; C = (st & 1) * 32 + (swz % 64) / 2; }
struct Unit { int pm, pn; };
struct Gemm { const u16* A; const u16* Bt; int lda, ldb, K; };
struct StaticOrder {
  int nM, nN, nwg, G, c;
  __device__ void init(int M, int N, int G_, int c_) { nM = M / BM; nN = N / BM; nwg = nM * nN; G = G_; c = c_; }
  __device__ bool next(int i, Unit& u) const {
    const long L = (long)i * G + c; if (L >= nwg) return false;
    int wgid = (int)L; { const int q = nwg / NXCD, r = nwg % NXCD, xcd = wgid % NXCD, off = wgid / NXCD; wgid = (xcd < r ? xcd * (q + 1) : r * (q + 1) + (xcd - r) * q) + off; }
    const int nig = WGM * nN, gid = wgid / nig, fm = gid * WGM, gsz = (nM - fm) < WGM ? (nM - fm) : WGM;
    u.pm = __builtin_amdgcn_readfirstlane(fm + ((wgid % nig) % gsz)); u.pn = __builtin_amdgcn_readfirstlane((wgid % nig) / gsz); return true;
  }
};
struct StrideOrder {
  int first, stride, count, limit;
  __device__ bool next(int i, Unit& u) const { const int x = first + i * stride; if (i >= count || x >= limit) return false; u.pm = x & 31; u.pn = x >> 5; return true; }
};

template <class Epi, class Sched>
__device__ __forceinline__ void gemm_phase(LAS unsigned char* lds, const Gemm g, const Sched& S, const Epi& E, int wv) {
  const int tid = tid_of(wv);
  const int wid = wv, lane = tid & 63, wr = wid >> 2, wc = wid & 3, fr = lane & 15, fq = lane >> 4;
  const int K = g.K, nt = K / BK;
  unsigned voffA[2], voffB[2];
#pragma unroll
  for (int i = 0; i < 2; ++i) { int R, C; stage_rc(tid * 16 + i * 8192, R, C);
    voffA[i] = (unsigned)(R * g.lda + C) * 2u; voffB[i] = (unsigned)(R * g.ldb + C) * 2u; }
  const size_t kstep = (size_t)(BK * 2);
  const size_t hstepA = (size_t)HALF * g.lda * 2, hstepB = (size_t)HALF * g.ldb * 2;
  const size_t tstepA = 2 * hstepA, tstepB = 2 * hstepB;
  const unsigned ldsw = (unsigned)wid * 1024u;
  const int aoff = lds_byte(wr * 64 + fr, fq * 8), boff = lds_byte(wc * 32 + fr, fq * 8);
#define PG8_SA(b, h) (((b) * 2 + (h)) * HTB)
#define PG8_SB(b, h) ((4 + (b) * 2 + (h)) * HTB)
#define PG8_STAGE(bufoff, gbase, voff) do { _Pragma("unroll") for (int _i = 0; _i < 2; ++_i) \
    __builtin_amdgcn_global_load_lds((const unsigned*)((const char*)(gbase) + (voff)[_i]), (LAS unsigned*)(lds + (bufoff) + ldsw + _i * 8192), 16, 0, 0); } while (0)
#define PG8_LDA(dst, b, h) do { _Pragma("unroll") for (int m = 0; m < 4; ++m) _Pragma("unroll") for (int k = 0; k < 2; ++k) dst[m][k] = *(const LAS bf16x8*)(lds + PG8_SA(b, h) + aoff + m * 2048 + k * 1024); } while (0)
#define PG8_LDB(dst, b, h) do { _Pragma("unroll") for (int n = 0; n < 2; ++n) _Pragma("unroll") for (int k = 0; k < 2; ++k) dst[n][k] = *(const LAS bf16x8*)(lds + PG8_SB(b, h) + boff + n * 2048 + k * 1024); } while (0)
#define PG8_MMA(ai, bj, At, Bt) do { __builtin_amdgcn_s_setprio(1); _Pragma("unroll") for (int m = 0; m < 4; ++m) _Pragma("unroll") for (int n = 0; n < 2; ++n) _Pragma("unroll") for (int k = 0; k < 2; ++k) \
    acc[ai][bj][m][n] = __builtin_amdgcn_mfma_f32_16x16x32_bf16(Bt[n][k], At[m][k], acc[ai][bj][m][n], 0, 0, 0); __builtin_amdgcn_s_setprio(0); } while (0)
#define PG8_WAIT_V(n) asm volatile("s_waitcnt vmcnt(" #n ")" ::: "memory")
#define PG8_WAIT_L(n) asm volatile("s_waitcnt lgkmcnt(" #n ")" ::: "memory")
#define PG8_BAR __builtin_amdgcn_s_barrier()
#define PG8_SCHED __builtin_amdgcn_sched_barrier(0)
  Unit cur, nxt; int ui = 0;
  if (!S.next(0, cur)) return;
  f32x4 acc[2][2][4][2];
#pragma unroll
  for (int a = 0; a < 2; ++a)
#pragma unroll
    for (int b = 0; b < 2; ++b)
#pragma unroll
      for (int m = 0; m < 4; ++m)
#pragma unroll
        for (int n = 0; n < 2; ++n) acc[a][b][m][n] = (f32x4){0.f, 0.f, 0.f, 0.f};
  bf16x8 At[4][2], B0[2][2], B1[2][2];
  const char* cA = (const char*)g.A + (size_t)cur.pm * tstepA; const char* cB = (const char*)g.Bt + (size_t)cur.pn * tstepB;
  PG8_STAGE(PG8_SB(0, 0), cB, voffB); PG8_STAGE(PG8_SA(0, 0), cA, voffA); PG8_STAGE(PG8_SB(0, 1), cB + hstepB, voffB); PG8_STAGE(PG8_SA(0, 1), cA + hstepA, voffA);
  if (wr == 1) PG8_BAR;
  PG8_WAIT_V(4); PG8_BAR;
  PG8_STAGE(PG8_SB(1, 0), cB + kstep, voffB); PG8_STAGE(PG8_SA(1, 0), cA + kstep, voffA); PG8_STAGE(PG8_SB(1, 1), cB + hstepB + kstep, voffB);
  PG8_WAIT_V(6); PG8_BAR;
  for (;;) {
    const bool has_next = S.next(ui + 1, nxt);
    const char* nA = has_next ? (const char*)g.A + (size_t)nxt.pm * tstepA : cA; const char* nB = has_next ? (const char*)g.Bt + (size_t)nxt.pn * tstepB : cB;
    for (int t = 0; t < nt; t += 2) {
      const bool last = (t == nt - 2);
      const char* a1 = cA + (size_t)(t + 1) * kstep;
      const char* a2 = last ? nA : cA + (size_t)(t + 2) * kstep; const char* b2 = last ? nB : cB + (size_t)(t + 2) * kstep;
      const char* a3 = a2 + kstep; const char* b3 = b2 + kstep;
      PG8_LDB(B0, 0, 0); PG8_SCHED; PG8_LDA(At, 0, 0); PG8_STAGE(PG8_SA(1, 1), a1 + hstepA, voffA);
      PG8_WAIT_L(8); PG8_BAR; PG8_WAIT_L(0); PG8_MMA(0, 0, At, B0); PG8_BAR; PG8_SCHED;
      PG8_LDB(B1, 0, 1); PG8_STAGE(PG8_SB(0, 0), b2, voffB);
      PG8_BAR; PG8_WAIT_L(0); PG8_MMA(0, 1, At, B1); PG8_BAR;
      PG8_LDA(At, 0, 1); PG8_STAGE(PG8_SA(0, 0), a2, voffA);
      PG8_BAR; PG8_WAIT_L(0); PG8_MMA(1, 0, At, B0); PG8_BAR; PG8_SCHED;
      PG8_STAGE(PG8_SB(0, 1), b2 + hstepB, voffB);
      PG8_WAIT_V(6); PG8_BAR; PG8_MMA(1, 1, At, B1); PG8_BAR;
      PG8_LDB(B0, 1, 0); PG8_SCHED; PG8_LDA(At, 1, 0); PG8_STAGE(PG8_SA(0, 1), a2 + hstepA, voffA);
      PG8_WAIT_L(8); PG8_BAR; PG8_WAIT_L(0); PG8_MMA(0, 0, At, B0); PG8_BAR; PG8_SCHED;
      PG8_LDB(B1, 1, 1); PG8_STAGE(PG8_SB(1, 0), b3, voffB);
      PG8_BAR; PG8_WAIT_L(0); PG8_MMA(0, 1, At, B1); PG8_BAR;
      PG8_LDA(At, 1, 1); PG8_STAGE(PG8_SA(1, 0), a3, voffA);
      PG8_BAR; PG8_WAIT_L(0); PG8_MMA(1, 0, At, B0); PG8_BAR; PG8_SCHED;
      PG8_STAGE(PG8_SB(1, 1), b3 + hstepB, voffB);
      PG8_WAIT_V(6); PG8_BAR; PG8_MMA(1, 1, At, B1); PG8_BAR;
    }
    if constexpr (!Epi::AFTER_DRAIN) E(acc, cur, wr, wc, fr, fq);
    if (!has_next) break;
#pragma unroll
    for (int a = 0; a < 2; ++a)
#pragma unroll
      for (int b = 0; b < 2; ++b)
#pragma unroll
        for (int m = 0; m < 4; ++m)
#pragma unroll
          for (int n = 0; n < 2; ++n) acc[a][b][m][n] = (f32x4){0.f, 0.f, 0.f, 0.f};
    cur = nxt; cA = nA; cB = nB; ++ui;
  }
  PG8_WAIT_V(0);
  if (wr == 0) PG8_BAR;
  PG8_BAR;
  if constexpr (Epi::AFTER_DRAIN) E.fused(acc, cur, wr, wc);
#undef PG8_SA
#undef PG8_SB
#undef PG8_STAGE
#undef PG8_LDA
#undef PG8_LDB
#undef PG8_MMA
#undef PG8_WAIT_V
#undef PG8_WAIT_L
#undef PG8_BAR
#undef PG8_SCHED
}
}

typedef const f32x4 (&AccRef)[2][2][4][2];

struct EpiA {
  static constexpr bool AFTER_DRAIN = false;
  Params p; int l;
  __device__ __forceinline__ void operator()(AccRef acc, const pg8::Unit& u, int wr, int wc, int fr_, int fq_) const {
    const int lane_ = tid_of(wr * 4 + wc) & 63, fr = lane_ & 15, fq = lane_ >> 4;
    const int rowb = u.pm * 256 + wr * 64 + fr;
#pragma unroll
    for (int bj = 0; bj < 2; ++bj) {
      const int cs = u.pn * 256 + bj * 128 + wc * 32;
      int kind;
      if (cs < C_KPE) kind = 0; else if (cs < C_GA) kind = 3; else if (cs < C_SGU) kind = 1;
      else if (cs < C_GB) kind = 2; else if (cs < C_SBQ) kind = 1; else if (cs < C_SBV) kind = 0;
      else if (cs < C_GC) kind = 4; else if (cs < C_MQ) kind = 1; else if (cs < C_GM) kind = 0;
      else if (cs < DIN) kind = 1; else kind = 5;
      if (kind == 5) continue;
      if (kind <= 2) {
#pragma unroll
        for (int ai = 0; ai < 2; ++ai)
#pragma unroll
          for (int m = 0; m < 4; ++m) {
            const int row = rowb + ai * 128 + m * 16;
#pragma unroll
            for (int n = 0; n < 2; ++n) {
              f32x4 v = acc[ai][bj][m][n];
              if (kind == 1) { v[0] = silu_f(v[0]); v[1] = silu_f(v[1]); v[2] = silu_f(v[2]); v[3] = silu_f(v[3]); }
              else if (kind == 2) { v[0] = gelu_f(v[0]); v[1] = gelu_f(v[1]); v[2] = gelu_f(v[2]); v[3] = gelu_f(v[3]); }
              *(uint2*)(p.h() + (size_t)row * DIN + cs + n * 16 + fq * 4) = make_uint2(pack2(v[0], v[1]), pack2(v[2], v[3]));
            }
          }
      } else if (kind == 3) {
        const int i0 = ((cs >> 5) & 1) * 16 + fq * 4;
#pragma unroll
        for (int ai = 0; ai < 2; ++ai)
#pragma unroll
          for (int m = 0; m < 4; ++m) {
            const int row = rowb + ai * 128 + m * 16;
            float4 cs4 = *(const float4*)(p.cosT() + (size_t)row * 32 + i0);
            float4 sn = *(const float4*)(p.sinT() + (size_t)row * 32 + i0);
            f32x4 x1 = acc[ai][bj][m][0], x2 = acc[ai][bj][m][1];
            float a0 = x1[0] * cs4.x - x2[0] * sn.x, a1 = x1[1] * cs4.y - x2[1] * sn.y, a2 = x1[2] * cs4.z - x2[2] * sn.z, a3 = x1[3] * cs4.w - x2[3] * sn.w;
            float b0 = x1[0] * sn.x + x2[0] * cs4.x, b1 = x1[1] * sn.y + x2[1] * cs4.y, b2 = x1[2] * sn.z + x2[2] * cs4.z, b3 = x1[3] * sn.w + x2[3] * cs4.w;
            uint2 ua = make_uint2(pack2(a0, a1), pack2(a2, a3)), ub = make_uint2(pack2(b0, b1), pack2(b2, b3));
#pragma unroll
            for (int hd = 0; hd < 6; ++hd) {
              u16* kp = p.k() + ((size_t)hd * SEQ + row) * 192 + 128 + i0;
              *(uint2*)kp = ua;
              *(uint2*)(kp + 32) = ub;
            }
          }
      } else {
#pragma unroll
        for (int ai = 0; ai < 2; ++ai)
#pragma unroll
          for (int m = 0; m < 4; ++m) {
            const int row = rowb + ai * 128 + m * 16;
#pragma unroll
            for (int n = 0; n < 2; ++n) {
              const int c = cs - C_SBV + n * 16 + fq * 4;
#pragma unroll
              for (int j = 0; j < 4; ++j) (p.vtsb() + (size_t)(c >> 7) * 128 * SEQ)[(unsigned)((row >> 6) * 8192 + vperm(row & 63) + ((c & 127) + j) * 64)] = f2bf(acc[ai][bj][m][n][j]);
            }
          }
      }
    }
    if (u.pn < 3) {
      float* sq = p.ssq() + (u.pn == 2 ? SEQ : 0);
#pragma unroll
      for (int ai = 0; ai < 2; ++ai)
#pragma unroll
        for (int m = 0; m < 4; ++m) {
          float v = 0.f;
#pragma unroll
          for (int bj = 0; bj < 2; ++bj)
#pragma unroll
            for (int n = 0; n < 2; ++n)
#pragma unroll
              for (int j = 0; j < 4; ++j) { float a = acc[ai][bj][m][n][j]; v += a * a; }
          v = xsum16(v);
          v = xsum32(v);
          if (fq == 0) atomicAdd(sq + rowb + ai * 128 + m * 16, v);
        }
    }
  }
};

struct EpiMem {
  static constexpr bool AFTER_DRAIN = false;
  Params p;
  __device__ __forceinline__ void operator()(AccRef acc, const pg8::Unit& u, int wr, int wc, int fr_, int fq_) const {
    const int lane_ = tid_of(wr * 4 + wc) & 63, fr = lane_ & 15, fq = lane_ >> 4;
    const int l = u.pn >> 1, isv = u.pn & 1;
    const int rowb = wr * 64 + fr;
#pragma unroll
    for (int bj = 0; bj < 2; ++bj)
#pragma unroll
      for (int ai = 0; ai < 2; ++ai)
#pragma unroll
        for (int m = 0; m < 4; ++m) {
          const int row = rowb + ai * 128 + m * 16;
#pragma unroll
          for (int n = 0; n < 2; ++n) {
            const int c = bj * 128 + wc * 32 + n * 16 + fq * 4, hd = c >> 6, e = c & 63;
            if (!isv) {
              *(uint2*)(p.mk() + ((size_t)(l * 4 + hd) * 256 + row) * 64 + e) =
                  make_uint2(pack2(acc[ai][bj][m][n][0], acc[ai][bj][m][n][1]), pack2(acc[ai][bj][m][n][2], acc[ai][bj][m][n][3]));
            } else {
#pragma unroll
              for (int j = 0; j < 4; ++j) p.mvt()[(unsigned)((((l * 4 + hd) * 4 + (row >> 6)) * 64 + e + j) * 64 + vperm(row & 63))] = f2bf(acc[ai][bj][m][n][j]);
            }
          }
        }
  }
};

struct EpiQ {
  static constexpr bool AFTER_DRAIN = false;
  Params p;
  __device__ __forceinline__ void operator()(AccRef acc, const pg8::Unit& u, int wr, int wc, int fr_, int fq_) const {
    const int lane_ = tid_of(wr * 4 + wc) & 63, fr = lane_ & 15, fq = lane_ >> 4;
    const float qs = 0.07216878364870322f * 1.4426950408889634f;
    const int rowb = u.pm * 256 + wr * 64 + fr;
#pragma unroll
    for (int ai = 0; ai < 2; ++ai)
#pragma unroll
      for (int m = 0; m < 4; ++m) {
        const int row = rowb + ai * 128 + m * 16;
        const float rs = rsqrtf(p.ssq()[row] * (1.f / 512.f) + 1e-6f) * qs;
#pragma unroll
        for (int bj = 0; bj < 2; ++bj) {
          const int cs = u.pn * 256 + bj * 128 + wc * 32;
          if (cs >= 1152) continue;
          const int hd = cs / 192, o = cs % 192;
          u16* qp = p.q() + ((size_t)hd * SEQ + row) * 192;
          if (o < 128) {
#pragma unroll
            for (int n = 0; n < 2; ++n) {
              f32x4 v = acc[ai][bj][m][n] * rs;
              *(uint2*)(qp + o + n * 16 + fq * 4) = make_uint2(pack2(v[0], v[1]), pack2(v[2], v[3]));
            }
          } else {
            const int i0 = ((cs >> 5) & 1) * 16 + fq * 4;
            float4 cs4 = *(const float4*)(p.cosT() + (size_t)row * 32 + i0);
            float4 sn = *(const float4*)(p.sinT() + (size_t)row * 32 + i0);
            f32x4 x1 = acc[ai][bj][m][0] * rs, x2 = acc[ai][bj][m][1] * rs;
            float a0 = x1[0] * cs4.x - x2[0] * sn.x, a1 = x1[1] * cs4.y - x2[1] * sn.y, a2 = x1[2] * cs4.z - x2[2] * sn.z, a3 = x1[3] * cs4.w - x2[3] * sn.w;
            float b0 = x1[0] * sn.x + x2[0] * cs4.x, b1 = x1[1] * sn.y + x2[1] * cs4.y, b2 = x1[2] * sn.z + x2[2] * cs4.z, b3 = x1[3] * sn.w + x2[3] * cs4.w;
            *(uint2*)(qp + 128 + i0) = make_uint2(pack2(a0, a1), pack2(a2, a3));
            *(uint2*)(qp + 160 + i0) = make_uint2(pack2(b0, b1), pack2(b2, b3));
          }
        }
      }
  }
};

struct EpiKV {
  static constexpr bool AFTER_DRAIN = false;
  Params p;
  __device__ __forceinline__ void operator()(AccRef acc, const pg8::Unit& u, int wr, int wc, int fr_, int fq_) const {
    const int lane_ = tid_of(wr * 4 + wc) & 63, fr = lane_ & 15, fq = lane_ >> 4;
    const int rowb = u.pm * 256 + wr * 64 + fr, hd = u.pn;
#pragma unroll
    for (int ai = 0; ai < 2; ++ai)
#pragma unroll
      for (int m = 0; m < 4; ++m) {
        const int row = rowb + ai * 128 + m * 16;
        const float rs = rsqrtf(p.ssq()[SEQ + row] * (1.f / 256.f) + 1e-6f);
        u16* kp = p.k() + ((size_t)hd * SEQ + row) * 192 + wc * 32;
#pragma unroll
        for (int n = 0; n < 2; ++n) {
          f32x4 v = acc[ai][0][m][n] * rs;
          *(uint2*)(kp + n * 16 + fq * 4) = make_uint2(pack2(v[0], v[1]), pack2(v[2], v[3]));
        }
#pragma unroll
        for (int n = 0; n < 2; ++n)
#pragma unroll
          for (int j = 0; j < 4; ++j)
            (p.vt() + (size_t)hd * 128 * SEQ)[(unsigned)((row >> 6) * 8192 + vperm(row & 63) + (wc * 32 + n * 16 + fq * 4 + j) * 64)] = f2bf(acc[ai][1][m][n][j] * rs);
      }
  }
};

struct EpiD {
  static constexpr bool AFTER_DRAIN = false;
  Params p; int l;
  __device__ __forceinline__ void operator()(AccRef acc, const pg8::Unit& u, int wr, int wc, int fr_, int fq_) const {
    const int lane_ = tid_of(wr * 4 + wc) & 63, fr = lane_ & 15, fq = lane_ >> 4;
    const float alpha = 1.681792830507429f;
    const float* xres = (l == 0) ? p.x : p.out;
    const int rowb = u.pm * 256 + wr * 64 + fr;
#pragma unroll
    for (int ai = 0; ai < 2; ++ai)
#pragma unroll
      for (int m = 0; m < 4; ++m) {
        const int row = rowb + ai * 128 + m * 16;
#pragma unroll
        for (int bj = 0; bj < 2; ++bj)
#pragma unroll
          for (int n = 0; n < 2; ++n) {
            const size_t off = (size_t)row * DM + u.pn * 256 + bj * 128 + wc * 32 + n * 16 + fq * 4;
            float4 xr = *(const float4*)(xres + off);
            f32x4 a = acc[ai][bj][m][n];
            *(float4*)(p.out + off) = make_float4(alpha * xr.x + a[0], alpha * xr.y + a[1], alpha * xr.z + a[2], alpha * xr.w + a[3]);
          }
      }
  }
};

struct EpiDF {
  static constexpr bool PERM = false, AFTER_DRAIN = true;
  Params p; int l; char* sm;
  __device__ __forceinline__ void operator()(AccRef, const pg8::Unit&, int, int, int, int) const {}
  __device__ __forceinline__ void fused(f32x4 (&z)[2][2][4][2], const pg8::Unit& u, int wr, int wc) const {
    typedef unsigned long long u64;
    const int wv = wr * 4 + wc, tid = tid_of(wv), lane = tid & 63, fr = lane & 15, fq = lane >> 4;
    const float alpha = 1.681792830507429f;
    const float* xres = (l == 0) ? p.x : p.out;
    float* P = (float*)(sm + GEMM_LDS);
    float* S = P + 2048;
    const int rlb = wr * 64 + fr, colb = u.pn * 256 + wc * 32 + fq * 4;
    for (size_t c = (size_t)blockIdx.x * NT + tid; c < (size_t)2 * SEQ; c += (size_t)gridDim.x * NT) p.ssq()[c] = 0.f;
#pragma unroll
    for (int ai = 0; ai < 2; ++ai) {
      float4 xr[4][2][2];
#pragma unroll
      for (int m = 0; m < 4; ++m)
#pragma unroll
        for (int bj = 0; bj < 2; ++bj)
#pragma unroll
          for (int n = 0; n < 2; ++n)
            xr[m][bj][n] = *(const float4*)(xres + (size_t)(u.pm * 256 + rlb + ai * 128 + m * 16) * DM + colb + bj * 128 + n * 16);
#pragma unroll
      for (int m = 0; m < 4; ++m) {
        float s1 = 0.f, s2 = 0.f;
#pragma unroll
        for (int bj = 0; bj < 2; ++bj)
#pragma unroll
          for (int n = 0; n < 2; ++n) {
            const float4 x4 = xr[m][bj][n];
            f32x4 v = z[ai][bj][m][n];
            v[0] = alpha * x4.x + v[0]; v[1] = alpha * x4.y + v[1]; v[2] = alpha * x4.z + v[2]; v[3] = alpha * x4.w + v[3];
            z[ai][bj][m][n] = v;
            s1 += (v[0] + v[1]) + (v[2] + v[3]);
            s2 += (v[0] * v[0] + v[1] * v[1]) + (v[2] * v[2] + v[3] * v[3]);
          }
        s1 = xsum32(xsum16(s1)); s2 = xsum32(xsum16(s2));
        if (fq == 0) { float* pp = P + ((rlb + ai * 128 + m * 16) * 4 + wc) * 2; pp[0] = s1; pp[1] = s2; }
      }
    }
    __syncthreads();
    u64* X = p.lnx() + (size_t)(u.pm * 8) * 256;
    if (tid < 256) {
      const float4 a = *(const float4*)(P + tid * 8), b = *(const float4*)(P + tid * 8 + 4);
      const float s1 = (a.x + a.z) + (b.x + b.z), s2 = (a.y + a.w) + (b.y + b.w);
      __hip_atomic_store(X + u.pn * 256 + tid, ((u64)__float_as_uint(s2) << 32) | __float_as_uint(s1), __ATOMIC_RELAXED, __HIP_MEMORY_SCOPE_AGENT);
    }
    asm volatile("s_waitcnt vmcnt(0)" ::: "memory");
    __syncthreads();
    if (tid == 0) {
      unsigned* cnt = p.ctr() + 1024 + l * 32 + u.pm;
      __hip_atomic_fetch_add(cnt, 1u, __ATOMIC_RELAXED, __HIP_MEMORY_SCOPE_AGENT);
      unsigned sp = 0;
      while (__hip_atomic_load(cnt, __ATOMIC_RELAXED, __HIP_MEMORY_SCOPE_AGENT) < 8u) { __builtin_amdgcn_s_sleep(2); if (++sp > (1u << 24)) break; }
    }
    __syncthreads();
    if (tid < 256) {
      float s1 = 0.f, s2 = 0.f;
#pragma unroll
      for (int j = 0; j < 8; ++j) {
        const u64 w = __hip_atomic_load(X + j * 256 + tid, __ATOMIC_RELAXED, __HIP_MEMORY_SCOPE_AGENT);
        s1 += __uint_as_float((unsigned)w); s2 += __uint_as_float((unsigned)(w >> 32));
      }
      const float mu = s1 * (1.f / DM);
      const float var = fmaxf(s2 * (1.f / DM) - mu * mu, 0.f);
      S[tid * 2] = mu; S[tid * 2 + 1] = rsqrtf(var + 1e-5f);
    }
    __syncthreads();
    const float* lg = p.ln_g + (size_t)l * DM;
    const float* lb = p.ln_b + (size_t)l * DM;
#pragma unroll
    for (int bj = 0; bj < 2; ++bj)
#pragma unroll
      for (int n = 0; n < 2; ++n) {
        const int col = colb + bj * 128 + n * 16;
        const float4 gg = *(const float4*)(lg + col), bb = *(const float4*)(lb + col);
#pragma unroll
        for (int ai = 0; ai < 2; ++ai)
#pragma unroll
          for (int m = 0; m < 4; ++m) {
            const int rl = rlb + ai * 128 + m * 16;
            const float mu = S[rl * 2], rs = S[rl * 2 + 1];
            const f32x4 v = z[ai][bj][m][n];
            const float r0 = (v[0] - mu) * rs * gg.x + bb.x, r1 = (v[1] - mu) * rs * gg.y + bb.y;
            const float r2 = (v[2] - mu) * rs * gg.z + bb.z, r3 = (v[3] - mu) * rs * gg.w + bb.w;
            const size_t off = (size_t)(u.pm * 256 + rl) * DM + col;
            *(float4*)(p.out + off) = make_float4(r0, r1, r2, r3);
            *(uint2*)(p.xb() + off) = make_uint2(pack2(r0, r1), pack2(r2, r3));
          }
      }
  }
};

__device__ void phaseE(const Params& p, int l, int wv) {
  const int tid = tid_of(wv);
  const int lane = tid & 63;
  const int gw = blockIdx.x * (NT / 64) + (tid >> 6), nw = gridDim.x * (NT / 64);
  for (size_t c = (size_t)blockIdx.x * NT + tid; c < (size_t)2 * SEQ; c += (size_t)gridDim.x * NT) p.ssq()[c] = 0.f;
  const float* g = p.ln_g + (size_t)l * DM;
  const float* b = p.ln_b + (size_t)l * DM;
  for (int row = gw; row < SEQ; row += nw) {
    float* zr = p.out + (size_t)row * DM;
    float4 v[8];
    float s = 0.f;
#pragma unroll
    for (int i = 0; i < 8; ++i) { v[i] = *(const float4*)(zr + (i * 64 + lane) * 4); s += v[i].x + v[i].y + v[i].z + v[i].w; }
#pragma unroll
    for (int o = 1; o < 16; o <<= 1) s += shx(s, lane, o);
    s = xsum16(s); s = xsum32(s);
    const float mu = s * (1.f / DM);
    float q = 0.f;
#pragma unroll
    for (int i = 0; i < 8; ++i) {
      v[i].x -= mu; v[i].y -= mu; v[i].z -= mu; v[i].w -= mu;
      q += v[i].x * v[i].x + v[i].y * v[i].y + v[i].z * v[i].z + v[i].w * v[i].w;
    }
#pragma unroll
    for (int o = 1; o < 16; o <<= 1) q += shx(q, lane, o);
    q = xsum16(q); q = xsum32(q);
    const float rstd = rsqrtf(q * (1.f / DM) + 1e-5f);
#pragma unroll
    for (int i = 0; i < 8; ++i) {
      const int c = (i * 64 + lane) * 4;
      float4 gg = *(const float4*)(g + c), bb = *(const float4*)(b + c);
      float4 r = make_float4(v[i].x * rstd * gg.x + bb.x, v[i].y * rstd * gg.y + bb.y, v[i].z * rstd * gg.z + bb.z, v[i].w * rstd * gg.w + bb.w);
      *(float4*)(zr + c) = r;
      *(uint2*)(p.xb() + (size_t)row * DM + c) = make_uint2(pack2(r.x, r.y), pack2(r.z, r.w));
    }
  }
}

template <int DK, int DV, int MODE, int QSN>
__device__ void attn_item(const u16* __restrict__ Qp, int ldq, const u16* __restrict__ Kp, int ldk, const u16* __restrict__ Vt, int ldv,
                          int t_first, int t_last, int t_diag, float zscale, int q0, const u16* __restrict__ gate, u16* __restrict__ outp,
                          char* smem, int wv, int nseg = 1, int seg = 0, float* part = nullptr, unsigned* cnt = nullptr) {
  constexpr int VST = 72, KCH = DK / 8;
  constexpr int NKR = (64 * KCH) / NT, NVR = (DV * 8) / NT, NST = DK / 32, NDS = DV / 16;
  u16* Ks = (u16*)smem;
  u16* Vs = Ks + 64 * DK;
  const int tid = tid_of(wv);
  asm volatile("" : "+s"(t_last));
  const int w = wv, lane = tid & 63, fr = lane & 15, fq = lane >> 4;

  const int fqs = (fq ^ ((fr >> 3) << 1)) * 16;
  constexpr int NSR = NST;
  bf16x8 qf[2][NSR];
  bf16x8* Qr = (bf16x8*)(smem + MLA_QR_OFF) + (w * 4) * 64 + lane;
#pragma unroll
  for (int qs = 0; qs < QSN; ++qs)
#pragma unroll
    for (int st = 0; st < NST; ++st) {
      bf16x8 v = *(const bf16x8*)(Qp + (unsigned)((w * (16 * QSN) + qs * 16 + fr) * ldq + st * 32 + fq * 8));
      if (st < NSR) qf[qs][st < NSR ? st : 0] = v;
      else Qr[(qs * 2 + (st - NSR)) * 64] = v;
    }

  f32x4 o[NDS][2];
#pragma unroll
  for (int ds = 0; ds < NDS; ++ds) { o[ds][0] = f32x4{0.f, 0.f, 0.f, 0.f}; o[ds][1] = f32x4{0.f, 0.f, 0.f, 0.f}; }
  float mrow[2] = {-1e30f, -1e30f};
  float lrow[2] = {0.f, 0.f};

  uint4 kk0, kk1, kk2, kk3, kk4, kk5, vv0, vv1, vv2, vv3;
#define KLOAD(i, T) if constexpr (NKR > i) { const int c_ = tid + NT * i, row_ = c_ / KCH, cc_ = c_ % KCH; kk##i = *(const uint4*)((Kp + (size_t)(T) * 64 * ldk) + (unsigned)(row_ * ldk + cc_ * 8)); }
#define KSTORE(i) if constexpr (NKR > i) { const int c_ = tid + NT * i, row_ = c_ / KCH, cc_ = c_ % KCH; \
    *(uint4*)((char*)Ks + (cc_ >> 2) * 4096 + row_ * 64 + (((cc_ & 3) ^ (((row_ >> 3) & 1) << 1)) * 16)) = kk##i; }
#define VLOAD(i, T) if constexpr (NVR > i) { const int c_ = tid + NT * i, dv_ = c_ >> 3, cc_ = c_ & 7; vv##i = *(const uint4*)((Vt + (size_t)(T) * (DV * 64)) + (unsigned)(dv_ * 64 + cc_ * 8)); }
#define VSTORE(i) if constexpr (NVR > i) { const int c_ = tid + NT * i, dv_ = c_ >> 3, cc_ = c_ & 7; *(uint4*)(Vs + dv_ * VST + cc_ * 8) = vv##i; }
#define load_k(T) do { KLOAD(0, T) KLOAD(1, T) KLOAD(2, T) KLOAD(3, T) KLOAD(4, T) KLOAD(5, T) } while (0)
#define load_v(T) do { VLOAD(0, T) VLOAD(1, T) VLOAD(2, T) VLOAD(3, T) } while (0)
#define store_tile() do { KSTORE(0) KSTORE(1) KSTORE(2) KSTORE(3) KSTORE(4) KSTORE(5) VSTORE(0) VSTORE(1) VSTORE(2) VSTORE(3) } while (0)

#define MLA_ISSUE(T, B) do { char* kb_ = smem + (B) * MLA_STAGE; \
    _Pragma("unroll") for (int i_ = 0; i_ < 3; ++i_) { const int P_ = tid + NT * i_, st_ = P_ >> 8, r_ = (P_ >> 2) & 63, q_ = (P_ & 3) ^ (((r_ >> 3) & 1) << 1); \
      __builtin_amdgcn_global_load_lds((const unsigned*)((Kp + (size_t)(T) * 64 * ldk) + (unsigned)(r_ * ldk + (st_ * 4 + q_) * 8)), (LAS unsigned*)(kb_ + P_ * 16), 16, 0, 0); } \
    _Pragma("unroll") for (int i_ = 0; i_ < 2; ++i_) { const int P_ = tid + NT * i_, dv_ = P_ >> 3, c_ = (P_ & 7) ^ ((dv_ >> 1) & 7); \
      __builtin_amdgcn_global_load_lds((const unsigned*)((Vt + (size_t)(T) * 8192) + (unsigned)(dv_ * 64 + c_ * 8)), (LAS unsigned*)(kb_ + 24576 + P_ * 16), 16, 0, 0); } } while (0)

  volatile int* flg = (volatile int*)(smem + CTL_OFF) + 8;
  if (MODE == 2 && tid == 0) flg[0] = 0;
  int it = 0;
  int t = (MODE == 2) ? t_last : t_first;
  int buf = 0;
  if constexpr (MODE == 0) {
    MLA_ISSUE(t, 0);
    if (t < t_last) MLA_ISSUE(t + 1, 1);
  } else {
    load_k(t);
    load_v(t);
  }
  while (true) {
    const int tn = (MODE == 2) ? t - 1 : t + 1;
    const bool more = (MODE == 2) ? (t > 0) : (t < t_last);
    if constexpr (MODE == 0) {
      if (more) asm volatile("s_waitcnt vmcnt(5)" ::: "memory"); else asm volatile("s_waitcnt vmcnt(0)" ::: "memory");
      __builtin_amdgcn_s_barrier();
      asm volatile("" ::: "memory");
      if (t + 2 <= t_last) MLA_ISSUE(t + 2, buf == 0 ? 2 : buf - 1);
    } else {
      store_tile();
      __syncthreads();
      if (MODE == 2 && tid == 0) flg[(it & 1) ^ 1] = 0;
      if (MODE != 2 && more) { load_k(tn); load_v(tn); }
    }
    const char* Kc = (MODE == 0) ? (const char*)(smem + buf * MLA_STAGE) : (const char*)Ks;
    bool active = true;
    if (MODE == 0) active = (t <= t_diag + (w >> 1));
    if (MODE == 2) active = (t <= t_diag + (w >> 2));
    if (MODE != 2 && active) {
      f32x4 s[4][2];
#pragma unroll
      for (int ks = 0; ks < 4; ++ks) { s[ks][0] = f32x4{0.f, 0.f, 0.f, 0.f}; s[ks][1] = f32x4{0.f, 0.f, 0.f, 0.f}; }
#pragma unroll
      for (int st = 0; st < NST; ++st) {
#pragma unroll
        for (int ks = 0; ks < 4; ++ks) {
          bf16x8 kf = *(const bf16x8*)(Kc + st * 4096 + (ks * 16 + fr) * 64 + fqs);
          if (st < NSR) {
            s[ks][0] = mfma16(kf, qf[0][st < NSR ? st : 0], s[ks][0]);
            s[ks][1] = mfma16(kf, qf[1][st < NSR ? st : 0], s[ks][1]);
          } else {
            s[ks][0] = mfma16(kf, Qr[(st - NSR) * 64], s[ks][0]);
            s[ks][1] = mfma16(kf, Qr[(2 + st - NSR) * 64], s[ks][1]);
          }
        }
      }
      {
#pragma unroll
        for (int qs = 0; qs < 2; ++qs) {
          float mx = -1e30f;
#pragma unroll
          for (int ks = 0; ks < 4; ++ks)
#pragma unroll
            for (int j = 0; j < 4; ++j) mx = fmaxf(mx, s[ks][qs][j]);
          mx *= zscale;
          mx = xmax16(mx);
          mx = xmax32(mx);
          const bool bump = __builtin_amdgcn_ballot_w64(mx > mrow[qs] + 8.0f) != 0ull;
          float ls = 0.f;
          if (bump) {
            const float mn = fmaxf(mrow[qs], mx);
            const float alpha = __builtin_amdgcn_exp2f(mrow[qs] - mn);
            mrow[qs] = mn;
            lrow[qs] *= alpha;
#pragma unroll
            for (int ds = 0; ds < NDS; ++ds) o[ds][qs] *= alpha;
          }
          const float mref = mrow[qs];
#pragma unroll
          for (int ks = 0; ks < 4; ++ks)
#pragma unroll
            for (int j = 0; j < 4; ++j) {
              float pv = __builtin_amdgcn_exp2f(s[ks][qs][j] * zscale - mref);
              ls += pv;
              s[ks][qs][j] = pv;
            }
          lrow[qs] += ls;
        }
      }
      bf16x8 pf[2][2];
#pragma unroll
      for (int qs = 0; qs < 2; ++qs)
#pragma unroll
        for (int u = 0; u < 2; ++u) {
          uint4 pk;
          pk.x = pack2(s[2 * u][qs][0], s[2 * u][qs][1]);
          pk.y = pack2(s[2 * u][qs][2], s[2 * u][qs][3]);
          pk.z = pack2(s[2 * u + 1][qs][0], s[2 * u + 1][qs][1]);
          pk.w = pack2(s[2 * u + 1][qs][2], s[2 * u + 1][qs][3]);
          pf[qs][u] = *(bf16x8*)&pk;
        }
#pragma unroll
      for (int u = 0; u < 2; ++u) {
        bf16x8 vfr[NDS];
#pragma unroll
        for (int ds = 0; ds < NDS; ++ds) {
          if constexpr (MODE == 0) vfr[ds] = *(const bf16x8*)(Kc + 24576 + (ds * 16 + fr) * 128 + (((u * 4 + fq) ^ ((fr >> 1) & 7)) * 16));
          else vfr[ds] = *(const bf16x8*)(Vs + (ds * 16 + fr) * VST + u * 32 + fq * 8);
        }
#pragma unroll
        for (int ds = 0; ds < NDS; ++ds) {
          o[ds][0] = mfma16(vfr[ds], pf[0][u], o[ds][0]);
          o[ds][1] = mfma16(vfr[ds], pf[1][u], o[ds][1]);
        }
      }
    }
    if (MODE == 2 && active) {
#pragma unroll
      for (int qs = 0; qs < QSN; ++qs) {
        f32x4 s1[4];
#pragma unroll
        for (int ks = 0; ks < 4; ++ks) s1[ks] = f32x4{0.f, 0.f, 0.f, 0.f};
#pragma unroll
        for (int st = 0; st < NST; ++st) {
#pragma unroll
          for (int ks = 0; ks < 4; ++ks) {
            bf16x8 kf = *(const bf16x8*)(Kc + st * 4096 + (ks * 16 + fr) * 64 + fqs);
            s1[ks] = mfma16(kf, qf[qs][st], s1[ks]);
          }
        }
        const int tq = q0 + w * (16 * QSN) + qs * 16 + fr;
        float running = lrow[qs];
#pragma unroll
        for (int ks = 3; ks >= 0; --ks) {
          float l1[4], lb[4];
#pragma unroll
          for (int j = 0; j < 4; ++j) {
            const float z = s1[ks][j] * zscale;
            const float e = __expf(-fabsf(z));
            const float sp = fmaxf(z, 0.f) + __logf(1.f + e);
            const int key = t * 64 + ks * 16 + fq * 4 + j;
            l1[j] = (key < tq) ? -sp : 0.f;
            lb[j] = z - sp;
          }
          const float p4 = (l1[0] + l1[1]) + (l1[2] + l1[3]);
          const float x16 = shx(p4, lane, 16);
          const float a2 = p4 + x16;
          const float x32 = shx(a2, lane, 32);
          const float tot = a2 + x32;
          const float gt = ((fq & 1) == 0 ? x16 : 0.f) + ((fq & 2) == 0 ? x32 : 0.f);
          const float s3 = running + gt;
          const float s2 = s3 + l1[3];
          const float s1_ = s2 + l1[2];
          const float s0 = s1_ + l1[1];
          s1[ks][0] = (l1[0] < 0.f) ? __expf(lb[0] + s0) : 0.f;
          s1[ks][1] = (l1[1] < 0.f) ? __expf(lb[1] + s1_) : 0.f;
          s1[ks][2] = (l1[2] < 0.f) ? __expf(lb[2] + s2) : 0.f;
          s1[ks][3] = (l1[3] < 0.f) ? __expf(lb[3] + s3) : 0.f;
          running += tot;
        }
        lrow[qs] = running;
        asm volatile("" ::: "memory");
#pragma unroll
        for (int u = 0; u < 2; ++u) {
          uint4 pk;
          pk.x = pack2(s1[2 * u][0], s1[2 * u][1]);
          pk.y = pack2(s1[2 * u][2], s1[2 * u][3]);
          pk.z = pack2(s1[2 * u + 1][0], s1[2 * u + 1][1]);
          pk.w = pack2(s1[2 * u + 1][2], s1[2 * u + 1][3]);
          bf16x8 pf1 = *(bf16x8*)&pk;
          bf16x8 vfr[NDS];
#pragma unroll
          for (int ds = 0; ds < NDS; ++ds) vfr[ds] = *(const bf16x8*)(Vs + (ds * 16 + fr) * VST + u * 32 + fq * 8);
#pragma unroll
          for (int ds = 0; ds < NDS; ++ds) o[ds][qs] = mfma16(vfr[ds], pf1, o[ds][qs]);
        }
        asm volatile("" ::: "memory");
        __builtin_amdgcn_sched_barrier(0);
      }
    }
    if (MODE == 2) {
      __builtin_amdgcn_sched_barrier(0);
      if (more) { load_k(tn); load_v(tn); }
      const int cont = (more && (lrow[0] >= -104.f || (QSN > 1 && lrow[1] >= -104.f))) ? 1 : 0;
      if (lane == 0 && __builtin_amdgcn_ballot_w64(cont != 0) != 0ull) flg[it & 1] = 1;
      __syncthreads();
      if (!flg[it & 1]) break;
      ++it;
    } else if (MODE == 1) {
      __syncthreads();
      if (!more) break;
    } else {
      if (!more) break;
      buf = (buf == 2) ? 0 : buf + 1;
    }
    t = tn;
  }
  if (MODE == 0 && nseg > 1) {
    typedef unsigned long long u64;
    volatile int* ctlw = (volatile int*)(smem + CTL_OFF);
    {
      u64* po = (u64*)(part + (size_t)seg * (6 * (PART_BYTES / 4))) + (size_t)(w * 34) * 64 + lane;
#pragma unroll
      for (int ds = 0; ds < NDS; ++ds)
#pragma unroll
        for (int qs = 0; qs < 2; ++qs) {
          const f32x4 v = o[ds][qs];
          const u64 lo = ((u64)__float_as_uint(v[1]) << 32) | __float_as_uint(v[0]), hi = ((u64)__float_as_uint(v[3]) << 32) | __float_as_uint(v[2]);
          __hip_atomic_store(po + ((ds * 2 + qs) * 2 + 0) * 64, lo, __ATOMIC_RELAXED, __HIP_MEMORY_SCOPE_AGENT);
          __hip_atomic_store(po + ((ds * 2 + qs) * 2 + 1) * 64, hi, __ATOMIC_RELAXED, __HIP_MEMORY_SCOPE_AGENT);
        }
      __hip_atomic_store(po + 32 * 64, ((u64)__float_as_uint(mrow[1]) << 32) | __float_as_uint(mrow[0]), __ATOMIC_RELAXED, __HIP_MEMORY_SCOPE_AGENT);
      __hip_atomic_store(po + 33 * 64, ((u64)__float_as_uint(lrow[1]) << 32) | __float_as_uint(lrow[0]), __ATOMIC_RELAXED, __HIP_MEMORY_SCOPE_AGENT);
    }
    asm volatile("s_waitcnt vmcnt(0)" ::: "memory");
    __syncthreads();
    if (tid == 0) ctlw[1] = (int)atomicAdd(cnt, 1u);
    __syncthreads();
    const int rank = __builtin_amdgcn_readfirstlane(ctlw[1]);
    if (rank != nseg - 1) return;
    for (int s2 = 0; s2 < nseg; ++s2) {
      if (s2 == seg) continue;
      u64* po = (u64*)(part + (size_t)s2 * (6 * (PART_BYTES / 4))) + (size_t)(w * 34) * 64 + lane;
      const u64 m2p = __hip_atomic_load(po + 32 * 64, __ATOMIC_RELAXED, __HIP_MEMORY_SCOPE_AGENT);
      const u64 l2p = __hip_atomic_load(po + 33 * 64, __ATOMIC_RELAXED, __HIP_MEMORY_SCOPE_AGENT);
#pragma unroll
      for (int qs = 0; qs < 2; ++qs) {
        const float m2 = __uint_as_float((unsigned)(m2p >> (32 * qs))), l2 = __uint_as_float((unsigned)(l2p >> (32 * qs)));
        const float mn = fmaxf(mrow[qs], m2);
        const float ca = __builtin_amdgcn_exp2f(mrow[qs] - mn), cb = __builtin_amdgcn_exp2f(m2 - mn);
        mrow[qs] = mn;
        lrow[qs] = lrow[qs] * ca + l2 * cb;
        u64 plo[NDS], phi[NDS];
#pragma unroll
        for (int ds = 0; ds < NDS; ++ds) {
          plo[ds] = __hip_atomic_load(po + ((ds * 2 + qs) * 2 + 0) * 64, __ATOMIC_RELAXED, __HIP_MEMORY_SCOPE_AGENT);
          phi[ds] = __hip_atomic_load(po + ((ds * 2 + qs) * 2 + 1) * 64, __ATOMIC_RELAXED, __HIP_MEMORY_SCOPE_AGENT);
        }
#pragma unroll
        for (int ds = 0; ds < NDS; ++ds) {
          f32x4 o2;
          o2[0] = __uint_as_float((unsigned)plo[ds]); o2[1] = __uint_as_float((unsigned)(plo[ds] >> 32));
          o2[2] = __uint_as_float((unsigned)phi[ds]); o2[3] = __uint_as_float((unsigned)(phi[ds] >> 32));
          o[ds][qs] = o[ds][qs] * ca + o2 * cb;
        }
      }
    }
  }
  int fr_e = fr, fq_e = fq;
  asm volatile("" : "+v"(fr_e), "+v"(fq_e));
#pragma unroll
  for (int qs = 0; qs < QSN; ++qs) {
    float inv = 1.f;
    if (MODE != 2) {
      float lsum = lrow[qs];
      lsum = xsum16(lsum);
      lsum = xsum32(lsum);
      inv = 1.f / lsum;
    }
    const int row = w * (16 * QSN) + qs * 16 + fr_e;
#pragma unroll
    for (int ds = 0; ds < NDS; ++ds) {
      const int dv = ds * 16 + fq_e * 4;
      uint2 g2 = *(const uint2*)(gate + (unsigned)(row * DIN + dv));
      float v0 = o[ds][qs][0] * inv * bflo(g2.x), v1 = o[ds][qs][1] * inv * bfhi(g2.x);
      float v2 = o[ds][qs][2] * inv * bflo(g2.y), v3 = o[ds][qs][3] * inv * bfhi(g2.y);
      *(uint2*)(outp + (unsigned)(row * DM + dv)) = make_uint2(pack2(v0, v1), pack2(v2, v3));
    }
  }
}

#undef KLOAD
#undef KSTORE
#undef VLOAD
#undef VSTORE
#undef load_k
#undef load_v
#undef store_tile

#undef KLOAD
#undef KSTORE
#undef VLOAD
#undef VSTORE
#undef load_k
#undef load_v
#undef store_tile
#undef MLA_ISSUE

__device__ void gmlp_item(const Params& p, int l, int n, int g, char* smem, int wv) {
  constexpr int WST = 136;
  u16* Ws = (u16*)smem;
  u16* Bs = Ws + 128 * WST;
  float* s_mu = (float*)(Bs + 128 * WST);
  float* s_rs = s_mu + 128;
  const int tid = tid_of(wv);
  const int w = wv, lane = tid & 63, fr = lane & 15, fq = lane >> 4;
  const int row0 = n * 128;
  {
    const int r = tid >> 2, qt = tid & 3;
    const u16* src = p.h() + (size_t)(row0 + r) * DIN + C_SGV + qt * 128;
    uint4 v[16];
#pragma unroll
    for (int i = 0; i < 16; ++i) v[i] = *(const uint4*)(src + i * 8);
    float s = 0.f, q = 0.f;
#pragma unroll
    for (int i = 0; i < 16; ++i) {
      const unsigned ww[4] = {v[i].x, v[i].y, v[i].z, v[i].w};
#pragma unroll
      for (int k = 0; k < 4; ++k) { float a = bflo(ww[k]), b = bfhi(ww[k]); s += a + b; q += a * a + b * b; }
    }
    s += shx(s, lane, 1); q += shx(q, lane, 1);
    s += shx(s, lane, 2); q += shx(q, lane, 2);
    const float mu = s * (1.f / 512.f);
    const float var = fmaxf(q * (1.f / 512.f) - mu * mu, 0.f);
    if (qt == 0) { s_mu[r] = mu; s_rs[r] = rsqrtf(var + 1e-5f); }
  }
  {
    const float* wsrc = p.sg_w + (size_t)(l * 4 + g) * 128 * 128;
    float4 wv4[8];
#pragma unroll
    for (int i = 0; i < 8; ++i) { int id = tid + NT * i; wv4[i] = *(const float4*)(wsrc + (id >> 5) * 128 + (id & 31) * 4); }
#pragma unroll
    for (int i = 0; i < 8; ++i) {
      int id = tid + NT * i, tt = id >> 5, s4 = (id & 31) * 4;
      float4 v = wv4[i];
      if (tt < 64 && s4 >= 64) v = make_float4(0.f, 0.f, 0.f, 0.f);
      *(uint2*)(Ws + tt * WST + s4) = make_uint2(pack2(v.x, v.y), pack2(v.z, v.w));
    }
  }
  const int bs_ = tid >> 2, bc_ = (tid & 3) * 32;
  uint4 bch[4];
#pragma unroll
  for (int i = 0; i < 4; ++i) bch[i] = *(const uint4*)(p.h() + (size_t)(row0 + bs_) * DIN + C_SGV + g * 128 + bc_ + i * 8);
  float4 lgv[8], lbv[8];
#pragma unroll
  for (int i = 0; i < 8; ++i) { lgv[i] = *(const float4*)(p.sg_ln_g + (size_t)l * 512 + g * 128 + bc_ + i * 4); lbv[i] = *(const float4*)(p.sg_ln_b + (size_t)l * 512 + g * 128 + bc_ + i * 4); }
  const int tt_e = w * 16 + fr;
  const float bias_e = p.sg_b[(size_t)(l * 4 + g) * 128 + tt_e];
  uint2 u2e[8], g2e[8];
#pragma unroll
  for (int ns = 0; ns < 8; ++ns) {
    const u16* hr = p.h() + (size_t)(row0 + tt_e) * DIN + g * 128 + ns * 16 + fq * 4;
    u2e[ns] = *(const uint2*)(hr + C_SGU); g2e[ns] = *(const uint2*)(hr + C_GB);
  }
  __syncthreads();
  {
    const float mu = s_mu[bs_], rs = s_rs[bs_];
#pragma unroll
    for (int i = 0; i < 4; ++i) {
      const int c0 = bc_ + i * 8;
      const float4 g0 = lgv[2 * i], g1 = lgv[2 * i + 1], b0 = lbv[2 * i], b1 = lbv[2 * i + 1];
      const unsigned ww[4] = {bch[i].x, bch[i].y, bch[i].z, bch[i].w};
      const float gg[8] = {g0.x, g0.y, g0.z, g0.w, g1.x, g1.y, g1.z, g1.w}, bb[8] = {b0.x, b0.y, b0.z, b0.w, b1.x, b1.y, b1.z, b1.w};
#pragma unroll
      for (int k = 0; k < 4; ++k) {
        const float v0 = (bflo(ww[k]) - mu) * rs * gg[2 * k] + bb[2 * k], v1 = (bfhi(ww[k]) - mu) * rs * gg[2 * k + 1] + bb[2 * k + 1];
        const unsigned pk = pack2(v0, v1);
        Bs[(c0 + 2 * k) * WST + bs_] = (u16)(pk & 0xffffu);
        Bs[(c0 + 2 * k + 1) * WST + bs_] = (u16)(pk >> 16);
      }
    }
  }
  __syncthreads();
  f32x4 acc[8];
#pragma unroll
  for (int ns = 0; ns < 8; ++ns) acc[ns] = f32x4{0.f, 0.f, 0.f, 0.f};
#pragma unroll
  for (int st = 0; st < 4; ++st) {
    const bf16x8 wf = *(const bf16x8*)(Ws + (w * 16 + fr) * WST + st * 32 + fq * 8);
#pragma unroll
    for (int ns = 0; ns < 8; ++ns) {
      bf16x8 bfv = *(const bf16x8*)(Bs + (ns * 16 + fr) * WST + st * 32 + fq * 8);
      acc[ns] = mfma16(bfv, wf, acc[ns]);
    }
  }
  {
    const int tt = w * 16 + fr;
    const float bias = bias_e;
    const u16* hrow = p.h() + (size_t)(row0 + tt) * DIN;
#pragma unroll
    for (int ns = 0; ns < 8; ++ns) {
      const int c = g * 128 + ns * 16 + fq * 4;
      const uint2 u2 = u2e[ns], g2 = g2e[ns];
      float v0 = bflo(u2.x) * (acc[ns][0] + bias) * bflo(g2.x);
      float v1 = bfhi(u2.x) * (acc[ns][1] + bias) * bfhi(g2.x);
      float v2 = bflo(u2.y) * (acc[ns][2] + bias) * bflo(g2.y);
      float v3 = bfhi(u2.y) * (acc[ns][3] + bias) * bfhi(g2.y);
      *(uint2*)(p.yin() + (size_t)(row0 + tt) * DM + 768 + c) = make_uint2(pack2(v0, v1), pack2(v2, v3));
    }
  }
  __syncthreads();
}

__device__ const unsigned g_mla_items[288] = {
  0x7e0101fu, 0x7e0103fu, 0x7e0105fu, 0x7e0107fu, 0x7e0109fu, 0x7e010bfu, 0x4e00809u, 0x4e00829u, 0xff0111fu, 0xff0113fu, 0xff0115fu, 0xff0117fu,
  0xff0119fu, 0xff011bfu, 0x4e00849u, 0x4e00869u, 0x7e0080fu, 0x7e0082fu, 0x7e0084fu, 0x7e0086fu, 0x7e0088fu, 0x7e008afu, 0x4e00889u, 0x4e008a9u,
  0x7a0101eu, 0x7a0103eu, 0x7a0105eu, 0x7a0107eu, 0x7a0109eu, 0x7a010beu, 0x4a01012u, 0x9699112u, 0xf6f911eu, 0xf6f913eu, 0xf6f915eu, 0xf6f917eu,
  0xf6f919eu, 0xf6f91beu, 0x4a01032u, 0x9699132u, 0x760101du, 0x760103du, 0x760105du, 0x760107du, 0x760109du, 0x76010bdu, 0x4a01052u, 0x9699152u,
  0xeef111du, 0xeef113du, 0xeef115du, 0xeef117du, 0xeef119du, 0xeef11bdu, 0x4a01072u, 0x9699172u, 0x760080eu, 0x760082eu, 0x760084eu, 0x760086eu,
  0x760088eu, 0x76008aeu, 0x4a01092u, 0x9699192u, 0x720101cu, 0x720103cu, 0x720105cu, 0x720107cu, 0x720109cu, 0x72010bcu, 0x4a010b2u, 0x96991b2u,
  0xe6e911cu, 0xe6e913cu, 0xe6e915cu, 0xe6e917cu, 0xe6e919cu, 0xe6e91bcu, 0x4601011u, 0x8e91111u, 0x6e0101bu, 0x6e0103bu, 0x6e0105bu, 0x6e0107bu,
  0x6e0109bu, 0x6e010bbu, 0x4601031u, 0x8e91131u, 0xdee111bu, 0xdee113bu, 0xdee115bu, 0xdee117bu, 0xdee119bu, 0xdee11bbu, 0x4601051u, 0x8e91151u,
  0x6e0080du, 0x6e0082du, 0x6e0084du, 0x6e0086du, 0x6e0088du, 0x6e008adu, 0x4601071u, 0x8e91171u, 0x6a0101au, 0x6a0103au, 0x6a0105au, 0x6a0107au,
  0x6a0109au, 0x6a010bau, 0x4601091u, 0x8e91191u, 0xd6d911au, 0xd6d913au, 0xd6d915au, 0xd6d917au, 0xd6d919au, 0xd6d91bau, 0x46010b1u, 0x8e911b1u,
  0x6601019u, 0x6601039u, 0x6601059u, 0x6601079u, 0x6601099u, 0x66010b9u, 0x4600808u, 0x4600828u, 0xced1119u, 0xced1139u, 0xced1159u, 0xced1179u,
  0xced1199u, 0xced11b9u, 0x4600848u, 0x4600868u, 0x660080cu, 0x660082cu, 0x660084cu, 0x660086cu, 0x660088cu, 0x66008acu, 0x4600888u, 0x46008a8u,
  0x6201018u, 0x6201038u, 0x6201058u, 0x6201078u, 0x6201098u, 0x62010b8u, 0x4201010u, 0x8689110u, 0xc6c9118u, 0xc6c9138u, 0xc6c9158u, 0xc6c9178u,
  0xc6c9198u, 0xc6c91b8u, 0x4201030u, 0x8689130u, 0x5e01017u, 0x5e01037u, 0x5e01057u, 0x5e01077u, 0x5e01097u, 0x5e010b7u, 0x4201050u, 0x8689150u,
  0xbec1117u, 0xbec1137u, 0xbec1157u, 0xbec1177u, 0xbec1197u, 0xbec11b7u, 0x4201070u, 0x8689170u, 0x5e0080bu, 0x5e0082bu, 0x5e0084bu, 0x5e0086bu,
  0x5e0088bu, 0x5e008abu, 0x4201090u, 0x8689190u, 0x5a01016u, 0x5a01036u, 0x5a01056u, 0x5a01076u, 0x5a01096u, 0x5a010b6u, 0x42010b0u, 0x86891b0u,
  0xb6b9116u, 0xb6b9136u, 0xb6b9156u, 0xb6b9176u, 0xb6b9196u, 0xb6b91b6u, 0x3e00807u, 0x3e00827u, 0x5601015u, 0x5601035u, 0x5601055u, 0x5601075u,
  0x5601095u, 0x56010b5u, 0x3e00847u, 0x3e00867u, 0xaeb1115u, 0xaeb1135u, 0xaeb1155u, 0xaeb1175u, 0xaeb1195u, 0xaeb11b5u, 0x3e00887u, 0x3e008a7u,
  0x560080au, 0x560082au, 0x560084au, 0x560086au, 0x560088au, 0x56008aau, 0x3600806u, 0x3600826u, 0x5201014u, 0x5201034u, 0x5201054u, 0x5201074u,
  0x5201094u, 0x52010b4u, 0x3600846u, 0x3600866u, 0xa6a9114u, 0xa6a9134u, 0xa6a9154u, 0xa6a9174u, 0xa6a9194u, 0xa6a91b4u, 0x3600886u, 0x36008a6u,
  0x4e01013u, 0x4e01033u, 0x4e01053u, 0x4e01073u, 0x4e01093u, 0x4e010b3u, 0x2e00805u, 0x2e00825u, 0x9ea1113u, 0x9ea1133u, 0x9ea1153u, 0x9ea1173u,
  0x9ea1193u, 0x9ea11b3u, 0x2e00845u, 0x2e00865u, 0x2e00885u, 0x2e008a5u, 0x2600804u, 0x2600824u, 0x2600844u, 0x2600864u, 0x2600884u, 0x26008a4u,
  0x1e00803u, 0x1e00823u, 0x1e00843u, 0x1e00863u, 0x1e00883u, 0x1e008a3u, 0x1600802u, 0x1600822u, 0x1600842u, 0x1600862u, 0x1600882u, 0x16008a2u,
  0xe00801u, 0xe00821u, 0xe00841u, 0xe00861u, 0xe00881u, 0xe008a1u, 0x600800u, 0x600820u, 0x600840u, 0x600860u, 0x600880u, 0x6008a0u,
};
__device__ const unsigned char g_slot_base[32] = {0, 0, 0, 0, 0, 0, 0, 0, 0, 0, 0, 0, 0, 0, 0, 0, 0, 2, 4, 6, 8, 10, 12, 14, 16, 18, 20, 22, 24, 26, 28, 30};

#ifndef PROBE_PHASE
#define PROBE_PHASE 0
#endif
#define PROBE_BEGIN(k) unsigned long long pt0_##k = 0; if (PROBE_PHASE == k) pt0_##k = __builtin_amdgcn_s_memrealtime();
#define PROBE_END(k) if (PROBE_PHASE == k) { const unsigned long long dt_ = __builtin_amdgcn_s_memrealtime() - pt0_##k, t1_ = __builtin_amdgcn_s_memrealtime(); \
    while (__builtin_amdgcn_s_memrealtime() - t1_ < dt_) __builtin_amdgcn_s_sleep(8); }
__device__ void phaseC(const Params& p, int l, int ci, char* smem, int wv) {
  volatile int* ctl = (volatile int*)(smem + CTL_OFF);
  constexpr int N_MLA = 288, N_SB = 256, N_MEM = 128, N_G = 256;
  constexpr int N_ALL = N_MLA + N_SB + N_MEM + N_G;
  bool first = true;
  while (true) {
    __syncthreads();
    if (tid_of(wv) == 0) ctl[0] = first ? (int)blockIdx.x : (int)atomicAdd(&p.ctr()[ci], 1u);
    first = false;
    __syncthreads();
    const int qi = __builtin_amdgcn_readfirstlane(ctl[0]);
    if (qi >= N_ALL) break;
    const int item = qi < N_MLA ? qi : qi < N_MLA + N_G ? qi + N_SB + N_MEM : qi - N_G;
    const int kind_ = item < N_MLA ? 7 : item < N_MLA + N_SB ? 8 : item < N_MLA + N_SB + N_MEM ? 9 : 10;
    unsigned long long it0_ = 0; if (PROBE_PHASE == kind_) it0_ = __builtin_amdgcn_s_memrealtime();
    if (item < N_MLA) {
      const unsigned wd = g_mla_items[item];
      const int qb = wd & 31, hd = (wd >> 5) & 7, seg = (wd >> 8) & 7, nseg = (wd >> 11) & 7, t0 = (wd >> 14) & 127, t1 = (wd >> 21) & 127;
      const int q0 = qb * 256;
      const int sbase = g_slot_base[qb];
      attn_item<192, 128, 0, 2>(p.q() + ((size_t)hd * SEQ + q0) * 192, 192, p.k() + (size_t)hd * SEQ * 192, 192,
                                p.vt() + (size_t)hd * 128 * SEQ, SEQ, t0, t1, 4 * qb, 1.0f, q0,
                                p.h() + (size_t)q0 * DIN + C_GA + hd * 128, p.yin() + (size_t)q0 * DM + hd * 128, smem, wv,
                                nseg, seg, p.part() + (size_t)(sbase * 6 + hd) * (PART_BYTES / 4), p.ctr() + 64 + (l * 32 + qb) * 6 + hd);
    } else if (item < N_MLA + N_SB) {
      const int it = item - N_MLA, qb = 63 - (it >> 2), hd = it & 3, q0 = qb * 128;
      attn_item<128, 128, 2, 1>(p.h() + (size_t)q0 * DIN + C_SBQ + hd * 128, DIN, p.h() + C_SBK + hd * 128, DIN,
                             p.vtsb() + (size_t)hd * 128 * SEQ, SEQ, 0, 2 * qb + 1, 2 * qb, 0.08838834764831845f, q0,
                             p.h() + (size_t)q0 * DIN + C_GC + hd * 128, p.yin() + (size_t)q0 * DM + 1280 + hd * 128, smem, wv);
    } else if (item < N_MLA + N_SB + N_MEM) {
      const int it = item - N_MLA - N_SB, qb = it >> 2, hd = it & 3, q0 = qb * 256;
      attn_item<64, 64, 1, 2>(p.h() + (size_t)q0 * DIN + C_MQ + hd * 64, DIN, p.mk() + (size_t)(l * 4 + hd) * 256 * 64, 64,
                           p.mvt() + (size_t)(l * 4 + hd) * 64 * 256, 256, 0, 3, 0, 0.125f * 1.4426950408889634f, q0,
                           p.h() + (size_t)q0 * DIN + C_GM + hd * 64, p.yin() + (size_t)q0 * DM + 1792 + hd * 64, smem, wv);
    } else {
      const int it = item - N_MLA - N_SB - N_MEM;
      gmlp_item(p, l, it >> 2, it & 3, smem, wv);
    }
    if (PROBE_PHASE == kind_) { const unsigned long long dt_ = __builtin_amdgcn_s_memrealtime() - it0_, t1_ = __builtin_amdgcn_s_memrealtime();
      while (__builtin_amdgcn_s_memrealtime() - t1_ < dt_) __builtin_amdgcn_s_sleep(8); }
  }
}

__global__ void __launch_bounds__(NT, 2) fwd_megakernel(Params p) {
  extern __shared__ __attribute__((aligned(16))) char smem[];
  volatile LAS unsigned* xst = (volatile LAS unsigned*)(smem + CTL_OFF + 16);
  const int wv = __builtin_amdgcn_readfirstlane(threadIdx.x >> 6);
  if (tid_of(wv) == 0) { xst[0] = 0u; xst[1] = 0u; }
  __syncthreads();
  const XcdBarrier xb = xcd_barrier_post(p.bar(), xst, wv);
#define grid_barrier() xcd_barrier(xb, wv)
  LAS unsigned char* glds = (LAS unsigned char*)smem;
  const int G = gridDim.x, B = blockIdx.x;
  PROBE_BEGIN(1)
  phase_prep(p, smem, wv);
  if (p.ws == nullptr) cg::this_grid().sync(); else grid_barrier();
  PROBE_END(1)
  for (int l = 0; l < NL; ++l) {
    int Bl = B, Gl = G, wvl = wv;
    asm volatile("" : "+s"(Bl), "+s"(Gl), "+s"(wvl));
    Params pl = p;
    { char* w_ = pl.ws; asm volatile("" : "+s"(w_)); pl.ws = w_; }
    PROBE_BEGIN(2)
    {
      pg8::StaticOrder S; S.init(SEQ, DINP, Gl, Bl);
      pg8::Gemm g{pl.xb(), pl.wt_in() + (size_t)l * DINP * DM, DM, DM, DM};
      EpiA E{pl, l};
      pg8::gemm_phase(glds, g, S, E, wvl);
    }
    if (l == 0) {
      __syncthreads();
      pg8::StaticOrder S; S.init(256, NL * 512, Gl, (Bl + 32) % Gl);
      pg8::Gemm g{pl.memb(), pl.wt_memkv(), DM, DM, DM};
      EpiMem E{pl};
      pg8::gemm_phase(glds, g, S, E, wvl);
    }
    grid_barrier();
    PROBE_END(2)
    PROBE_BEGIN(3)
    {
      pg8::StrideOrder Sq, Skv;
      if (Gl == 256) { Sq = pg8::StrideOrder{Bl, 0, Bl < 160 ? 1 : 0, 160}; Skv = pg8::StrideOrder{(Bl - 160) * 2, 1, Bl >= 160 ? 2 : 0, 192}; }
      else { Sq = pg8::StrideOrder{Bl, Gl, 1 << 20, 160}; Skv = pg8::StrideOrder{Bl, Gl, 1 << 20, 192}; }
      {
        pg8::Gemm g{pl.h() + C_CQ, pl.wt_uq() + (size_t)l * UQP * 512, DIN, 512, 512};
        EpiQ E{pl};
        pg8::gemm_phase(glds, g, Sq, E, wvl);
      }
      __syncthreads();
      {
        pg8::Gemm g{pl.h() + C_CKV, pl.wt_ukv() + (size_t)l * 1536 * 256, DIN, 256, 256};
        EpiKV E{pl};
        pg8::gemm_phase(glds, g, Skv, E, wvl);
      }
    }
    grid_barrier();
    PROBE_END(3)
    PROBE_BEGIN(4)
    phaseC(pl, l, l, smem, wvl);
    grid_barrier();
    PROBE_END(4)
    PROBE_BEGIN(5)
    {
      pg8::StaticOrder S; S.init(SEQ, DM, Gl, Bl);
      pg8::Gemm g{pl.yin(), pl.wt_out() + (size_t)l * DM * DM, DM, DM, DM};
      EpiDF E{pl, l, smem};
      pg8::gemm_phase(glds, g, S, E, wvl);
    }
    if (l + 1 < NL) grid_barrier();
    PROBE_END(5)
  }
}

extern "C" void kernel_launch(void* const* d_in, const int* in_sizes, int n_in, void* d_out, int out_size, void* d_ws,
                              size_t ws_size, hipStream_t stream) {
  static int grid_blocks = 0;
  if (!grid_blocks) {
    int dev = 0, cus = 0, per_cu = 0;
    (void)hipGetDevice(&dev);
    (void)hipDeviceGetAttribute(&cus, hipDeviceAttributeMultiprocessorCount, dev);
    (void)hipFuncSetAttribute((const void*)fwd_megakernel, hipFuncAttributeMaxDynamicSharedMemorySize, LDS_BYTES);
    (void)hipOccupancyMaxActiveBlocksPerMultiprocessor(&per_cu, fwd_megakernel, NT, LDS_BYTES);
    if (per_cu > 1) per_cu = 1;
    if (per_cu < 1) per_cu = 1;
    grid_blocks = cus * per_cu;
  }
  Params p{};
  p.x = (const float*)d_in[0]; p.mem = (const float*)d_in[1]; p.pos = (const int*)d_in[2]; p.w_in = (const float*)d_in[3];
  p.q_norm_g = (const float*)d_in[4]; p.w_uq = (const float*)d_in[5]; p.kv_norm_g = (const float*)d_in[6];
  p.w_ukv = (const float*)d_in[7]; p.sg_ln_g = (const float*)d_in[8]; p.sg_ln_b = (const float*)d_in[9];
  p.sg_w = (const float*)d_in[10]; p.sg_b = (const float*)d_in[11]; p.w_mem_k = (const float*)d_in[12];
  p.w_mem_v = (const float*)d_in[13]; p.w_out = (const float*)d_in[14]; p.ln_g = (const float*)d_in[15];
  p.ln_b = (const float*)d_in[16];
  p.out = (float*)d_out;
  p.ws = (char*)d_ws;
  (void)hipMemsetAsync(p.ws + OFF_BAR, 0, 16384, stream);
  void* args[] = {&p};
  hipError_t e = hipLaunchCooperativeKernel((const void*)fwd_megakernel, dim3(grid_blocks), dim3(NT), args, LDS_BYTES, stream);
  if (e != hipSuccess) fprintf(stderr, "cooperative launch failed: %s (grid %d)\n", hipGetErrorString(e), grid_blocks);
}
```

```cpp
#include <hip/hip_runtime.h>
#include <hip/hip_cooperative_groups.h>
#include <cstdio>
namespace cg = cooperative_groups;

typedef unsigned short u16;
using bf16x8 = __attribute__((ext_vector_type(8))) short;
using f32x4 = __attribute__((ext_vector_type(4))) float;
typedef __bf16 bf16x2_t __attribute__((ext_vector_type(2)));
typedef float f32x2_t __attribute__((ext_vector_type(2)));

#define SEQ 8192
#define DM 2048
#define DIN 5696
#define DINP 5888
#define UQP 1280
#define NL 4
#define NT 512

constexpr int GEMM_LDS = 131072;
constexpr int MLA_STAGE = 40960;
constexpr int MLA_QR_OFF = 3 * MLA_STAGE;
constexpr int CTL_OFF = MLA_QR_OFF + 32768;
constexpr int LDS_BYTES = CTL_OFF + 256;

constexpr int C_CQ = 0, C_CKV = 512, C_KPE = 768, C_GA = 832, C_SGU = 1600, C_SGV = 2112, C_GB = 2624,
              C_SBQ = 3136, C_SBK = 3648, C_SBV = 4160, C_GC = 4672, C_MQ = 5184, C_GM = 5440;

constexpr size_t al256(size_t x) { return (x + 255) & ~(size_t)255; }
constexpr size_t OFF_BAR = 0;
constexpr size_t OFF_CTR = OFF_BAR + al256(16384);
constexpr size_t OFF_SSQ = OFF_CTR + al256(8192);
constexpr size_t OFF_WT_IN = OFF_SSQ + al256((size_t)2 * SEQ * 4);
constexpr size_t OFF_WT_OUT = OFF_WT_IN + al256((size_t)NL * DINP * DM * 2);
constexpr size_t OFF_WT_UQ = OFF_WT_OUT + al256((size_t)NL * DM * DM * 2);
constexpr size_t OFF_WT_UKV = OFF_WT_UQ + al256((size_t)NL * UQP * 512 * 2);
constexpr size_t OFF_WT_MEMKV = OFF_WT_UKV + al256((size_t)NL * 1536 * 256 * 2);
constexpr size_t OFF_MEMB = OFF_WT_MEMKV + al256((size_t)NL * 512 * DM * 2);
constexpr size_t OFF_XB = OFF_MEMB + al256((size_t)256 * DM * 2);
constexpr size_t OFF_H = OFF_XB + al256((size_t)SEQ * DM * 2);
constexpr size_t OFF_Q = OFF_H + al256((size_t)SEQ * DIN * 2);
constexpr size_t OFF_K = OFF_Q + al256((size_t)6 * SEQ * 192 * 2);
constexpr size_t OFF_VT = OFF_K + al256((size_t)6 * SEQ * 192 * 2);
constexpr size_t OFF_VTSB = OFF_VT + al256((size_t)6 * 128 * SEQ * 2);
constexpr size_t OFF_YIN = OFF_VTSB + al256((size_t)4 * 128 * SEQ * 2);
constexpr size_t OFF_MK = OFF_YIN + al256((size_t)SEQ * DM * 2);
constexpr size_t OFF_MVT = OFF_MK + al256((size_t)NL * 4 * 256 * 64 * 2);
constexpr size_t OFF_COST = OFF_MVT + al256((size_t)NL * 4 * 64 * 256 * 2);
constexpr size_t OFF_SINT = OFF_COST + al256((size_t)SEQ * 32 * 4);
constexpr size_t OFF_LNSTAT = OFF_SINT + al256((size_t)SEQ * 32 * 4);
constexpr size_t OFF_LNX = OFF_LNSTAT + al256((size_t)SEQ * 2 * 4);
constexpr size_t OFF_PART = OFF_LNX + al256((size_t)32 * 8 * 256 * 8);
constexpr size_t PART_BYTES = 139264;
constexpr size_t WS_TOTAL = OFF_PART + al256((size_t)192 * PART_BYTES);
struct Params {
  const float* x; const float* mem; const int* pos; const float* w_in; const float* q_norm_g; const float* w_uq;
  const float* kv_norm_g; const float* w_ukv; const float* sg_ln_g; const float* sg_ln_b; const float* sg_w; const float* sg_b;
  const float* w_mem_k; const float* w_mem_v; const float* w_out; const float* ln_g; const float* ln_b;
  float* out;
  char* ws;
  __device__ __forceinline__ unsigned* bar() const { return (unsigned*)(ws + OFF_BAR); }
  __device__ __forceinline__ unsigned* ctr() const { return (unsigned*)(ws + OFF_CTR); }
  __device__ __forceinline__ float* ssq() const { return (float*)(ws + OFF_SSQ); }
  __device__ __forceinline__ u16* wt_in() const { return (u16*)(ws + OFF_WT_IN); }
  __device__ __forceinline__ u16* wt_out() const { return (u16*)(ws + OFF_WT_OUT); }
  __device__ __forceinline__ u16* wt_uq() const { return (u16*)(ws + OFF_WT_UQ); }
  __device__ __forceinline__ u16* wt_ukv() const { return (u16*)(ws + OFF_WT_UKV); }
  __device__ __forceinline__ u16* wt_memkv() const { return (u16*)(ws + OFF_WT_MEMKV); }
  __device__ __forceinline__ u16* memb() const { return (u16*)(ws + OFF_MEMB); }
  __device__ __forceinline__ u16* xb() const { return (u16*)(ws + OFF_XB); }
  __device__ __forceinline__ u16* h() const { return (u16*)(ws + OFF_H); }
  __device__ __forceinline__ u16* q() const { return (u16*)(ws + OFF_Q); }
  __device__ __forceinline__ u16* k() const { return (u16*)(ws + OFF_K); }
  __device__ __forceinline__ u16* vt() const { return (u16*)(ws + OFF_VT); }
  __device__ __forceinline__ u16* vtsb() const { return (u16*)(ws + OFF_VTSB); }
  __device__ __forceinline__ u16* yin() const { return (u16*)(ws + OFF_YIN); }
  __device__ __forceinline__ u16* mk() const { return (u16*)(ws + OFF_MK); }
  __device__ __forceinline__ u16* mvt() const { return (u16*)(ws + OFF_MVT); }
  __device__ __forceinline__ float* cosT() const { return (float*)(ws + OFF_COST); }
  __device__ __forceinline__ float* sinT() const { return (float*)(ws + OFF_SINT); }
  __device__ __forceinline__ float* part() const { return (float*)(ws + OFF_PART); }
  __device__ __forceinline__ float* lnstat() const { return (float*)(ws + OFF_LNSTAT); }
  __device__ __forceinline__ unsigned long long* lnx() const { return (unsigned long long*)(ws + OFF_LNX); }
};

__device__ __forceinline__ unsigned pack2(float a, float b) {
  f32x2_t v = {a, b};
  bf16x2_t r = __builtin_convertvector(v, bf16x2_t);
  return *(unsigned*)&r;
}
__device__ __forceinline__ u16 f2bf(float a) { return (u16)(pack2(a, 0.f) & 0xffffu); }
__device__ __forceinline__ float bflo(unsigned w) { return __uint_as_float(w << 16); }
__device__ __forceinline__ float bfhi(unsigned w) { return __uint_as_float(w & 0xffff0000u); }
__device__ __forceinline__ float bf2f(u16 h) { return __uint_as_float(((unsigned)h) << 16); }
__device__ __forceinline__ float silu_f(float x) { return x * __builtin_amdgcn_rcpf(1.f + __expf(-x)); }
__device__ __forceinline__ float gelu_f(float x) {
  float u = 0.7978845608028654f * (x + 0.044715f * x * x * x);
  float t = 1.f - 2.f * __builtin_amdgcn_rcpf(__expf(2.f * u) + 1.f);
  return 0.5f * x * (1.f + t);
}
__device__ __forceinline__ f32x4 mfma16(bf16x8 a, bf16x8 b, f32x4 c) {
  return __builtin_amdgcn_mfma_f32_16x16x32_bf16(a, b, c, 0, 0, 0);
}
__device__ __forceinline__ int vperm(int s) { return (s & 32) | (((s >> 2) & 3) << 3) | (((s >> 4) & 1) << 2) | (s & 3); }
__device__ __forceinline__ float xmax16(float v) { auto r = __builtin_amdgcn_permlane16_swap(__float_as_uint(v), __float_as_uint(v), false, false); return fmaxf(__uint_as_float(r[0]), __uint_as_float(r[1])); }
__device__ __forceinline__ float xmax32(float v) { auto r = __builtin_amdgcn_permlane32_swap(__float_as_uint(v), __float_as_uint(v), false, false); return fmaxf(__uint_as_float(r[0]), __uint_as_float(r[1])); }
__device__ __forceinline__ float xsum16(float v) { auto r = __builtin_amdgcn_permlane16_swap(__float_as_uint(v), __float_as_uint(v), false, false); return __uint_as_float(r[0]) + __uint_as_float(r[1]); }
__device__ __forceinline__ float xsum32(float v) { auto r = __builtin_amdgcn_permlane32_swap(__float_as_uint(v), __float_as_uint(v), false, false); return __uint_as_float(r[0]) + __uint_as_float(r[1]); }
__device__ __forceinline__ float shx(float v, int lane, int m) { return __uint_as_float(__builtin_amdgcn_ds_bpermute((lane ^ m) << 2, __float_as_uint(v))); }
__device__ __forceinline__ int tid_of(int wv) {
  int lane;
  asm volatile("v_mbcnt_lo_u32_b32 %0, -1, 0\n\tv_mbcnt_hi_u32_b32 %0, -1, %0" : "=v"(lane));
  return wv * 64 + lane;
}

#define XB_TMO      128
#define XB_XCNT(j)  (256  + 64 * (j))
#define XB_XSUB(j)  (1280 + 64 * (j))
#define XB_XGEN(j)  (2304 + 64 * (j))
#define XB_TOP      3328
#define XB_TOPGEN   3392
#define XCD_BAR_WORDS 3456
#define XB_SPIN_CAP (1u << 22)
#define LAS __attribute__((address_space(3)))
__device__ __forceinline__ unsigned xb_ld(unsigned* p) { return __hip_atomic_load(p, __ATOMIC_RELAXED, __HIP_MEMORY_SCOPE_AGENT); }
__device__ __forceinline__ unsigned xb_add(unsigned* p, unsigned v) { return __hip_atomic_fetch_add(p, v, __ATOMIC_RELAXED, __HIP_MEMORY_SCOPE_AGENT); }
__device__ __forceinline__ unsigned xb_xcc_id() { return (unsigned)__builtin_amdgcn_s_getreg((3 << 11) | 20) & 0xFu; }
#define XB_SPIN(cond, bar) do { unsigned _sp = 0; while (cond) { __builtin_amdgcn_s_sleep(1); \
    if ((++_sp & 255u) == 0u) { if (xb_ld(&(bar)[XB_TMO])) break; if (_sp > XB_SPIN_CAP) { atomicAdd(&(bar)[XB_TMO], 1u); break; } } } } while (0)
struct XcdBarrier { unsigned* bar; unsigned x; volatile LAS unsigned* st; };
__device__ __forceinline__ XcdBarrier xcd_barrier_post(unsigned* bar, volatile LAS unsigned* st, int wv) {
  XcdBarrier b; b.bar = bar; b.x = xb_xcc_id(); b.st = st;
  if (tid_of(wv) == 0) (void)xb_add(&bar[XB_XCNT(b.x)], 1u);
  return b;
}
__device__ __forceinline__ void xcd_barrier_complete(unsigned* bar, unsigned x, unsigned& nloc, unsigned& nx) {
  const unsigned G = gridDim.x * gridDim.y * gridDim.z;
  unsigned sum, cnt, mine, sp = 0u;
  for (;;) {
    sum = 0u; cnt = 0u; mine = 0u;
#pragma unroll
    for (unsigned j = 0; j < 16; ++j) { const unsigned c = xb_ld(&bar[XB_XCNT(j)]); sum += c; cnt += (c > 0u) ? 1u : 0u; mine = (j == x) ? c : mine; }
    if (sum == G) break;
    __builtin_amdgcn_s_sleep(1);
    if ((++sp & 255u) == 0u) { if (xb_ld(&bar[XB_TMO])) break; if (sp > XB_SPIN_CAP) { atomicAdd(&bar[XB_TMO], 1u); break; } }
  }
  nloc = mine > 0u ? mine : 1u; nx = cnt > 0u ? cnt : 1u;
}
__device__ __forceinline__ void xcd_barrier(const XcdBarrier& b, int wv) {
  asm volatile("s_waitcnt vmcnt(0)" ::: "memory");
  __syncthreads();
  if (tid_of(wv) == 0) {
    unsigned* bar = b.bar;
    __builtin_amdgcn_s_waitcnt(0);
    unsigned nloc = b.st[0], nx = b.st[1];
    if (nloc == 0u) { xcd_barrier_complete(bar, b.x, nloc, nx); b.st[0] = nloc; b.st[1] = nx; }
    const unsigned old = xb_add(&bar[XB_XSUB(b.x)], 1u);
    const unsigned gen = old / nloc;
    if (old + 1u == (gen + 1u) * nloc) {
      __builtin_amdgcn_fence(__ATOMIC_RELEASE, "agent");
      asm volatile("s_waitcnt vmcnt(0)" ::: "memory");
      const unsigned og = xb_add(&bar[XB_TOP], 1u);
      const unsigned tg = og / nx;
      if (og + 1u == (tg + 1u) * nx) xb_add(&bar[XB_TOPGEN], 1u);
      else XB_SPIN(xb_ld(&bar[XB_TOPGEN]) == tg, bar);
      __builtin_amdgcn_fence(__ATOMIC_ACQUIRE, "agent");
      xb_add(&bar[XB_XGEN(b.x)], 1u);
      asm volatile("s_waitcnt vmcnt(0)" ::: "memory");
    } else {
      XB_SPIN(xb_ld(&bar[XB_XGEN(b.x)]) == gen, bar);
      __builtin_amdgcn_fence(__ATOMIC_ACQUIRE, "agent");
      asm volatile("s_waitcnt vmcnt(0)" ::: "memory");
    }
  }
  __syncthreads();
}

__device__ __forceinline__ int perm64(int g) { return ((g >> 4) & 1) * 32 + (g >> 5) * 16 + (g & 15); }

__device__ void tconv_all(const float* src, u16* dst, int K, int N, int Npad, size_t srcLS, size_t dstLS, int dstRowOff,
                          const float* g, int gS, int permMode, float* lds0, int wv) {
  const int tid = tid_of(wv);
  const int half = tid >> 8, ht = tid & 255;
  float* lds = lds0 + half * (2 * 64 * 65);
  const int nkt = K / 64, nnt = Npad / 64, per = nkt * nnt, total = NL * per;
  for (int t0 = blockIdx.x * 4; t0 < total; t0 += gridDim.x * 4) {
    float4 v[2][4];
    bool ok[2];
    int n0s[2], k0s[2], ls[2];
#pragma unroll
    for (int j = 0; j < 2; ++j) {
      const int t = t0 + half * 2 + j;
      ok[j] = t < total;
      const int l = t / per, r = t % per, kt = r / nnt, nt = r % nnt;
      ls[j] = l; k0s[j] = kt * 64; n0s[j] = nt * 64;
      const float* sp = src + (size_t)l * srcLS;
#pragma unroll
      for (int i = 0; i < 4; ++i) {
        const int rr = (ht >> 4) + 16 * i, c = (ht & 15) * 4;
        v[j][i] = make_float4(0.f, 0.f, 0.f, 0.f);
        if (ok[j] && n0s[j] + c < N) {
          const f32x4 w4 = __builtin_nontemporal_load((const f32x4*)(sp + (size_t)(k0s[j] + rr) * N + n0s[j] + c));
          v[j][i] = make_float4(w4[0], w4[1], w4[2], w4[3]);
        }
      }
    }
#pragma unroll
    for (int j = 0; j < 2; ++j) {
      const float* gp = g ? g + (size_t)ls[j] * gS : nullptr;
#pragma unroll
      for (int i = 0; i < 4; ++i) {
        const int rr = (ht >> 4) + 16 * i, c = (ht & 15) * 4;
        float4 x = v[j][i];
        if (gp && ok[j]) { const float sc = gp[k0s[j] + rr]; x.x *= sc; x.y *= sc; x.z *= sc; x.w *= sc; }
        float* pp = lds + j * (64 * 65) + rr * 65 + c;
        pp[0] = x.x; pp[1] = x.y; pp[2] = x.z; pp[3] = x.w;
      }
    }
    __syncthreads();
#pragma unroll
    for (int j = 0; j < 2; ++j) {
      if (ok[j]) {
        const int n0 = n0s[j], k0 = k0s[j];
        u16* dp = dst + (size_t)ls[j] * dstLS + (size_t)dstRowOff * K;
        const float* lj = lds + j * (64 * 65);
        const bool perm = (permMode == 1) ? (n0 == C_KPE) : (permMode == 2) ? ((n0 % 192) == 128 && n0 < 1152) : false;
#pragma unroll
        for (int i = 0; i < 2; ++i) {
          const int id = ht + 256 * i, n = id >> 3, kc = (id & 7) * 8;
          const int ns = perm ? perm64(n) : n;
          unsigned w0 = pack2(lj[(kc + 0) * 65 + ns], lj[(kc + 1) * 65 + ns]);
          unsigned w1 = pack2(lj[(kc + 2) * 65 + ns], lj[(kc + 3) * 65 + ns]);
          unsigned w2 = pack2(lj[(kc + 4) * 65 + ns], lj[(kc + 5) * 65 + ns]);
          unsigned w3 = pack2(lj[(kc + 6) * 65 + ns], lj[(kc + 7) * 65 + ns]);
          *(uint4*)(dp + (size_t)(n0 + n) * K + k0 + kc) = make_uint4(w0, w1, w2, w3);
        }
      }
    }
    __syncthreads();
  }
}

__device__ void phase_prep(const Params& p, char* smem, int wv) {
  float* lds = (float*)smem;
  const int tid = tid_of(wv);
  const size_t gtid = (size_t)blockIdx.x * NT + tid, gsz = (size_t)gridDim.x * NT;
  if (blockIdx.x == 0) { p.ctr()[tid] = (tid < 8) ? gridDim.x : 0u; p.ctr()[tid + NT] = 0u; p.ctr()[tid + 2 * NT] = 0u; p.ctr()[tid + 3 * NT] = 0u; }
  for (size_t c = gtid; c < (size_t)2 * SEQ; c += gsz) p.ssq()[c] = 0.f;
  for (size_t c = gtid; c < (size_t)SEQ * DM / 8; c += gsz) {
    float4 a = *(const float4*)(p.x + c * 8), b = *(const float4*)(p.x + c * 8 + 4);
    *(uint4*)(p.xb() + c * 8) = make_uint4(pack2(a.x, a.y), pack2(a.z, a.w), pack2(b.x, b.y), pack2(b.z, b.w));
  }
  for (size_t c = gtid; c < (size_t)256 * DM / 8; c += gsz) {
    float4 a = *(const float4*)(p.mem + c * 8), b = *(const float4*)(p.mem + c * 8 + 4);
    *(uint4*)(p.memb() + c * 8) = make_uint4(pack2(a.x, a.y), pack2(a.z, a.w), pack2(b.x, b.y), pack2(b.z, b.w));
  }
  for (size_t e = gtid; e < (size_t)SEQ * 32; e += gsz) {
    int s = (int)(e >> 5), i = (int)(e & 31);
    float invf = __builtin_amdgcn_exp2f(-(float)i * (13.287712379549449f / 32.0f));
    float ang = (float)p.pos[s] * invf;
    double rev = (double)ang * 0.15915494309189535;
    float fr = (float)(rev - floor(rev));
    p.cosT()[e] = __builtin_amdgcn_cosf(fr);
    p.sinT()[e] = __builtin_amdgcn_sinf(fr);
  }
  tconv_all(p.w_in, p.wt_in(), DM, DIN, DINP, (size_t)DM * DIN, (size_t)DINP * DM, 0, nullptr, 0, 1, lds, wv);
  tconv_all(p.w_out, p.wt_out(), DM, DM, DM, (size_t)DM * DM, (size_t)DM * DM, 0, nullptr, 0, 0, lds, wv);
  tconv_all(p.w_uq, p.wt_uq(), 512, 1152, UQP, (size_t)512 * 1152, (size_t)UQP * 512, 0, p.q_norm_g, 512, 2, lds, wv);
  tconv_all(p.w_ukv, p.wt_ukv(), 256, 1536, 1536, (size_t)256 * 1536, (size_t)1536 * 256, 0, p.kv_norm_g, 256, 0, lds, wv);
  tconv_all(p.w_mem_k, p.wt_memkv(), DM, 256, 256, (size_t)DM * 256, (size_t)512 * DM, 0, nullptr, 0, 0, lds, wv);
  tconv_all(p.w_mem_v, p.wt_memkv(), DM, 256, 256, (size_t)DM * 256, (size_t)512 * DM, 256, nullptr, 0, 0, lds, wv);
}

namespace pg8 {
constexpr int BM = 256, BK = 64, HALF = 128, HTB = HALF * BK * 2, NXCD = 8, WGM = 8;
__device__ __forceinline__ int lds_byte(int r, int c) { const int st = (r >> 4) * 2 + (c >> 5), rr = r & 15, cc = c & 31, ob = rr * 64 + cc * 2; return st * 1024 + (ob ^ (((ob >> 9) & 1) << 5)); }
__device__ __forceinline__ void stage_rc(int b, int& R, int& C) { const int st = b / 1024, sb = b % 1024, swz = sb ^ (((sb >> 9) & 1) << 5); R = (st >> 1) * 16 + swz / 64; C = (st & 1) * 32 + (swz % 64) / 2; }
struct Unit { int pm, pn; };
struct Gemm { const u16* A; const u16* Bt; int lda, ldb, K; };
struct StaticOrder {
  int nM, nN, nwg, G, c;
  __device__ void init(int M, int N, int G_, int c_) { nM = M / BM; nN = N / BM; nwg = nM * nN; G = G_; c = c_; }
  __device__ bool next(int i, Unit& u) const {
    const long L = (long)i * G + c; if (L >= nwg) return false;
    int wgid = (int)L; { const int q = nwg / NXCD, r = nwg % NXCD, xcd = wgid % NXCD, off = wgid / NXCD; wgid = (xcd < r ? xcd * (q + 1) : r * (q + 1) + (xcd - r) * q) + off; }
    const int nig = WGM * nN, gid = wgid / nig, fm = gid * WGM, gsz = (nM - fm) < WGM ? (nM - fm) : WGM;
    u.pm = __builtin_amdgcn_readfirstlane(fm + ((wgid % nig) % gsz)); u.pn = __builtin_amdgcn_readfirstlane((wgid % nig) / gsz); return true;
  }
};
struct StrideOrder {
  int first, stride, count, limit;
  __device__ bool next(int i, Unit& u) const { const int x = first + i * stride; if (i >= count || x >= limit) return false; u.pm = x & 31; u.pn = x >> 5; return true; }
};

template <class Epi, class Sched>
__device__ __forceinline__ void gemm_phase(LAS unsigned char* lds, const Gemm g, const Sched& S, const Epi& E, int wv) {
  const int tid = tid_of(wv);
  const int wid = wv, lane = tid & 63, wr = wid >> 2, wc = wid & 3, fr = lane & 15, fq = lane >> 4;
  const int K = g.K, nt = K / BK;
  unsigned voffA[2], voffB[2];
#pragma unroll
  for (int i = 0; i < 2; ++i) { int R, C; stage_rc(tid * 16 + i * 8192, R, C);
    voffA[i] = (unsigned)(R * g.lda + C) * 2u; voffB[i] = (unsigned)(R * g.ldb + C) * 2u; }
  const size_t kstep = (size_t)(BK * 2);
  const size_t hstepA = (size_t)HALF * g.lda * 2, hstepB = (size_t)HALF * g.ldb * 2;
  const size_t tstepA = 2 * hstepA, tstepB = 2 * hstepB;
  const unsigned ldsw = (unsigned)wid * 1024u;
  const int aoff = lds_byte(wr * 64 + fr, fq * 8), boff = lds_byte(wc * 32 + fr, fq * 8);
#define PG8_SA(b, h) (((b) * 2 + (h)) * HTB)
#define PG8_SB(b, h) ((4 + (b) * 2 + (h)) * HTB)
#define PG8_STAGE(bufoff, gbase, voff) do { _Pragma("unroll") for (int _i = 0; _i < 2; ++_i) \
    __builtin_amdgcn_global_load_lds((const unsigned*)((const char*)(gbase) + (voff)[_i]), (LAS unsigned*)(lds + (bufoff) + ldsw + _i * 8192), 16, 0, 0); } while (0)
#define PG8_LDA(dst, b, h) do { _Pragma("unroll") for (int m = 0; m < 4; ++m) _Pragma("unroll") for (int k = 0; k < 2; ++k) dst[m][k] = *(const LAS bf16x8*)(lds + PG8_SA(b, h) + aoff + m * 2048 + k * 1024); } while (0)
#define PG8_LDB(dst, b, h) do { _Pragma("unroll") for (int n = 0; n < 2; ++n) _Pragma("unroll") for (int k = 0; k < 2; ++k) dst[n][k] = *(const LAS bf16x8*)(lds + PG8_SB(b, h) + boff + n * 2048 + k * 1024); } while (0)
#define PG8_MMA(ai, bj, At, Bt) do { __builtin_amdgcn_s_setprio(1); _Pragma("unroll") for (int m = 0; m < 4; ++m) _Pragma("unroll") for (int n = 0; n < 2; ++n) _Pragma("unroll") for (int k = 0; k < 2; ++k) \
    acc[ai][bj][m][n] = __builtin_amdgcn_mfma_f32_16x16x32_bf16(Bt[n][k], At[m][k], acc[ai][bj][m][n], 0, 0, 0); __builtin_amdgcn_s_setprio(0); } while (0)
#define PG8_WAIT_V(n) asm volatile("s_waitcnt vmcnt(" #n ")" ::: "memory")
#define PG8_WAIT_L(n) asm volatile("s_waitcnt lgkmcnt(" #n ")" ::: "memory")
#define PG8_BAR __builtin_amdgcn_s_barrier()
#define PG8_SCHED __builtin_amdgcn_sched_barrier(0)
  Unit cur, nxt; int ui = 0;
  if (!S.next(0, cur)) return;
  f32x4 acc[2][2][4][2];
#pragma unroll
  for (int a = 0; a < 2; ++a)
#pragma unroll
    for (int b = 0; b < 2; ++b)
#pragma unroll
      for (int m = 0; m < 4; ++m)
#pragma unroll
        for (int n = 0; n < 2; ++n) acc[a][b][m][n] = (f32x4){0.f, 0.f, 0.f, 0.f};
  bf16x8 At[4][2], B0[2][2], B1[2][2];
  const char* cA = (const char*)g.A + (size_t)cur.pm * tstepA; const char* cB = (const char*)g.Bt + (size_t)cur.pn * tstepB;
  PG8_STAGE(PG8_SB(0, 0), cB, voffB); PG8_STAGE(PG8_SA(0, 0), cA, voffA); PG8_STAGE(PG8_SB(0, 1), cB + hstepB, voffB); PG8_STAGE(PG8_SA(0, 1), cA + hstepA, voffA);
  if (wr == 1) PG8_BAR;
  PG8_WAIT_V(4); PG8_BAR;
  PG8_STAGE(PG8_SB(1, 0), cB + kstep, voffB); PG8_STAGE(PG8_SA(1, 0), cA + kstep, voffA); PG8_STAGE(PG8_SB(1, 1), cB + hstepB + kstep, voffB);
  PG8_WAIT_V(6); PG8_BAR;
  for (;;) {
    const bool has_next = S.next(ui + 1, nxt);
    const char* nA = has_next ? (const char*)g.A + (size_t)nxt.pm * tstepA : cA; const char* nB = has_next ? (const char*)g.Bt + (size_t)nxt.pn * tstepB : cB;
    for (int t = 0; t < nt; t += 2) {
      const bool last = (t == nt - 2);
      const char* a1 = cA + (size_t)(t + 1) * kstep;
      const char* a2 = last ? nA : cA + (size_t)(t + 2) * kstep; const char* b2 = last ? nB : cB + (size_t)(t + 2) * kstep;
      const char* a3 = a2 + kstep; const char* b3 = b2 + kstep;
      PG8_LDB(B0, 0, 0); PG8_SCHED; PG8_LDA(At, 0, 0); PG8_STAGE(PG8_SA(1, 1), a1 + hstepA, voffA);
      PG8_WAIT_L(8); PG8_BAR; PG8_WAIT_L(0); PG8_MMA(0, 0, At, B0); PG8_BAR; PG8_SCHED;
      PG8_LDB(B1, 0, 1); PG8_STAGE(PG8_SB(0, 0), b2, voffB);
      PG8_BAR; PG8_WAIT_L(0); PG8_MMA(0, 1, At, B1); PG8_BAR;
      PG8_LDA(At, 0, 1); PG8_STAGE(PG8_SA(0, 0), a2, voffA);
      PG8_BAR; PG8_WAIT_L(0); PG8_MMA(1, 0, At, B0); PG8_BAR; PG8_SCHED;
      PG8_STAGE(PG8_SB(0, 1), b2 + hstepB, voffB);
      PG8_WAIT_V(6); PG8_BAR; PG8_MMA(1, 1, At, B1); PG8_BAR;
      PG8_LDB(B0, 1, 0); PG8_SCHED; PG8_LDA(At, 1, 0); PG8_STAGE(PG8_SA(0, 1), a2 + hstepA, voffA);
      PG8_WAIT_L(8); PG8_BAR; PG8_WAIT_L(0); PG8_MMA(0, 0, At, B0); PG8_BAR; PG8_SCHED;
      PG8_LDB(B1, 1, 1); PG8_STAGE(PG8_SB(1, 0), b3, voffB);
      PG8_BAR; PG8_WAIT_L(0); PG8_MMA(0, 1, At, B1); PG8_BAR;
      PG8_LDA(At, 1, 1); PG8_STAGE(PG8_SA(1, 0), a3, voffA);
      PG8_BAR; PG8_WAIT_L(0); PG8_MMA(1, 0, At, B0); PG8_BAR; PG8_SCHED;
      PG8_STAGE(PG8_SB(1, 1), b3 + hstepB, voffB);
      PG8_WAIT_V(6); PG8_BAR; PG8_MMA(1, 1, At, B1); PG8_BAR;
    }
    if constexpr (!Epi::AFTER_DRAIN) E(acc, cur, wr, wc, fr, fq);
    if (!has_next) break;
#pragma unroll
    for (int a = 0; a < 2; ++a)
#pragma unroll
      for (int b = 0; b < 2; ++b)
#pragma unroll
        for (int m = 0; m < 4; ++m)
#pragma unroll
          for (int n = 0; n < 2; ++n) acc[a][b][m][n] = (f32x4){0.f, 0.f, 0.f, 0.f};
    cur = nxt; cA = nA; cB = nB; ++ui;
  }
  PG8_WAIT_V(0);
  if (wr == 0) PG8_BAR;
  PG8_BAR;
  if constexpr (Epi::AFTER_DRAIN) E.fused(acc, cur, wr, wc);
#undef PG8_SA
#undef PG8_SB
#undef PG8_STAGE
#undef PG8_LDA
#undef PG8_LDB
#undef PG8_MMA
#undef PG8_WAIT_V
#undef PG8_WAIT_L
#undef PG8_BAR
#undef PG8_SCHED
}
}

typedef const f32x4 (&AccRef)[2][2][4][2];

struct EpiA {
  static constexpr bool AFTER_DRAIN = false;
  Params p; int l;
  __device__ __forceinline__ void operator()(AccRef acc, const pg8::Unit& u, int wr, int wc, int fr_, int fq_) const {
    const int lane_ = tid_of(wr * 4 + wc) & 63, fr = lane_ & 15, fq = lane_ >> 4;
    const int rowb = u.pm * 256 + wr * 64 + fr;
#pragma unroll
    for (int bj = 0; bj < 2; ++bj) {
      const int cs = u.pn * 256 + bj * 128 + wc * 32;
      int kind;
      if (cs < C_KPE) kind = 0; else if (cs < C_GA) kind = 3; else if (cs < C_SGU) kind = 1;
      else if (cs < C_GB) kind = 2; else if (cs < C_SBQ) kind = 1; else if (cs < C_SBV) kind = 0;
      else if (cs < C_GC) kind = 4; else if (cs < C_MQ) kind = 1; else if (cs < C_GM) kind = 0;
      else if (cs < DIN) kind = 1; else kind = 5;
      if (kind == 5) continue;
      if (kind <= 2) {
#pragma unroll
        for (int ai = 0; ai < 2; ++ai)
#pragma unroll
          for (int m = 0; m < 4; ++m) {
            const int row = rowb + ai * 128 + m * 16;
#pragma unroll
            for (int n = 0; n < 2; ++n) {
              f32x4 v = acc[ai][bj][m][n];
              if (kind == 1) { v[0] = silu_f(v[0]); v[1] = silu_f(v[1]); v[2] = silu_f(v[2]); v[3] = silu_f(v[3]); }
              else if (kind == 2) { v[0] = gelu_f(v[0]); v[1] = gelu_f(v[1]); v[2] = gelu_f(v[2]); v[3] = gelu_f(v[3]); }
              *(uint2*)(p.h() + (size_t)row * DIN + cs + n * 16 + fq * 4) = make_uint2(pack2(v[0], v[1]), pack2(v[2], v[3]));
            }
          }
      } else if (kind == 3) {
        const int i0 = ((cs >> 5) & 1) * 16 + fq * 4;
#pragma unroll
        for (int ai = 0; ai < 2; ++ai)
#pragma unroll
          for (int m = 0; m < 4; ++m) {
            const int row = rowb + ai * 128 + m * 16;
            float4 cs4 = *(const float4*)(p.cosT() + (size_t)row * 32 + i0);
            float4 sn = *(const float4*)(p.sinT() + (size_t)row * 32 + i0);
            f32x4 x1 = acc[ai][bj][m][0], x2 = acc[ai][bj][m][1];
            float a0 = x1[0] * cs4.x - x2[0] * sn.x, a1 = x1[1] * cs4.y - x2[1] * sn.y, a2 = x1[2] * cs4.z - x2[2] * sn.z, a3 = x1[3] * cs4.w - x2[3] * sn.w;
            float b0 = x1[0] * sn.x + x2[0] * cs4.x, b1 = x1[1] * sn.y + x2[1] * cs4.y, b2 = x1[2] * sn.z + x2[2] * cs4.z, b3 = x1[3] * sn.w + x2[3] * cs4.w;
            uint2 ua = make_uint2(pack2(a0, a1), pack2(a2, a3)), ub = make_uint2(pack2(b0, b1), pack2(b2, b3));
#pragma unroll
            for (int hd = 0; hd < 6; ++hd) {
              u16* kp = p.k() + ((size_t)hd * SEQ + row) * 192 + 128 + i0;
              *(uint2*)kp = ua;
              *(uint2*)(kp + 32) = ub;
            }
          }
      } else {
#pragma unroll
        for (int ai = 0; ai < 2; ++ai)
#pragma unroll
          for (int m = 0; m < 4; ++m) {
            const int row = rowb + ai * 128 + m * 16;
#pragma unroll
            for (int n = 0; n < 2; ++n) {
              const int c = cs - C_SBV + n * 16 + fq * 4;
#pragma unroll
              for (int j = 0; j < 4; ++j) (p.vtsb() + (size_t)(c >> 7) * 128 * SEQ)[(unsigned)((row >> 6) * 8192 + vperm(row & 63) + ((c & 127) + j) * 64)] = f2bf(acc[ai][bj][m][n][j]);
            }
          }
      }
    }
    if (u.pn < 3) {
      float* sq = p.ssq() + (u.pn == 2 ? SEQ : 0);
#pragma unroll
      for (int ai = 0; ai < 2; ++ai)
#pragma unroll
        for (int m = 0; m < 4; ++m) {
          float v = 0.f;
#pragma unroll
          for (int bj = 0; bj < 2; ++bj)
#pragma unroll
            for (int n = 0; n < 2; ++n)
#pragma unroll
              for (int j = 0; j < 4; ++j) { float a = acc[ai][bj][m][n][j]; v += a * a; }
          v = xsum16(v);
          v = xsum32(v);
          if (fq == 0) atomicAdd(sq + rowb + ai * 128 + m * 16, v);
        }
    }
  }
};

struct EpiMem {
  static constexpr bool AFTER_DRAIN = false;
  Params p;
  __device__ __forceinline__ void operator()(AccRef acc, const pg8::Unit& u, int wr, int wc, int fr_, int fq_) const {
    const int lane_ = tid_of(wr * 4 + wc) & 63, fr = lane_ & 15, fq = lane_ >> 4;
    const int l = u.pn >> 1, isv = u.pn & 1;
    const int rowb = wr * 64 + fr;
#pragma unroll
    for (int bj = 0; bj < 2; ++bj)
#pragma unroll
      for (int ai = 0; ai < 2; ++ai)
#pragma unroll
        for (int m = 0; m < 4; ++m) {
          const int row = rowb + ai * 128 + m * 16;
#pragma unroll
          for (int n = 0; n < 2; ++n) {
            const int c = bj * 128 + wc * 32 + n * 16 + fq * 4, hd = c >> 6, e = c & 63;
            if (!isv) {
              *(uint2*)(p.mk() + ((size_t)(l * 4 + hd) * 256 + row) * 64 + e) =
                  make_uint2(pack2(acc[ai][bj][m][n][0], acc[ai][bj][m][n][1]), pack2(acc[ai][bj][m][n][2], acc[ai][bj][m][n][3]));
            } else {
#pragma unroll
              for (int j = 0; j < 4; ++j) p.mvt()[(unsigned)((((l * 4 + hd) * 4 + (row >> 6)) * 64 + e + j) * 64 + vperm(row & 63))] = f2bf(acc[ai][bj][m][n][j]);
            }
          }
        }
  }
};

struct EpiQ {
  static constexpr bool AFTER_DRAIN = false;
  Params p;
  __device__ __forceinline__ void operator()(AccRef acc, const pg8::Unit& u, int wr, int wc, int fr_, int fq_) const {
    const int lane_ = tid_of(wr * 4 + wc) & 63, fr = lane_ & 15, fq = lane_ >> 4;
    const float qs = 0.07216878364870322f * 1.4426950408889634f;
    const int rowb = u.pm * 256 + wr * 64 + fr;
#pragma unroll
    for (int ai = 0; ai < 2; ++ai)
#pragma unroll
      for (int m = 0; m < 4; ++m) {
        const int row = rowb + ai * 128 + m * 16;
        const float rs = rsqrtf(p.ssq()[row] * (1.f / 512.f) + 1e-6f) * qs;
#pragma unroll
        for (int bj = 0; bj < 2; ++bj) {
          const int cs = u.pn * 256 + bj * 128 + wc * 32;
          if (cs >= 1152) continue;
          const int hd = cs / 192, o = cs % 192;
          u16* qp = p.q() + ((size_t)hd * SEQ + row) * 192;
          if (o < 128) {
#pragma unroll
            for (int n = 0; n < 2; ++n) {
              f32x4 v = acc[ai][bj][m][n] * rs;
              *(uint2*)(qp + o + n * 16 + fq * 4) = make_uint2(pack2(v[0], v[1]), pack2(v[2], v[3]));
            }
          } else {
            const int i0 = ((cs >> 5) & 1) * 16 + fq * 4;
            float4 cs4 = *(const float4*)(p.cosT() + (size_t)row * 32 + i0);
            float4 sn = *(const float4*)(p.sinT() + (size_t)row * 32 + i0);
            f32x4 x1 = acc[ai][bj][m][0] * rs, x2 = acc[ai][bj][m][1] * rs;
            float a0 = x1[0] * cs4.x - x2[0] * sn.x, a1 = x1[1] * cs4.y - x2[1] * sn.y, a2 = x1[2] * cs4.z - x2[2] * sn.z, a3 = x1[3] * cs4.w - x2[3] * sn.w;
            float b0 = x1[0] * sn.x + x2[0] * cs4.x, b1 = x1[1] * sn.y + x2[1] * cs4.y, b2 = x1[2] * sn.z + x2[2] * cs4.z, b3 = x1[3] * sn.w + x2[3] * cs4.w;
            *(uint2*)(qp + 128 + i0) = make_uint2(pack2(a0, a1), pack2(a2, a3));
            *(uint2*)(qp + 160 + i0) = make_uint2(pack2(b0, b1), pack2(b2, b3));
          }
        }
      }
  }
};

struct EpiKV {
  static constexpr bool AFTER_DRAIN = false;
  Params p;
  __device__ __forceinline__ void operator()(AccRef acc, const pg8::Unit& u, int wr, int wc, int fr_, int fq_) const {
    const int lane_ = tid_of(wr * 4 + wc) & 63, fr = lane_ & 15, fq = lane_ >> 4;
    const int rowb = u.pm * 256 + wr * 64 + fr, hd = u.pn;
#pragma unroll
    for (int ai = 0; ai < 2; ++ai)
#pragma unroll
      for (int m = 0; m < 4; ++m) {
        const int row = rowb + ai * 128 + m * 16;
        const float rs = rsqrtf(p.ssq()[SEQ + row] * (1.f / 256.f) + 1e-6f);
        u16* kp = p.k() + ((size_t)hd * SEQ + row) * 192 + wc * 32;
#pragma unroll
        for (int n = 0; n < 2; ++n) {
          f32x4 v = acc[ai][0][m][n] * rs;
          *(uint2*)(kp + n * 16 + fq * 4) = make_uint2(pack2(v[0], v[1]), pack2(v[2], v[3]));
        }
#pragma unroll
        for (int n = 0; n < 2; ++n)
#pragma unroll
          for (int j = 0; j < 4; ++j)
            (p.vt() + (size_t)hd * 128 * SEQ)[(unsigned)((row >> 6) * 8192 + vperm(row & 63) + (wc * 32 + n * 16 + fq * 4 + j) * 64)] = f2bf(acc[ai][1][m][n][j] * rs);
      }
  }
};

struct EpiD {
  static constexpr bool AFTER_DRAIN = false;
  Params p; int l;
  __device__ __forceinline__ void operator()(AccRef acc, const pg8::Unit& u, int wr, int wc, int fr_, int fq_) const {
    const int lane_ = tid_of(wr * 4 + wc) & 63, fr = lane_ & 15, fq = lane_ >> 4;
    const float alpha = 1.681792830507429f;
    const float* xres = (l == 0) ? p.x : p.out;
    const int rowb = u.pm * 256 + wr * 64 + fr;
#pragma unroll
    for (int ai = 0; ai < 2; ++ai)
#pragma unroll
      for (int m = 0; m < 4; ++m) {
        const int row = rowb + ai * 128 + m * 16;
#pragma unroll
        for (int bj = 0; bj < 2; ++bj)
#pragma unroll
          for (int n = 0; n < 2; ++n) {
            const size_t off = (size_t)row * DM + u.pn * 256 + bj * 128 + wc * 32 + n * 16 + fq * 4;
            float4 xr = *(const float4*)(xres + off);
            f32x4 a = acc[ai][bj][m][n];
            *(float4*)(p.out + off) = make_float4(alpha * xr.x + a[0], alpha * xr.y + a[1], alpha * xr.z + a[2], alpha * xr.w + a[3]);
          }
      }
  }
};

struct EpiDF {
  static constexpr bool PERM = false, AFTER_DRAIN = true;
  Params p; int l; char* sm;
  __device__ __forceinline__ void operator()(AccRef, const pg8::Unit&, int, int, int, int) const {}
  __device__ __forceinline__ void fused(f32x4 (&z)[2][2][4][2], const pg8::Unit& u, int wr, int wc) const {
    typedef unsigned long long u64;
    const int wv = wr * 4 + wc, tid = tid_of(wv), lane = tid & 63, fr = lane & 15, fq = lane >> 4;
    const float alpha = 1.681792830507429f;
    const float* xres = (l == 0) ? p.x : p.out;
    float* P = (float*)(sm + GEMM_LDS);
    float* S = P + 2048;
    const int rlb = wr * 64 + fr, colb = u.pn * 256 + wc * 32 + fq * 4;
    for (size_t c = (size_t)blockIdx.x * NT + tid; c < (size_t)2 * SEQ; c += (size_t)gridDim.x * NT) p.ssq()[c] = 0.f;
#pragma unroll
    for (int ai = 0; ai < 2; ++ai) {
      float4 xr[4][2][2];
#pragma unroll
      for (int m = 0; m < 4; ++m)
#pragma unroll
        for (int bj = 0; bj < 2; ++bj)
#pragma unroll
          for (int n = 0; n < 2; ++n)
            xr[m][bj][n] = *(const float4*)(xres + (size_t)(u.pm * 256 + rlb + ai * 128 + m * 16) * DM + colb + bj * 128 + n * 16);
#pragma unroll
      for (int m = 0; m < 4; ++m) {
        float s1 = 0.f, s2 = 0.f;
#pragma unroll
        for (int bj = 0; bj < 2; ++bj)
#pragma unroll
          for (int n = 0; n < 2; ++n) {
            const float4 x4 = xr[m][bj][n];
            f32x4 v = z[ai][bj][m][n];
            v[0] = alpha * x4.x + v[0]; v[1] = alpha * x4.y + v[1]; v[2] = alpha * x4.z + v[2]; v[3] = alpha * x4.w + v[3];
            z[ai][bj][m][n] = v;
            s1 += (v[0] + v[1]) + (v[2] + v[3]);
            s2 += (v[0] * v[0] + v[1] * v[1]) + (v[2] * v[2] + v[3] * v[3]);
          }
        s1 = xsum32(xsum16(s1)); s2 = xsum32(xsum16(s2));
        if (fq == 0) { float* pp = P + ((rlb + ai * 128 + m * 16) * 4 + wc) * 2; pp[0] = s1; pp[1] = s2; }
      }
    }
    __syncthreads();
    u64* X = p.lnx() + (size_t)(u.pm * 8) * 256;
    if (tid < 256) {
      const float4 a = *(const float4*)(P + tid * 8), b = *(const float4*)(P + tid * 8 + 4);
      const float s1 = (a.x + a.z) + (b.x + b.z), s2 = (a.y + a.w) + (b.y + b.w);
      __hip_atomic_store(X + u.pn * 256 + tid, ((u64)__float_as_uint(s2) << 32) | __float_as_uint(s1), __ATOMIC_RELAXED, __HIP_MEMORY_SCOPE_AGENT);
    }
    asm volatile("s_waitcnt vmcnt(0)" ::: "memory");
    __syncthreads();
    if (tid == 0) {
      unsigned* cnt = p.ctr() + 1024 + l * 32 + u.pm;
      __hip_atomic_fetch_add(cnt, 1u, __ATOMIC_RELAXED, __HIP_MEMORY_SCOPE_AGENT);
      unsigned sp = 0;
      while (__hip_atomic_load(cnt, __ATOMIC_RELAXED, __HIP_MEMORY_SCOPE_AGENT) < 8u) { __builtin_amdgcn_s_sleep(2); if (++sp > (1u << 24)) break; }
    }
    __syncthreads();
    if (tid < 256) {
      float s1 = 0.f, s2 = 0.f;
#pragma unroll
      for (int j = 0; j < 8; ++j) {
        const u64 w = __hip_atomic_load(X + j * 256 + tid, __ATOMIC_RELAXED, __HIP_MEMORY_SCOPE_AGENT);
        s1 += __uint_as_float((unsigned)w); s2 += __uint_as_float((unsigned)(w >> 32));
      }
      const float mu = s1 * (1.f / DM);
      const float var = fmaxf(s2 * (1.f / DM) - mu * mu, 0.f);
      S[tid * 2] = mu; S[tid * 2 + 1] = rsqrtf(var + 1e-5f);
    }
    __syncthreads();
    const float* lg = p.ln_g + (size_t)l * DM;
    const float* lb = p.ln_b + (size_t)l * DM;
#pragma unroll
    for (int bj = 0; bj < 2; ++bj)
#pragma unroll
      for (int n = 0; n < 2; ++n) {
        const int col = colb + bj * 128 + n * 16;
        const float4 gg = *(const float4*)(lg + col), bb = *(const float4*)(lb + col);
#pragma unroll
        for (int ai = 0; ai < 2; ++ai)
#pragma unroll
          for (int m = 0; m < 4; ++m) {
            const int rl = rlb + ai * 128 + m * 16;
            const float mu = S[rl * 2], rs = S[rl * 2 + 1];
            const f32x4 v = z[ai][bj][m][n];
            const float r0 = (v[0] - mu) * rs * gg.x + bb.x, r1 = (v[1] - mu) * rs * gg.y + bb.y;
            const float r2 = (v[2] - mu) * rs * gg.z + bb.z, r3 = (v[3] - mu) * rs * gg.w + bb.w;
            const size_t off = (size_t)(u.pm * 256 + rl) * DM + col;
            *(float4*)(p.out + off) = make_float4(r0, r1, r2, r3);
            *(uint2*)(p.xb() + off) = make_uint2(pack2(r0, r1), pack2(r2, r3));
          }
      }
  }
};

__device__ void phaseE(const Params& p, int l, int wv) {
  const int tid = tid_of(wv);
  const int lane = tid & 63;
  const int gw = blockIdx.x * (NT / 64) + (tid >> 6), nw = gridDim.x * (NT / 64);
  for (size_t c = (size_t)blockIdx.x * NT + tid; c < (size_t)2 * SEQ; c += (size_t)gridDim.x * NT) p.ssq()[c] = 0.f;
  const float* g = p.ln_g + (size_t)l * DM;
  const float* b = p.ln_b + (size_t)l * DM;
  for (int row = gw; row < SEQ; row += nw) {
    float* zr = p.out + (size_t)row * DM;
    float4 v[8];
    float s = 0.f;
#pragma unroll
    for (int i = 0; i < 8; ++i) { v[i] = *(const float4*)(zr + (i * 64 + lane) * 4); s += v[i].x + v[i].y + v[i].z + v[i].w; }
#pragma unroll
    for (int o = 1; o < 16; o <<= 1) s += shx(s, lane, o);
    s = xsum16(s); s = xsum32(s);
    const float mu = s * (1.f / DM);
    float q = 0.f;
#pragma unroll
    for (int i = 0; i < 8; ++i) {
      v[i].x -= mu; v[i].y -= mu; v[i].z -= mu; v[i].w -= mu;
      q += v[i].x * v[i].x + v[i].y * v[i].y + v[i].z * v[i].z + v[i].w * v[i].w;
    }
#pragma unroll
    for (int o = 1; o < 16; o <<= 1) q += shx(q, lane, o);
    q = xsum16(q); q = xsum32(q);
    const float rstd = rsqrtf(q * (1.f / DM) + 1e-5f);
#pragma unroll
    for (int i = 0; i < 8; ++i) {
      const int c = (i * 64 + lane) * 4;
      float4 gg = *(const float4*)(g + c), bb = *(const float4*)(b + c);
      float4 r = make_float4(v[i].x * rstd * gg.x + bb.x, v[i].y * rstd * gg.y + bb.y, v[i].z * rstd * gg.z + bb.z, v[i].w * rstd * gg.w + bb.w);
      *(float4*)(zr + c) = r;
      *(uint2*)(p.xb() + (size_t)row * DM + c) = make_uint2(pack2(r.x, r.y), pack2(r.z, r.w));
    }
  }
}

template <int DK, int DV, int MODE, int QSN>
__device__ void attn_item(const u16* __restrict__ Qp, int ldq, const u16* __restrict__ Kp, int ldk, const u16* __restrict__ Vt, int ldv,
                          int t_first, int t_last, int t_diag, float zscale, int q0, const u16* __restrict__ gate, u16* __restrict__ outp,
                          char* smem, int wv, int nseg = 1, int seg = 0, float* part = nullptr, unsigned* cnt = nullptr) {
  constexpr int VST = 72, KCH = DK / 8;
  constexpr int NKR = (64 * KCH) / NT, NVR = (DV * 8) / NT, NST = DK / 32, NDS = DV / 16;
  u16* Ks = (u16*)smem;
  u16* Vs = Ks + 64 * DK;
  const int tid = tid_of(wv);
  asm volatile("" : "+s"(t_last));
  const int w = wv, lane = tid & 63, fr = lane & 15, fq = lane >> 4;

  const int fqs = (fq ^ ((fr >> 3) << 1)) * 16;
  constexpr int NSR = NST;
  bf16x8 qf[2][NSR];
  bf16x8* Qr = (bf16x8*)(smem + MLA_QR_OFF) + (w * 4) * 64 + lane;
#pragma unroll
  for (int qs = 0; qs < QSN; ++qs)
#pragma unroll
    for (int st = 0; st < NST; ++st) {
      bf16x8 v = *(const bf16x8*)(Qp + (unsigned)((w * (16 * QSN) + qs * 16 + fr) * ldq + st * 32 + fq * 8));
      if (st < NSR) qf[qs][st < NSR ? st : 0] = v;
      else Qr[(qs * 2 + (st - NSR)) * 64] = v;
    }

  f32x4 o[NDS][2];
#pragma unroll
  for (int ds = 0; ds < NDS; ++ds) { o[ds][0] = f32x4{0.f, 0.f, 0.f, 0.f}; o[ds][1] = f32x4{0.f, 0.f, 0.f, 0.f}; }
  float mrow[2] = {-1e30f, -1e30f};
  float lrow[2] = {0.f, 0.f};

  uint4 kk0, kk1, kk2, kk3, kk4, kk5, vv0, vv1, vv2, vv3;
#define KLOAD(i, T) if constexpr (NKR > i) { const int c_ = tid + NT * i, row_ = c_ / KCH, cc_ = c_ % KCH; kk##i = *(const uint4*)((Kp + (size_t)(T) * 64 * ldk) + (unsigned)(row_ * ldk + cc_ * 8)); }
#define KSTORE(i) if constexpr (NKR > i) { const int c_ = tid + NT * i, row_ = c_ / KCH, cc_ = c_ % KCH; \
    *(uint4*)((char*)Ks + (cc_ >> 2) * 4096 + row_ * 64 + (((cc_ & 3) ^ (((row_ >> 3) & 1) << 1)) * 16)) = kk##i; }
#define VLOAD(i, T) if constexpr (NVR > i) { const int c_ = tid + NT * i, dv_ = c_ >> 3, cc_ = c_ & 7; vv##i = *(const uint4*)((Vt + (size_t)(T) * (DV * 64)) + (unsigned)(dv_ * 64 + cc_ * 8)); }
#define VSTORE(i) if constexpr (NVR > i) { const int c_ = tid + NT * i, dv_ = c_ >> 3, cc_ = c_ & 7; *(uint4*)(Vs + dv_ * VST + cc_ * 8) = vv##i; }
#define load_k(T) do { KLOAD(0, T) KLOAD(1, T) KLOAD(2, T) KLOAD(3, T) KLOAD(4, T) KLOAD(5, T) } while (0)
#define load_v(T) do { VLOAD(0, T) VLOAD(1, T) VLOAD(2, T) VLOAD(3, T) } while (0)
#define store_tile() do { KSTORE(0) KSTORE(1) KSTORE(2) KSTORE(3) KSTORE(4) KSTORE(5) VSTORE(0) VSTORE(1) VSTORE(2) VSTORE(3) } while (0)

#define MLA_ISSUE(T, B) do { char* kb_ = smem + (B) * MLA_STAGE; \
    _Pragma("unroll") for (int i_ = 0; i_ < 3; ++i_) { const int P_ = tid + NT * i_, st_ = P_ >> 8, r_ = (P_ >> 2) & 63, q_ = (P_ & 3) ^ (((r_ >> 3) & 1) << 1); \
      __builtin_amdgcn_global_load_lds((const unsigned*)((Kp + (size_t)(T) * 64 * ldk) + (unsigned)(r_ * ldk + (st_ * 4 + q_) * 8)), (LAS unsigned*)(kb_ + P_ * 16), 16, 0, 0); } \
    _Pragma("unroll") for (int i_ = 0; i_ < 2; ++i_) { const int P_ = tid + NT * i_, dv_ = P_ >> 3, c_ = (P_ & 7) ^ ((dv_ >> 1) & 7); \
      __builtin_amdgcn_global_load_lds((const unsigned*)((Vt + (size_t)(T) * 8192) + (unsigned)(dv_ * 64 + c_ * 8)), (LAS unsigned*)(kb_ + 24576 + P_ * 16), 16, 0, 0); } } while (0)

  volatile int* flg = (volatile int*)(smem + CTL_OFF) + 8;
  if (MODE == 2 && tid == 0) flg[0] = 0;
  int it = 0;
  int t = (MODE == 2) ? t_last : t_first;
  int buf = 0;
  if constexpr (MODE == 0) {
    MLA_ISSUE(t, 0);
    if (t < t_last) MLA_ISSUE(t + 1, 1);
  } else {
    load_k(t);
    load_v(t);
  }
  while (true) {
    const int tn = (MODE == 2) ? t - 1 : t + 1;
    const bool more = (MODE == 2) ? (t > 0) : (t < t_last);
    if constexpr (MODE == 0) {
      if (more) asm volatile("s_waitcnt vmcnt(5)" ::: "memory"); else asm volatile("s_waitcnt vmcnt(0)" ::: "memory");
      __builtin_amdgcn_s_barrier();
      asm volatile("" ::: "memory");
      if (t + 2 <= t_last) MLA_ISSUE(t + 2, buf == 0 ? 2 : buf - 1);
    } else {
      store_tile();
      __syncthreads();
      if (MODE == 2 && tid == 0) flg[(it & 1) ^ 1] = 0;
      if (MODE != 2 && more) { load_k(tn); load_v(tn); }
    }
    const char* Kc = (MODE == 0) ? (const char*)(smem + buf * MLA_STAGE) : (const char*)Ks;
    bool active = true;
    if (MODE == 0) active = (t <= t_diag + (w >> 1));
    if (MODE == 2) active = (t <= t_diag + (w >> 2));
    if (MODE != 2 && active) {
      f32x4 s[4][2];
#pragma unroll
      for (int ks = 0; ks < 4; ++ks) { s[ks][0] = f32x4{0.f, 0.f, 0.f, 0.f}; s[ks][1] = f32x4{0.f, 0.f, 0.f, 0.f}; }
#pragma unroll
      for (int st = 0; st < NST; ++st) {
#pragma unroll
        for (int ks = 0; ks < 4; ++ks) {
          bf16x8 kf = *(const bf16x8*)(Kc + st * 4096 + (ks * 16 + fr) * 64 + fqs);
          if (st < NSR) {
            s[ks][0] = mfma16(kf, qf[0][st < NSR ? st : 0], s[ks][0]);
            s[ks][1] = mfma16(kf, qf[1][st < NSR ? st : 0], s[ks][1]);
          } else {
            s[ks][0] = mfma16(kf, Qr[(st - NSR) * 64], s[ks][0]);
            s[ks][1] = mfma16(kf, Qr[(2 + st - NSR) * 64], s[ks][1]);
          }
        }
      }
      {
#pragma unroll
        for (int qs = 0; qs < 2; ++qs) {
          float mx = -1e30f;
#pragma unroll
          for (int ks = 0; ks < 4; ++ks)
#pragma unroll
            for (int j = 0; j < 4; ++j) mx = fmaxf(mx, s[ks][qs][j]);
          mx *= zscale;
          mx = xmax16(mx);
          mx = xmax32(mx);
          const bool bump = __builtin_amdgcn_ballot_w64(mx > mrow[qs] + 8.0f) != 0ull;
          float ls = 0.f;
          if (bump) {
            const float mn = fmaxf(mrow[qs], mx);
            const float alpha = __builtin_amdgcn_exp2f(mrow[qs] - mn);
            mrow[qs] = mn;
            lrow[qs] *= alpha;
#pragma unroll
            for (int ds = 0; ds < NDS; ++ds) o[ds][qs] *= alpha;
          }
          const float mref = mrow[qs];
#pragma unroll
          for (int ks = 0; ks < 4; ++ks)
#pragma unroll
            for (int j = 0; j < 4; ++j) {
              float pv = __builtin_amdgcn_exp2f(s[ks][qs][j] * zscale - mref);
              ls += pv;
              s[ks][qs][j] = pv;
            }
          lrow[qs] += ls;
        }
      }
      bf16x8 pf[2][2];
#pragma unroll
      for (int qs = 0; qs < 2; ++qs)
#pragma unroll
        for (int u = 0; u < 2; ++u) {
          uint4 pk;
          pk.x = pack2(s[2 * u][qs][0], s[2 * u][qs][1]);
          pk.y = pack2(s[2 * u][qs][2], s[2 * u][qs][3]);
          pk.z = pack2(s[2 * u + 1][qs][0], s[2 * u + 1][qs][1]);
          pk.w = pack2(s[2 * u + 1][qs][2], s[2 * u + 1][qs][3]);
          pf[qs][u] = *(bf16x8*)&pk;
        }
#pragma unroll
      for (int u = 0; u < 2; ++u) {
        bf16x8 vfr[NDS];
#pragma unroll
        for (int ds = 0; ds < NDS; ++ds) {
          if constexpr (MODE == 0) vfr[ds] = *(const bf16x8*)(Kc + 24576 + (ds * 16 + fr) * 128 + (((u * 4 + fq) ^ ((fr >> 1) & 7)) * 16));
          else vfr[ds] = *(const bf16x8*)(Vs + (ds * 16 + fr) * VST + u * 32 + fq * 8);
        }
#pragma unroll
        for (int ds = 0; ds < NDS; ++ds) {
          o[ds][0] = mfma16(vfr[ds], pf[0][u], o[ds][0]);
          o[ds][1] = mfma16(vfr[ds], pf[1][u], o[ds][1]);
        }
      }
    }
    if (MODE == 2 && active) {
#pragma unroll
      for (int qs = 0; qs < QSN; ++qs) {
        f32x4 s1[4];
#pragma unroll
        for (int ks = 0; ks < 4; ++ks) s1[ks] = f32x4{0.f, 0.f, 0.f, 0.f};
#pragma unroll
        for (int st = 0; st < NST; ++st) {
#pragma unroll
          for (int ks = 0; ks < 4; ++ks) {
            bf16x8 kf = *(const bf16x8*)(Kc + st * 4096 + (ks * 16 + fr) * 64 + fqs);
            s1[ks] = mfma16(kf, qf[qs][st], s1[ks]);
          }
        }
        const int tq = q0 + w * (16 * QSN) + qs * 16 + fr;
        float running = lrow[qs];
#pragma unroll
        for (int ks = 3; ks >= 0; --ks) {
          float l1[4], lb[4];
#pragma unroll
          for (int j = 0; j < 4; ++j) {
            const float z = s1[ks][j] * zscale;
            const float e = __expf(-fabsf(z));
            const float sp = fmaxf(z, 0.f) + __logf(1.f + e);
            const int key = t * 64 + ks * 16 + fq * 4 + j;
            l1[j] = (key < tq) ? -sp : 0.f;
            lb[j] = z - sp;
          }
          const float p4 = (l1[0] + l1[1]) + (l1[2] + l1[3]);
          const float x16 = shx(p4, lane, 16);
          const float a2 = p4 + x16;
          const float x32 = shx(a2, lane, 32);
          const float tot = a2 + x32;
          const float gt = ((fq & 1) == 0 ? x16 : 0.f) + ((fq & 2) == 0 ? x32 : 0.f);
          const float s3 = running + gt;
          const float s2 = s3 + l1[3];
          const float s1_ = s2 + l1[2];
          const float s0 = s1_ + l1[1];
          s1[ks][0] = (l1[0] < 0.f) ? __expf(lb[0] + s0) : 0.f;
          s1[ks][1] = (l1[1] < 0.f) ? __expf(lb[1] + s1_) : 0.f;
          s1[ks][2] = (l1[2] < 0.f) ? __expf(lb[2] + s2) : 0.f;
          s1[ks][3] = (l1[3] < 0.f) ? __expf(lb[3] + s3) : 0.f;
          running += tot;
        }
        lrow[qs] = running;
        asm volatile("" ::: "memory");
#pragma unroll
        for (int u = 0; u < 2; ++u) {
          uint4 pk;
          pk.x = pack2(s1[2 * u][0], s1[2 * u][1]);
          pk.y = pack2(s1[2 * u][2], s1[2 * u][3]);
          pk.z = pack2(s1[2 * u + 1][0], s1[2 * u + 1][1]);
          pk.w = pack2(s1[2 * u + 1][2], s1[2 * u + 1][3]);
          bf16x8 pf1 = *(bf16x8*)&pk;
          bf16x8 vfr[NDS];
#pragma unroll
          for (int ds = 0; ds < NDS; ++ds) vfr[ds] = *(const bf16x8*)(Vs + (ds * 16 + fr) * VST + u * 32 + fq * 8);
#pragma unroll
          for (int ds = 0; ds < NDS; ++ds) o[ds][qs] = mfma16(vfr[ds], pf1, o[ds][qs]);
        }
        asm volatile("" ::: "memory");
        __builtin_amdgcn_sched_barrier(0);
      }
    }
    if (MODE == 2) {
      __builtin_amdgcn_sched_barrier(0);
      if (more) { load_k(tn); load_v(tn); }
      const int cont = (more && (lrow[0] >= -104.f || (QSN > 1 && lrow[1] >= -104.f))) ? 1 : 0;
      if (lane == 0 && __builtin_amdgcn_ballot_w64(cont != 0) != 0ull) flg[it & 1] = 1;
      __syncthreads();
      if (!flg[it & 1]) break;
      ++it;
    } else if (MODE == 1) {
      __syncthreads();
      if (!more) break;
    } else {
      if (!more) break;
      buf = (buf == 2) ? 0 : buf + 1;
    }
    t = tn;
  }
  if (MODE == 0 && nseg > 1) {
    typedef unsigned long long u64;
    volatile int* ctlw = (volatile int*)(smem + CTL_OFF);
    {
      u64* po = (u64*)(part + (size_t)seg * (6 * (PART_BYTES / 4))) + (size_t)(w * 34) * 64 + lane;
#pragma unroll
      for (int ds = 0; ds < NDS; ++ds)
#pragma unroll
        for (int qs = 0; qs < 2; ++qs) {
          const f32x4 v = o[ds][qs];
          const u64 lo = ((u64)__float_as_uint(v[1]) << 32) | __float_as_uint(v[0]), hi = ((u64)__float_as_uint(v[3]) << 32) | __float_as_uint(v[2]);
          __hip_atomic_store(po + ((ds * 2 + qs) * 2 + 0) * 64, lo, __ATOMIC_RELAXED, __HIP_MEMORY_SCOPE_AGENT);
          __hip_atomic_store(po + ((ds * 2 + qs) * 2 + 1) * 64, hi, __ATOMIC_RELAXED, __HIP_MEMORY_SCOPE_AGENT);
        }
      __hip_atomic_store(po + 32 * 64, ((u64)__float_as_uint(mrow[1]) << 32) | __float_as_uint(mrow[0]), __ATOMIC_RELAXED, __HIP_MEMORY_SCOPE_AGENT);
      __hip_atomic_store(po + 33 * 64, ((u64)__float_as_uint(lrow[1]) << 32) | __float_as_uint(lrow[0]), __ATOMIC_RELAXED, __HIP_MEMORY_SCOPE_AGENT);
    }
    asm volatile("s_waitcnt vmcnt(0)" ::: "memory");
    __syncthreads();
    if (tid == 0) ctlw[1] = (int)atomicAdd(cnt, 1u);
    __syncthreads();
    const int rank = __builtin_amdgcn_readfirstlane(ctlw[1]);
    if (rank != nseg - 1) return;
    for (int s2 = 0; s2 < nseg; ++s2) {
      if (s2 == seg) continue;
      u64* po = (u64*)(part + (size_t)s2 * (6 * (PART_BYTES / 4))) + (size_t)(w * 34) * 64 + lane;
      const u64 m2p = __hip_atomic_load(po + 32 * 64, __ATOMIC_RELAXED, __HIP_MEMORY_SCOPE_AGENT);
      const u64 l2p = __hip_atomic_load(po + 33 * 64, __ATOMIC_RELAXED, __HIP_MEMORY_SCOPE_AGENT);
#pragma unroll
      for (int qs = 0; qs < 2; ++qs) {
        const float m2 = __uint_as_float((unsigned)(m2p >> (32 * qs))), l2 = __uint_as_float((unsigned)(l2p >> (32 * qs)));
        const float mn = fmaxf(mrow[qs], m2);
        const float ca = __builtin_amdgcn_exp2f(mrow[qs] - mn), cb = __builtin_amdgcn_exp2f(m2 - mn);
        mrow[qs] = mn;
        lrow[qs] = lrow[qs] * ca + l2 * cb;
        u64 plo[NDS], phi[NDS];
#pragma unroll
        for (int ds = 0; ds < NDS; ++ds) {
          plo[ds] = __hip_atomic_load(po + ((ds * 2 + qs) * 2 + 0) * 64, __ATOMIC_RELAXED, __HIP_MEMORY_SCOPE_AGENT);
          phi[ds] = __hip_atomic_load(po + ((ds * 2 + qs) * 2 + 1) * 64, __ATOMIC_RELAXED, __HIP_MEMORY_SCOPE_AGENT);
        }
#pragma unroll
        for (int ds = 0; ds < NDS; ++ds) {
          f32x4 o2;
          o2[0] = __uint_as_float((unsigned)plo[ds]); o2[1] = __uint_as_float((unsigned)(plo[ds] >> 32));
          o2[2] = __uint_as_float((unsigned)phi[ds]); o2[3] = __uint_as_float((unsigned)(phi[ds] >> 32));
          o[ds][qs] = o[ds][qs] * ca + o2 * cb;
        }
      }
    }
  }
  int fr_e = fr, fq_e = fq;
  asm volatile("" : "+v"(fr_e), "+v"(fq_e));
#pragma unroll
  for (int qs = 0; qs < QSN; ++qs) {
    float inv = 1.f;
    if (MODE != 2) {
      float lsum = lrow[qs];
      lsum = xsum16(lsum);
      lsum = xsum32(lsum);
      inv = 1.f / lsum;
    }
    const int row = w * (16 * QSN) + qs * 16 + fr_e;
#pragma unroll
    for (int ds = 0; ds < NDS; ++ds) {
      const int dv = ds * 16 + fq_e * 4;
      uint2 g2 = *(const uint2*)(gate + (unsigned)(row * DIN + dv));
      float v0 = o[ds][qs][0] * inv * bflo(g2.x), v1 = o[ds][qs][1] * inv * bfhi(g2.x);
      float v2 = o[ds][qs][2] * inv * bflo(g2.y), v3 = o[ds][qs][3] * inv * bfhi(g2.y);
      *(uint2*)(outp + (unsigned)(row * DM + dv)) = make_uint2(pack2(v0, v1), pack2(v2, v3));
    }
  }
}

#undef KLOAD
#undef KSTORE
#undef VLOAD
#undef VSTORE
#undef load_k
#undef load_v
#undef store_tile

#undef KLOAD
#undef KSTORE
#undef VLOAD
#undef VSTORE
#undef load_k
#undef load_v
#undef store_tile
#undef MLA_ISSUE

__device__ void gmlp_item(const Params& p, int l, int n, int g, char* smem, int wv) {
  constexpr int WST = 136;
  u16* Ws = (u16*)smem;
  u16* Bs = Ws + 128 * WST;
  float* s_mu = (float*)(Bs + 128 * WST);
  float* s_rs = s_mu + 128;
  const int tid = tid_of(wv);
  const int w = wv, lane = tid & 63, fr = lane & 15, fq = lane >> 4;
  const int row0 = n * 128;
  {
    const int r = tid >> 2, qt = tid & 3;
    const u16* src = p.h() + (size_t)(row0 + r) * DIN + C_SGV + qt * 128;
    uint4 v[16];
#pragma unroll
    for (int i = 0; i < 16; ++i) v[i] = *(const uint4*)(src + i * 8);
    float s = 0.f, q = 0.f;
#pragma unroll
    for (int i = 0; i < 16; ++i) {
      const unsigned ww[4] = {v[i].x, v[i].y, v[i].z, v[i].w};
#pragma unroll
      for (int k = 0; k < 4; ++k) { float a = bflo(ww[k]), b = bfhi(ww[k]); s += a + b; q += a * a + b * b; }
    }
    s += shx(s, lane, 1); q += shx(q, lane, 1);
    s += shx(s, lane, 2); q += shx(q, lane, 2);
    const float mu = s * (1.f / 512.f);
    const float var = fmaxf(q * (1.f / 512.f) - mu * mu, 0.f);
    if (qt == 0) { s_mu[r] = mu; s_rs[r] = rsqrtf(var + 1e-5f); }
  }
  {
    const float* wsrc = p.sg_w + (size_t)(l * 4 + g) * 128 * 128;
    float4 wv4[8];
#pragma unroll
    for (int i = 0; i < 8; ++i) { int id = tid + NT * i; wv4[i] = *(const float4*)(wsrc + (id >> 5) * 128 + (id & 31) * 4); }
#pragma unroll
    for (int i = 0; i < 8; ++i) {
      int id = tid + NT * i, tt = id >> 5, s4 = (id & 31) * 4;
      float4 v = wv4[i];
      if (tt < 64 && s4 >= 64) v = make_float4(0.f, 0.f, 0.f, 0.f);
      *(uint2*)(Ws + tt * WST + s4) = make_uint2(pack2(v.x, v.y), pack2(v.z, v.w));
    }
  }
  const int bs_ = tid >> 2, bc_ = (tid & 3) * 32;
  uint4 bch[4];
#pragma unroll
  for (int i = 0; i < 4; ++i) bch[i] = *(const uint4*)(p.h() + (size_t)(row0 + bs_) * DIN + C_SGV + g * 128 + bc_ + i * 8);
  float4 lgv[8], lbv[8];
#pragma unroll
  for (int i = 0; i < 8; ++i) { lgv[i] = *(const float4*)(p.sg_ln_g + (size_t)l * 512 + g * 128 + bc_ + i * 4); lbv[i] = *(const float4*)(p.sg_ln_b + (size_t)l * 512 + g * 128 + bc_ + i * 4); }
  const int tt_e = w * 16 + fr;
  const float bias_e = p.sg_b[(size_t)(l * 4 + g) * 128 + tt_e];
  uint2 u2e[8], g2e[8];
#pragma unroll
  for (int ns = 0; ns < 8; ++ns) {
    const u16* hr = p.h() + (size_t)(row0 + tt_e) * DIN + g * 128 + ns * 16 + fq * 4;
    u2e[ns] = *(const uint2*)(hr + C_SGU); g2e[ns] = *(const uint2*)(hr + C_GB);
  }
  __syncthreads();
  {
    const float mu = s_mu[bs_], rs = s_rs[bs_];
#pragma unroll
    for (int i = 0; i < 4; ++i) {
      const int c0 = bc_ + i * 8;
      const float4 g0 = lgv[2 * i], g1 = lgv[2 * i + 1], b0 = lbv[2 * i], b1 = lbv[2 * i + 1];
      const unsigned ww[4] = {bch[i].x, bch[i].y, bch[i].z, bch[i].w};
      const float gg[8] = {g0.x, g0.y, g0.z, g0.w, g1.x, g1.y, g1.z, g1.w}, bb[8] = {b0.x, b0.y, b0.z, b0.w, b1.x, b1.y, b1.z, b1.w};
#pragma unroll
      for (int k = 0; k < 4; ++k) {
        const float v0 = (bflo(ww[k]) - mu) * rs * gg[2 * k] + bb[2 * k], v1 = (bfhi(ww[k]) - mu) * rs * gg[2 * k + 1] + bb[2 * k + 1];
        const unsigned pk = pack2(v0, v1);
        Bs[(c0 + 2 * k) * WST + bs_] = (u16)(pk & 0xffffu);
        Bs[(c0 + 2 * k + 1) * WST + bs_] = (u16)(pk >> 16);
      }
    }
  }
  __syncthreads();
  f32x4 acc[8];
#pragma unroll
  for (int ns = 0; ns < 8; ++ns) acc[ns] = f32x4{0.f, 0.f, 0.f, 0.f};
#pragma unroll
  for (int st = 0; st < 4; ++st) {
    const bf16x8 wf = *(const bf16x8*)(Ws + (w * 16 + fr) * WST + st * 32 + fq * 8);
#pragma unroll
    for (int ns = 0; ns < 8; ++ns) {
      bf16x8 bfv = *(const bf16x8*)(Bs + (ns * 16 + fr) * WST + st * 32 + fq * 8);
      acc[ns] = mfma16(bfv, wf, acc[ns]);
    }
  }
  {
    const int tt = w * 16 + fr;
    const float bias = bias_e;
    const u16* hrow = p.h() + (size_t)(row0 + tt) * DIN;
#pragma unroll
    for (int ns = 0; ns < 8; ++ns) {
      const int c = g * 128 + ns * 16 + fq * 4;
      const uint2 u2 = u2e[ns], g2 = g2e[ns];
      float v0 = bflo(u2.x) * (acc[ns][0] + bias) * bflo(g2.x);
      float v1 = bfhi(u2.x) * (acc[ns][1] + bias) * bfhi(g2.x);
      float v2 = bflo(u2.y) * (acc[ns][2] + bias) * bflo(g2.y);
      float v3 = bfhi(u2.y) * (acc[ns][3] + bias) * bfhi(g2.y);
      *(uint2*)(p.yin() + (size_t)(row0 + tt) * DM + 768 + c) = make_uint2(pack2(v0, v1), pack2(v2, v3));
    }
  }
  __syncthreads();
}

__device__ const unsigned g_mla_items[288] = {
  0x7e0101fu, 0x7e0103fu, 0x7e0105fu, 0x7e0107fu, 0x7e0109fu, 0x7e010bfu, 0x4e00809u, 0x4e00829u, 0xff0111fu, 0xff0113fu, 0xff0115fu, 0xff0117fu,
  0xff0119fu, 0xff011bfu, 0x4e00849u, 0x4e00869u, 0x7e0080fu, 0x7e0082fu, 0x7e0084fu, 0x7e0086fu, 0x7e0088fu, 0x7e008afu, 0x4e00889u, 0x4e008a9u,
  0x7a0101eu, 0x7a0103eu, 0x7a0105eu, 0x7a0107eu, 0x7a0109eu, 0x7a010beu, 0x4a01012u, 0x9699112u, 0xf6f911eu, 0xf6f913eu, 0xf6f915eu, 0xf6f917eu,
  0xf6f919eu, 0xf6f91beu, 0x4a01032u, 0x9699132u, 0x760101du, 0x760103du, 0x760105du, 0x760107du, 0x760109du, 0x76010bdu, 0x4a01052u, 0x9699152u,
  0xeef111du, 0xeef113du, 0xeef115du, 0xeef117du, 0xeef119du, 0xeef11bdu, 0x4a01072u, 0x9699172u, 0x760080eu, 0x760082eu, 0x760084eu, 0x760086eu,
  0x760088eu, 0x76008aeu, 0x4a01092u, 0x9699192u, 0x720101cu, 0x720103cu, 0x720105cu, 0x720107cu, 0x720109cu, 0x72010bcu, 0x4a010b2u, 0x96991b2u,
  0xe6e911cu, 0xe6e913cu, 0xe6e915cu, 0xe6e917cu, 0xe6e919cu, 0xe6e91bcu, 0x4601011u, 0x8e91111u, 0x6e0101bu, 0x6e0103bu, 0x6e0105bu, 0x6e0107bu,
  0x6e0109bu, 0x6e010bbu, 0x4601031u, 0x8e91131u, 0xdee111bu, 0xdee113bu, 0xdee115bu, 0xdee117bu, 0xdee119bu, 0xdee11bbu, 0x4601051u, 0x8e91151u,
  0x6e0080du, 0x6e0082du, 0x6e0084du, 0x6e0086du, 0x6e0088du, 0x6e008adu, 0x4601071u, 0x8e91171u, 0x6a0101au, 0x6a0103au, 0x6a0105au, 0x6a0107au,
  0x6a0109au, 0x6a010bau, 0x4601091u, 0x8e91191u, 0xd6d911au, 0xd6d913au, 0xd6d915au, 0xd6d917au, 0xd6d919au, 0xd6d91bau, 0x46010b1u, 0x8e911b1u,
  0x6601019u, 0x6601039u, 0x6601059u, 0x6601079u, 0x6601099u, 0x66010b9u, 0x4600808u, 0x4600828u, 0xced1119u, 0xced1139u, 0xced1159u, 0xced1179u,
  0xced1199u, 0xced11b9u, 0x4600848u, 0x4600868u, 0x660080cu, 0x660082cu, 0x660084cu, 0x660086cu, 0x660088cu, 0x66008acu, 0x4600888u, 0x46008a8u,
  0x6201018u, 0x6201038u, 0x6201058u, 0x6201078u, 0x6201098u, 0x62010b8u, 0x4201010u, 0x8689110u, 0xc6c9118u, 0xc6c9138u, 0xc6c9158u, 0xc6c9178u,
  0xc6c9198u, 0xc6c91b8u, 0x4201030u, 0x8689130u, 0x5e01017u, 0x5e01037u, 0x5e01057u, 0x5e01077u, 0x5e01097u, 0x5e010b7u, 0x4201050u, 0x8689150u,
  0xbec1117u, 0xbec1137u, 0xbec1157u, 0xbec1177u, 0xbec1197u, 0xbec11b7u, 0x4201070u, 0x8689170u, 0x5e0080bu, 0x5e0082bu, 0x5e0084bu, 0x5e0086bu,
  0x5e0088bu, 0x5e008abu, 0x4201090u, 0x8689190u, 0x5a01016u, 0x5a01036u, 0x5a01056u, 0x5a01076u, 0x5a01096u, 0x5a010b6u, 0x42010b0u, 0x86891b0u,
  0xb6b9116u, 0xb6b9136u, 0xb6b9156u, 0xb6b9176u, 0xb6b9196u, 0xb6b91b6u, 0x3e00807u, 0x3e00827u, 0x5601015u, 0x5601035u, 0x5601055u, 0x5601075u,
  0x5601095u, 0x56010b5u, 0x3e00847u, 0x3e00867u, 0xaeb1115u, 0xaeb1135u, 0xaeb1155u, 0xaeb1175u, 0xaeb1195u, 0xaeb11b5u, 0x3e00887u, 0x3e008a7u,
  0x560080au, 0x560082au, 0x560084au, 0x560086au, 0x560088au, 0x56008aau, 0x3600806u, 0x3600826u, 0x5201014u, 0x5201034u, 0x5201054u, 0x5201074u,
  0x5201094u, 0x52010b4u, 0x3600846u, 0x3600866u, 0xa6a9114u, 0xa6a9134u, 0xa6a9154u, 0xa6a9174u, 0xa6a9194u, 0xa6a91b4u, 0x3600886u, 0x36008a6u,
  0x4e01013u, 0x4e01033u, 0x4e01053u, 0x4e01073u, 0x4e01093u, 0x4e010b3u, 0x2e00805u, 0x2e00825u, 0x9ea1113u, 0x9ea1133u, 0x9ea1153u, 0x9ea1173u,
  0x9ea1193u, 0x9ea11b3u, 0x2e00845u, 0x2e00865u, 0x2e00885u, 0x2e008a5u, 0x2600804u, 0x2600824u, 0x2600844u, 0x2600864u, 0x2600884u, 0x26008a4u,
  0x1e00803u, 0x1e00823u, 0x1e00843u, 0x1e00863u, 0x1e00883u, 0x1e008a3u, 0x1600802u, 0x1600822u, 0x1600842u, 0x1600862u, 0x1600882u, 0x16008a2u,
  0xe00801u, 0xe00821u, 0xe00841u, 0xe00861u, 0xe00881u, 0xe008a1u, 0x600800u, 0x600820u, 0x600840u, 0x600860u, 0x600880u, 0x6008a0u,
};
__device__ const unsigned char g_slot_base[32] = {0, 0, 0, 0, 0, 0, 0, 0, 0, 0, 0, 0, 0, 0, 0, 0, 0, 2, 4, 6, 8, 10, 12, 14, 16, 18, 20, 22, 24, 26, 28, 30};

#ifndef PROBE_PHASE
#define PROBE_PHASE 0
#endif
#define PROBE_BEGIN(k) unsigned long long pt0_##k = 0; if (PROBE_PHASE == k) pt0_##k = __builtin_amdgcn_s_memrealtime();
#define PROBE_END(k) if (PROBE_PHASE == k) { const unsigned long long dt_ = __builtin_amdgcn_s_memrealtime() - pt0_##k, t1_ = __builtin_amdgcn_s_memrealtime(); \
    while (__builtin_amdgcn_s_memrealtime() - t1_ < dt_) __builtin_amdgcn_s_sleep(8); }
__device__ void phaseC(const Params& p, int l, int ci, char* smem, int wv) {
  volatile int* ctl = (volatile int*)(smem + CTL_OFF);
  constexpr int N_MLA = 288, N_SB = 256, N_MEM = 128, N_G = 256;
  constexpr int N_ALL = N_MLA + N_SB + N_MEM + N_G;
  bool first = true;
  while (true) {
    __syncthreads();
    if (tid_of(wv) == 0) ctl[0] = first ? (int)blockIdx.x : (int)atomicAdd(&p.ctr()[ci], 1u);
    first = false;
    __syncthreads();
    const int qi = __builtin_amdgcn_readfirstlane(ctl[0]);
    if (qi >= N_ALL) break;
    const int item = qi < N_MLA ? qi : qi < N_MLA + N_G ? qi + N_SB + N_MEM : qi - N_G;
    const int kind_ = item < N_MLA ? 7 : item < N_MLA + N_SB ? 8 : item < N_MLA + N_SB + N_MEM ? 9 : 10;
    unsigned long long it0_ = 0; if (PROBE_PHASE == kind_) it0_ = __builtin_amdgcn_s_memrealtime();
    if (item < N_MLA) {
      const unsigned wd = g_mla_items[item];
      const int qb = wd & 31, hd = (wd >> 5) & 7, seg = (wd >> 8) & 7, nseg = (wd >> 11) & 7, t0 = (wd >> 14) & 127, t1 = (wd >> 21) & 127;
      const int q0 = qb * 256;
      const int sbase = g_slot_base[qb];
      attn_item<192, 128, 0, 2>(p.q() + ((size_t)hd * SEQ + q0) * 192, 192, p.k() + (size_t)hd * SEQ * 192, 192,
                                p.vt() + (size_t)hd * 128 * SEQ, SEQ, t0, t1, 4 * qb, 1.0f, q0,
                                p.h() + (size_t)q0 * DIN + C_GA + hd * 128, p.yin() + (size_t)q0 * DM + hd * 128, smem, wv,
                                nseg, seg, p.part() + (size_t)(sbase * 6 + hd) * (PART_BYTES / 4), p.ctr() + 64 + (l * 32 + qb) * 6 + hd);
    } else if (item < N_MLA + N_SB) {
      const int it = item - N_MLA, qb = 63 - (it >> 2), hd = it & 3, q0 = qb * 128;
      attn_item<128, 128, 2, 1>(p.h() + (size_t)q0 * DIN + C_SBQ + hd * 128, DIN, p.h() + C_SBK + hd * 128, DIN,
                             p.vtsb() + (size_t)hd * 128 * SEQ, SEQ, 0, 2 * qb + 1, 2 * qb, 0.08838834764831845f, q0,
                             p.h() + (size_t)q0 * DIN + C_GC + hd * 128, p.yin() + (size_t)q0 * DM + 1280 + hd * 128, smem, wv);
    } else if (item < N_MLA + N_SB + N_MEM) {
      const int it = item - N_MLA - N_SB, qb = it >> 2, hd = it & 3, q0 = qb * 256;
      attn_item<64, 64, 1, 2>(p.h() + (size_t)q0 * DIN + C_MQ + hd * 64, DIN, p.mk() + (size_t)(l * 4 + hd) * 256 * 64, 64,
                           p.mvt() + (size_t)(l * 4 + hd) * 64 * 256, 256, 0, 3, 0, 0.125f * 1.4426950408889634f, q0,
                           p.h() + (size_t)q0 * DIN + C_GM + hd * 64, p.yin() + (size_t)q0 * DM + 1792 + hd * 64, smem, wv);
    } else {
      const int it = item - N_MLA - N_SB - N_MEM;
      gmlp_item(p, l, it >> 2, it & 3, smem, wv);
    }
    if (PROBE_PHASE == kind_) { const unsigned long long dt_ = __builtin_amdgcn_s_memrealtime() - it0_, t1_ = __builtin_amdgcn_s_memrealtime();
      while (__builtin_amdgcn_s_memrealtime() - t1_ < dt_) __builtin_amdgcn_s_sleep(8); }
  }
}

__global__ void __launch_bounds__(NT, 2) fwd_megakernel(Params p) {
  extern __shared__ __attribute__((aligned(16))) char smem[];
  volatile LAS unsigned* xst = (volatile LAS unsigned*)(smem + CTL_OFF + 16);
  const int wv = __builtin_amdgcn_readfirstlane(threadIdx.x >> 6);
  if (tid_of(wv) == 0) { xst[0] = 0u; xst[1] = 0u; }
  __syncthreads();
  const XcdBarrier xb = xcd_barrier_post(p.bar(), xst, wv);
#define grid_barrier() xcd_barrier(xb, wv)
  LAS unsigned char* glds = (LAS unsigned char*)smem;
  const int G = gridDim.x, B = blockIdx.x;
  PROBE_BEGIN(1)
  phase_prep(p, smem, wv);
  if (p.ws == nullptr) cg::this_grid().sync(); else grid_barrier();
  PROBE_END(1)
  for (int l = 0; l < NL; ++l) {
    int Bl = B, Gl = G, wvl = wv;
    asm volatile("" : "+s"(Bl), "+s"(Gl), "+s"(wvl));
    Params pl = p;
    { char* w_ = pl.ws; asm volatile("" : "+s"(w_)); pl.ws = w_; }
    PROBE_BEGIN(2)
    {
      pg8::StaticOrder S; S.init(SEQ, DINP, Gl, Bl);
      pg8::Gemm g{pl.xb(), pl.wt_in() + (size_t)l * DINP * DM, DM, DM, DM};
      EpiA E{pl, l};
      pg8::gemm_phase(glds, g, S, E, wvl);
    }
    if (l == 0) {
      __syncthreads();
      pg8::StaticOrder S; S.init(256, NL * 512, Gl, (Bl + 32) % Gl);
      pg8::Gemm g{pl.memb(), pl.wt_memkv(), DM, DM, DM};
      EpiMem E{pl};
      pg8::gemm_phase(glds, g, S, E, wvl);
    }
    grid_barrier();
    PROBE_END(2)
    PROBE_BEGIN(3)
    {
      pg8::StrideOrder Sq, Skv;
      if (Gl == 256) { Sq = pg8::StrideOrder{Bl, 0, Bl < 160 ? 1 : 0, 160}; Skv = pg8::StrideOrder{(Bl - 160) * 2, 1, Bl >= 160 ? 2 : 0, 192}; }
      else { Sq = pg8::StrideOrder{Bl, Gl, 1 << 20, 160}; Skv = pg8::StrideOrder{Bl, Gl, 1 << 20, 192}; }
      {
        pg8::Gemm g{pl.h() + C_CQ, pl.wt_uq() + (size_t)l * UQP * 512, DIN, 512, 512};
        EpiQ E{pl};
        pg8::gemm_phase(glds, g, Sq, E, wvl);
      }
      __syncthreads();
      {
        pg8::Gemm g{pl.h() + C_CKV, pl.wt_ukv() + (size_t)l * 1536 * 256, DIN, 256, 256};
        EpiKV E{pl};
        pg8::gemm_phase(glds, g, Skv, E, wvl);
      }
    }
    grid_barrier();
    PROBE_END(3)
    PROBE_BEGIN(4)
    phaseC(pl, l, l, smem, wvl);
    grid_barrier();
    PROBE_END(4)
    PROBE_BEGIN(5)
    {
      pg8::StaticOrder S; S.init(SEQ, DM, Gl, Bl);
      pg8::Gemm g{pl.yin(), pl.wt_out() + (size_t)l * DM * DM, DM, DM, DM};
      EpiDF E{pl, l, smem};
      pg8::gemm_phase(glds, g, S, E, wvl);
    }
    if (l + 1 < NL) grid_barrier();
    PROBE_END(5)
  }
}

extern "C" void kernel_launch(void* const* d_in, const int* in_sizes, int n_in, void* d_out, int out_size, void* d_ws,
                              size_t ws_size, hipStream_t stream) {
  static int grid_blocks = 0;
  if (!grid_blocks) {
    int dev = 0, cus = 0, per_cu = 0;
    (void)hipGetDevice(&dev);
    (void)hipDeviceGetAttribute(&cus, hipDeviceAttributeMultiprocessorCount, dev);
    (void)hipFuncSetAttribute((const void*)fwd_megakernel, hipFuncAttributeMaxDynamicSharedMemorySize, LDS_BYTES);
    (void)hipOccupancyMaxActiveBlocksPerMultiprocessor(&per_cu, fwd_megakernel, NT, LDS_BYTES);
    if (per_cu > 1) per_cu = 1;
    if (per_cu < 1) per_cu = 1;
    grid_blocks = cus * per_cu;
  }
  Params p{};
  p.x = (const float*)d_in[0]; p.mem = (const float*)d_in[1]; p.pos = (const int*)d_in[2]; p.w_in = (const float*)d_in[3];
  p.q_norm_g = (const float*)d_in[4]; p.w_uq = (const float*)d_in[5]; p.kv_norm_g = (const float*)d_in[6];
  p.w_ukv = (const float*)d_in[7]; p.sg_ln_g = (const float*)d_in[8]; p.sg_ln_b = (const float*)d_in[9];
  p.sg_w = (const float*)d_in[10]; p.sg_b = (const float*)d_in[11]; p.w_mem_k = (const float*)d_in[12];
  p.w_mem_v = (const float*)d_in[13]; p.w_out = (const float*)d_in[14]; p.ln_g = (const float*)d_in[15];
  p.ln_b = (const float*)d_in[16];
  p.out = (float*)d_out;
  p.ws = (char*)d_ws;
  (void)hipMemsetAsync(p.ws + OFF_BAR, 0, 16384, stream);
  void* args[] = {&p};
  hipError_t e = hipLaunchCooperativeKernel((const void*)fwd_megakernel, dim3(grid_blocks), dim3(NT), args, LDS_BYTES, stream);
  if (e != hipSuccess) fprintf(stderr, "cooperative launch failed: %s (grid %d)\n", hipGetErrorString(e), grid_blocks);
}
```

```cpp
#include <hip/hip_runtime.h>
#include <hip/hip_cooperative_groups.h>
#include <cstdio>
namespace cg = cooperative_groups;

typedef unsigned short u16;
using bf16x8 = __attribute__((ext_vector_type(8))) short;
using f32x4 = __attribute__((ext_vector_type(4))) float;
typedef __bf16 bf16x2_t __attribute__((ext_vector_type(2)));
typedef float f32x2_t __attribute__((ext_vector_type(2)));

#define SEQ 8192
#define DM 2048
#define DIN 5696
#define DINP 5888
#define UQP 1280
#define NL 4
#define NT 512

constexpr int GEMM_LDS = 131072;
constexpr int MLA_STAGE = 40960;
constexpr int MLA_QR_OFF = 3 * MLA_STAGE;
constexpr int CTL_OFF = MLA_QR_OFF + 32768;
constexpr int LDS_BYTES = CTL_OFF + 256;

constexpr int C_CQ = 0, C_CKV = 512, C_KPE = 768, C_GA = 832, C_SGU = 1600, C_SGV = 2112, C_GB = 2624,
              C_SBQ = 3136, C_SBK = 3648, C_SBV = 4160, C_GC = 4672, C_MQ = 5184, C_GM = 5440;

constexpr size_t al256(size_t x) { return (x + 255) & ~(size_t)255; }
constexpr size_t OFF_BAR = 0;
constexpr size_t OFF_CTR = OFF_BAR + al256(16384);
constexpr size_t OFF_SSQ = OFF_CTR + al256(8192);
constexpr size_t OFF_WT_IN = OFF_SSQ + al256((size_t)2 * SEQ * 4);
constexpr size_t OFF_WT_OUT = OFF_WT_IN + al256((size_t)NL * DINP * DM * 2);
constexpr size_t OFF_WT_UQ = OFF_WT_OUT + al256((size_t)NL * DM * DM * 2);
constexpr size_t OFF_WT_UKV = OFF_WT_UQ + al256((size_t)NL * UQP * 512 * 2);
constexpr size_t OFF_WT_MEMKV = OFF_WT_UKV + al256((size_t)NL * 1536 * 256 * 2);
constexpr size_t OFF_MEMB = OFF_WT_MEMKV + al256((size_t)NL * 512 * DM * 2);
constexpr size_t OFF_XB = OFF_MEMB + al256((size_t)256 * DM * 2);
constexpr size_t OFF_H = OFF_XB + al256((size_t)SEQ * DM * 2);
constexpr size_t OFF_Q = OFF_H + al256((size_t)SEQ * DIN * 2);
constexpr size_t OFF_K = OFF_Q + al256((size_t)6 * SEQ * 192 * 2);
constexpr size_t OFF_VT = OFF_K + al256((size_t)6 * SEQ * 192 * 2);
constexpr size_t OFF_VTSB = OFF_VT + al256((size_t)6 * 128 * SEQ * 2);
constexpr size_t OFF_YIN = OFF_VTSB + al256((size_t)4 * 128 * SEQ * 2);
constexpr size_t OFF_MK = OFF_YIN + al256((size_t)SEQ * DM * 2);
constexpr size_t OFF_MVT = OFF_MK + al256((size_t)NL * 4 * 256 * 64 * 2);
constexpr size_t OFF_COST = OFF_MVT + al256((size_t)NL * 4 * 64 * 256 * 2);
constexpr size_t OFF_SINT = OFF_COST + al256((size_t)SEQ * 32 * 4);
constexpr size_t OFF_LNSTAT = OFF_SINT + al256((size_t)SEQ * 32 * 4);
constexpr size_t OFF_LNX = OFF_LNSTAT + al256((size_t)SEQ * 2 * 4);
constexpr size_t OFF_KROPE = OFF_LNX + al256((size_t)32 * 8 * 256 * 8);
constexpr size_t OFF_PART = OFF_KROPE + al256((size_t)SEQ * 64 * 2);
constexpr size_t PART_BYTES = 139264;
constexpr size_t WS_TOTAL = OFF_PART + al256((size_t)192 * PART_BYTES);
struct Params {
  const float* x; const float* mem; const int* pos; const float* w_in; const float* q_norm_g; const float* w_uq;
  const float* kv_norm_g; const float* w_ukv; const float* sg_ln_g; const float* sg_ln_b; const float* sg_w; const float* sg_b;
  const float* w_mem_k; const float* w_mem_v; const float* w_out; const float* ln_g; const float* ln_b;
  float* out;
  char* ws;
  __device__ __forceinline__ unsigned* bar() const { return (unsigned*)(ws + OFF_BAR); }
  __device__ __forceinline__ unsigned* ctr() const { return (unsigned*)(ws + OFF_CTR); }
  __device__ __forceinline__ float* ssq() const { return (float*)(ws + OFF_SSQ); }
  __device__ __forceinline__ u16* wt_in() const { return (u16*)(ws + OFF_WT_IN); }
  __device__ __forceinline__ u16* wt_out() const { return (u16*)(ws + OFF_WT_OUT); }
  __device__ __forceinline__ u16* wt_uq() const { return (u16*)(ws + OFF_WT_UQ); }
  __device__ __forceinline__ u16* wt_ukv() const { return (u16*)(ws + OFF_WT_UKV); }
  __device__ __forceinline__ u16* wt_memkv() const { return (u16*)(ws + OFF_WT_MEMKV); }
  __device__ __forceinline__ u16* memb() const { return (u16*)(ws + OFF_MEMB); }
  __device__ __forceinline__ u16* xb() const { return (u16*)(ws + OFF_XB); }
  __device__ __forceinline__ u16* h() const { return (u16*)(ws + OFF_H); }
  __device__ __forceinline__ u16* q() const { return (u16*)(ws + OFF_Q); }
  __device__ __forceinline__ u16* k() const { return (u16*)(ws + OFF_K); }
  __device__ __forceinline__ u16* vt() const { return (u16*)(ws + OFF_VT); }
  __device__ __forceinline__ u16* vtsb() const { return (u16*)(ws + OFF_VTSB); }
  __device__ __forceinline__ u16* yin() const { return (u16*)(ws + OFF_YIN); }
  __device__ __forceinline__ u16* mk() const { return (u16*)(ws + OFF_MK); }
  __device__ __forceinline__ u16* mvt() const { return (u16*)(ws + OFF_MVT); }
  __device__ __forceinline__ float* cosT() const { return (float*)(ws + OFF_COST); }
  __device__ __forceinline__ float* sinT() const { return (float*)(ws + OFF_SINT); }
  __device__ __forceinline__ float* part() const { return (float*)(ws + OFF_PART); }
  __device__ __forceinline__ float* lnstat() const { return (float*)(ws + OFF_LNSTAT); }
  __device__ __forceinline__ u16* krope() const { return (u16*)(ws + OFF_KROPE); }
  __device__ __forceinline__ unsigned long long* lnx() const { return (unsigned long long*)(ws + OFF_LNX); }
};

__device__ __forceinline__ unsigned pack2(float a, float b) {
  f32x2_t v = {a, b};
  bf16x2_t r = __builtin_convertvector(v, bf16x2_t);
  return *(unsigned*)&r;
}
__device__ __forceinline__ u16 f2bf(float a) { return (u16)(pack2(a, 0.f) & 0xffffu); }
__device__ __forceinline__ float bflo(unsigned w) { return __uint_as_float(w << 16); }
__device__ __forceinline__ float bfhi(unsigned w) { return __uint_as_float(w & 0xffff0000u); }
__device__ __forceinline__ float bf2f(u16 h) { return __uint_as_float(((unsigned)h) << 16); }
__device__ __forceinline__ float silu_f(float x) { return x * __builtin_amdgcn_rcpf(1.f + __expf(-x)); }
__device__ __forceinline__ float gelu_f(float x) {
  float u = 0.7978845608028654f * (x + 0.044715f * x * x * x);
  float t = 1.f - 2.f * __builtin_amdgcn_rcpf(__expf(2.f * u) + 1.f);
  return 0.5f * x * (1.f + t);
}
__device__ __forceinline__ f32x4 mfma16(bf16x8 a, bf16x8 b, f32x4 c) {
  return __builtin_amdgcn_mfma_f32_16x16x32_bf16(a, b, c, 0, 0, 0);
}
__device__ __forceinline__ int vperm(int s) { return (s & 32) | (((s >> 2) & 3) << 3) | (((s >> 4) & 1) << 2) | (s & 3); }
__device__ __forceinline__ float xmax16(float v) { auto r = __builtin_amdgcn_permlane16_swap(__float_as_uint(v), __float_as_uint(v), false, false); return fmaxf(__uint_as_float(r[0]), __uint_as_float(r[1])); }
__device__ __forceinline__ float xmax32(float v) { auto r = __builtin_amdgcn_permlane32_swap(__float_as_uint(v), __float_as_uint(v), false, false); return fmaxf(__uint_as_float(r[0]), __uint_as_float(r[1])); }
__device__ __forceinline__ float xsum16(float v) { auto r = __builtin_amdgcn_permlane16_swap(__float_as_uint(v), __float_as_uint(v), false, false); return __uint_as_float(r[0]) + __uint_as_float(r[1]); }
__device__ __forceinline__ float xsum32(float v) { auto r = __builtin_amdgcn_permlane32_swap(__float_as_uint(v), __float_as_uint(v), false, false); return __uint_as_float(r[0]) + __uint_as_float(r[1]); }
__device__ __forceinline__ float shx(float v, int lane, int m) { return __uint_as_float(__builtin_amdgcn_ds_bpermute((lane ^ m) << 2, __float_as_uint(v))); }
__device__ __forceinline__ int tid_of(int wv) {
  int lane;
  asm volatile("v_mbcnt_lo_u32_b32 %0, -1, 0\n\tv_mbcnt_hi_u32_b32 %0, -1, %0" : "=v"(lane));
  return wv * 64 + lane;
}

#define XB_TMO      128
#define XB_XCNT(j)  (256  + 64 * (j))
#define XB_XSUB(j)  (1280 + 64 * (j))
#define XB_XGEN(j)  (2304 + 64 * (j))
#define XB_TOP      3328
#define XB_TOPGEN   3392
#define XCD_BAR_WORDS 3456
#define XB_SPIN_CAP (1u << 22)
#define LAS __attribute__((address_space(3)))
__device__ __forceinline__ unsigned xb_ld(unsigned* p) { return __hip_atomic_load(p, __ATOMIC_RELAXED, __HIP_MEMORY_SCOPE_AGENT); }
__device__ __forceinline__ unsigned xb_add(unsigned* p, unsigned v) { return __hip_atomic_fetch_add(p, v, __ATOMIC_RELAXED, __HIP_MEMORY_SCOPE_AGENT); }
__device__ __forceinline__ unsigned xb_xcc_id() { return (unsigned)__builtin_amdgcn_s_getreg((3 << 11) | 20) & 0xFu; }
#define XB_SPIN(cond, bar) do { unsigned _sp = 0; while (cond) { __builtin_amdgcn_s_sleep(1); \
    if ((++_sp & 255u) == 0u) { if (xb_ld(&(bar)[XB_TMO])) break; if (_sp > XB_SPIN_CAP) { atomicAdd(&(bar)[XB_TMO], 1u); break; } } } } while (0)
struct XcdBarrier { unsigned* bar; unsigned x; volatile LAS unsigned* st; };
__device__ __forceinline__ XcdBarrier xcd_barrier_post(unsigned* bar, volatile LAS unsigned* st, int wv) {
  XcdBarrier b; b.bar = bar; b.x = xb_xcc_id(); b.st = st;
  if (tid_of(wv) == 0) (void)xb_add(&bar[XB_XCNT(b.x)], 1u);
  return b;
}
__device__ __forceinline__ void xcd_barrier_complete(unsigned* bar, unsigned x, unsigned& nloc, unsigned& nx) {
  const unsigned G = gridDim.x * gridDim.y * gridDim.z;
  unsigned sum, cnt, mine, sp = 0u;
  for (;;) {
    sum = 0u; cnt = 0u; mine = 0u;
#pragma unroll
    for (unsigned j = 0; j < 16; ++j) { const unsigned c = xb_ld(&bar[XB_XCNT(j)]); sum += c; cnt += (c > 0u) ? 1u : 0u; mine = (j == x) ? c : mine; }
    if (sum == G) break;
    __builtin_amdgcn_s_sleep(1);
    if ((++sp & 255u) == 0u) { if (xb_ld(&bar[XB_TMO])) break; if (sp > XB_SPIN_CAP) { atomicAdd(&bar[XB_TMO], 1u); break; } }
  }
  nloc = mine > 0u ? mine : 1u; nx = cnt > 0u ? cnt : 1u;
}
__device__ __forceinline__ void xcd_barrier(const XcdBarrier& b, int wv) {
  asm volatile("s_waitcnt vmcnt(0)" ::: "memory");
  __syncthreads();
  if (tid_of(wv) == 0) {
    unsigned* bar = b.bar;
    __builtin_amdgcn_s_waitcnt(0);
    unsigned nloc = b.st[0], nx = b.st[1];
    if (nloc == 0u) { xcd_barrier_complete(bar, b.x, nloc, nx); b.st[0] = nloc; b.st[1] = nx; }
    const unsigned old = xb_add(&bar[XB_XSUB(b.x)], 1u);
    const unsigned gen = old / nloc;
    if (old + 1u == (gen + 1u) * nloc) {
      __builtin_amdgcn_fence(__ATOMIC_RELEASE, "agent");
      asm volatile("s_waitcnt vmcnt(0)" ::: "memory");
      const unsigned og = xb_add(&bar[XB_TOP], 1u);
      const unsigned tg = og / nx;
      if (og + 1u == (tg + 1u) * nx) xb_add(&bar[XB_TOPGEN], 1u);
      else XB_SPIN(xb_ld(&bar[XB_TOPGEN]) == tg, bar);
      __builtin_amdgcn_fence(__ATOMIC_ACQUIRE, "agent");
      xb_add(&bar[XB_XGEN(b.x)], 1u);
      asm volatile("s_waitcnt vmcnt(0)" ::: "memory");
    } else {
      XB_SPIN(xb_ld(&bar[XB_XGEN(b.x)]) == gen, bar);
      __builtin_amdgcn_fence(__ATOMIC_ACQUIRE, "agent");
      asm volatile("s_waitcnt vmcnt(0)" ::: "memory");
    }
  }
  __syncthreads();
}

__device__ __forceinline__ int perm64(int g) { return ((g >> 4) & 1) * 32 + (g >> 5) * 16 + (g & 15); }

__device__ void tconv_all(const float* src, u16* dst, int K, int N, int Npad, size_t srcLS, size_t dstLS, int dstRowOff,
                          const float* g, int gS, int permMode, float* lds0, int wv) {
  const int tid = tid_of(wv);
  const int half = tid >> 8, ht = tid & 255;
  float* lds = lds0 + half * (2 * 64 * 65);
  const int nkt = K / 64, nnt = Npad / 64, per = nkt * nnt, total = NL * per;
  for (int t0 = blockIdx.x * 4; t0 < total; t0 += gridDim.x * 4) {
    float4 v[2][4];
    bool ok[2];
    int n0s[2], k0s[2], ls[2];
#pragma unroll
    for (int j = 0; j < 2; ++j) {
      const int t = t0 + half * 2 + j;
      ok[j] = t < total;
      const int l = t / per, r = t % per, kt = r / nnt, nt = r % nnt;
      ls[j] = l; k0s[j] = kt * 64; n0s[j] = nt * 64;
      const float* sp = src + (size_t)l * srcLS;
#pragma unroll
      for (int i = 0; i < 4; ++i) {
        const int rr = (ht >> 4) + 16 * i, c = (ht & 15) * 4;
        v[j][i] = make_float4(0.f, 0.f, 0.f, 0.f);
        if (ok[j] && n0s[j] + c < N) {
          const f32x4 w4 = __builtin_nontemporal_load((const f32x4*)(sp + (size_t)(k0s[j] + rr) * N + n0s[j] + c));
          v[j][i] = make_float4(w4[0], w4[1], w4[2], w4[3]);
        }
      }
    }
#pragma unroll
    for (int j = 0; j < 2; ++j) {
      const float* gp = g ? g + (size_t)ls[j] * gS : nullptr;
#pragma unroll
      for (int i = 0; i < 4; ++i) {
        const int rr = (ht >> 4) + 16 * i, c = (ht & 15) * 4;
        float4 x = v[j][i];
        if (gp && ok[j]) { const float sc = gp[k0s[j] + rr]; x.x *= sc; x.y *= sc; x.z *= sc; x.w *= sc; }
        float* pp = lds + j * (64 * 65) + rr * 65 + c;
        pp[0] = x.x; pp[1] = x.y; pp[2] = x.z; pp[3] = x.w;
      }
    }
    __syncthreads();
#pragma unroll
    for (int j = 0; j < 2; ++j) {
      if (ok[j]) {
        const int n0 = n0s[j], k0 = k0s[j];
        u16* dp = dst + (size_t)ls[j] * dstLS + (size_t)dstRowOff * K;
        const float* lj = lds + j * (64 * 65);
        const bool perm = (permMode == 1) ? (n0 == C_KPE) : (permMode == 2) ? ((n0 % 192) == 128 && n0 < 1152) : false;
#pragma unroll
        for (int i = 0; i < 2; ++i) {
          const int id = ht + 256 * i, n = id >> 3, kc = (id & 7) * 8;
          const int ns = perm ? perm64(n) : n;
          unsigned w0 = pack2(lj[(kc + 0) * 65 + ns], lj[(kc + 1) * 65 + ns]);
          unsigned w1 = pack2(lj[(kc + 2) * 65 + ns], lj[(kc + 3) * 65 + ns]);
          unsigned w2 = pack2(lj[(kc + 4) * 65 + ns], lj[(kc + 5) * 65 + ns]);
          unsigned w3 = pack2(lj[(kc + 6) * 65 + ns], lj[(kc + 7) * 65 + ns]);
          *(uint4*)(dp + (size_t)(n0 + n) * K + k0 + kc) = make_uint4(w0, w1, w2, w3);
        }
      }
    }
    __syncthreads();
  }
}

__device__ void phase_prep(const Params& p, char* smem, int wv) {
  float* lds = (float*)smem;
  const int tid = tid_of(wv);
  const size_t gtid = (size_t)blockIdx.x * NT + tid, gsz = (size_t)gridDim.x * NT;
  if (blockIdx.x == 0) { p.ctr()[tid] = (tid < 8) ? gridDim.x : 0u; p.ctr()[tid + NT] = 0u; p.ctr()[tid + 2 * NT] = 0u; p.ctr()[tid + 3 * NT] = 0u; }
  for (size_t c = gtid; c < (size_t)2 * SEQ; c += gsz) p.ssq()[c] = 0.f;
  for (size_t c = gtid; c < (size_t)SEQ * DM / 8; c += gsz) {
    float4 a = *(const float4*)(p.x + c * 8), b = *(const float4*)(p.x + c * 8 + 4);
    *(uint4*)(p.xb() + c * 8) = make_uint4(pack2(a.x, a.y), pack2(a.z, a.w), pack2(b.x, b.y), pack2(b.z, b.w));
  }
  for (size_t c = gtid; c < (size_t)256 * DM / 8; c += gsz) {
    float4 a = *(const float4*)(p.mem + c * 8), b = *(const float4*)(p.mem + c * 8 + 4);
    *(uint4*)(p.memb() + c * 8) = make_uint4(pack2(a.x, a.y), pack2(a.z, a.w), pack2(b.x, b.y), pack2(b.z, b.w));
  }
  for (size_t e = gtid; e < (size_t)SEQ * 32; e += gsz) {
    int s = (int)(e >> 5), i = (int)(e & 31);
    float invf = __builtin_amdgcn_exp2f(-(float)i * (13.287712379549449f / 32.0f));
    float ang = (float)p.pos[s] * invf;
    double rev = (double)ang * 0.15915494309189535;
    float fr = (float)(rev - floor(rev));
    p.cosT()[e] = __builtin_amdgcn_cosf(fr);
    p.sinT()[e] = __builtin_amdgcn_sinf(fr);
  }
  tconv_all(p.w_in, p.wt_in(), DM, DIN, DINP, (size_t)DM * DIN, (size_t)DINP * DM, 0, nullptr, 0, 1, lds, wv);
  tconv_all(p.w_out, p.wt_out(), DM, DM, DM, (size_t)DM * DM, (size_t)DM * DM, 0, nullptr, 0, 0, lds, wv);
  tconv_all(p.w_uq, p.wt_uq(), 512, 1152, UQP, (size_t)512 * 1152, (size_t)UQP * 512, 0, p.q_norm_g, 512, 2, lds, wv);
  tconv_all(p.w_ukv, p.wt_ukv(), 256, 1536, 1536, (size_t)256 * 1536, (size_t)1536 * 256, 0, p.kv_norm_g, 256, 0, lds, wv);
  tconv_all(p.w_mem_k, p.wt_memkv(), DM, 256, 256, (size_t)DM * 256, (size_t)512 * DM, 0, nullptr, 0, 0, lds, wv);
  tconv_all(p.w_mem_v, p.wt_memkv(), DM, 256, 256, (size_t)DM * 256, (size_t)512 * DM, 256, nullptr, 0, 0, lds, wv);
}

namespace pg8 {
constexpr int BM = 256, BK = 64, HALF = 128, HTB = HALF * BK * 2, NXCD = 8, WGM = 8;
__device__ __forceinline__ int lds_byte(int r, int c) { const int st = (r >> 4) * 2 + (c >> 5), rr = r & 15, cc = c & 31, ob = rr * 64 + cc * 2; return st * 1024 + (ob ^ (((ob >> 9) & 1) << 5)); }
__device__ __forceinline__ void stage_rc(int b, int& R, int& C) { const int st = b / 1024, sb = b % 1024, swz = sb ^ (((sb >> 9) & 1) << 5); R = (st >> 1) * 16 + swz / 64; C = (st & 1) * 32 + (swz % 64) / 2; }
struct Unit { int pm, pn; };
struct Gemm { const u16* A; const u16* Bt; int lda, ldb, K; };
struct StaticOrder {
  int nM, nN, nwg, G, c;
  __device__ void init(int M, int N, int G_, int c_) { nM = M / BM; nN = N / BM; nwg = nM * nN; G = G_; c = c_; }
  __device__ bool next(int i, Unit& u) const {
    const long L = (long)i * G + c; if (L >= nwg) return false;
    int wgid = (int)L; { const int q = nwg / NXCD, r = nwg % NXCD, xcd = wgid % NXCD, off = wgid / NXCD; wgid = (xcd < r ? xcd * (q + 1) : r * (q + 1) + (xcd - r) * q) + off; }
    const int nig = WGM * nN, gid = wgid / nig, fm = gid * WGM, gsz = (nM - fm) < WGM ? (nM - fm) : WGM;
    u.pm = __builtin_amdgcn_readfirstlane(fm + ((wgid % nig) % gsz)); u.pn = __builtin_amdgcn_readfirstlane((wgid % nig) / gsz); return true;
  }
};
struct StrideOrder {
  int first, stride, count, limit;
  __device__ bool next(int i, Unit& u) const { const int x = first + i * stride; if (i >= count || x >= limit) return false; u.pm = x & 31; u.pn = x >> 5; return true; }
};

template <class Epi, class Sched>
__device__ __forceinline__ void gemm_phase(LAS unsigned char* lds, const Gemm g, const Sched& S, const Epi& E, int wv) {
  const int tid = tid_of(wv);
  const int wid = wv, lane = tid & 63, wr = wid >> 2, wc = wid & 3, fr = lane & 15, fq = lane >> 4;
  const int K = g.K, nt = K / BK;
  unsigned voffA[2], voffB[2];
#pragma unroll
  for (int i = 0; i < 2; ++i) { int R, C; stage_rc(tid * 16 + i * 8192, R, C);
    voffA[i] = (unsigned)(R * g.lda + C) * 2u; voffB[i] = (unsigned)(R * g.ldb + C) * 2u; }
  const size_t kstep = (size_t)(BK * 2);
  const size_t hstepA = (size_t)HALF * g.lda * 2, hstepB = (size_t)HALF * g.ldb * 2;
  const size_t tstepA = 2 * hstepA, tstepB = 2 * hstepB;
  const unsigned ldsw = (unsigned)wid * 1024u;
  const int aoff = lds_byte(wr * 64 + fr, fq * 8), boff = lds_byte(wc * 32 + fr, fq * 8);
#define PG8_SA(b, h) (((b) * 2 + (h)) * HTB)
#define PG8_SB(b, h) ((4 + (b) * 2 + (h)) * HTB)
#define PG8_STAGE(bufoff, gbase, voff) do { _Pragma("unroll") for (int _i = 0; _i < 2; ++_i) \
    __builtin_amdgcn_global_load_lds((const unsigned*)((const char*)(gbase) + (voff)[_i]), (LAS unsigned*)(lds + (bufoff) + ldsw + _i * 8192), 16, 0, 0); } while (0)
#define PG8_LDA(dst, b, h) do { _Pragma("unroll") for (int m = 0; m < 4; ++m) _Pragma("unroll") for (int k = 0; k < 2; ++k) dst[m][k] = *(const LAS bf16x8*)(lds + PG8_SA(b, h) + aoff + m * 2048 + k * 1024); } while (0)
#define PG8_LDB(dst, b, h) do { _Pragma("unroll") for (int n = 0; n < 2; ++n) _Pragma("unroll") for (int k = 0; k < 2; ++k) dst[n][k] = *(const LAS bf16x8*)(lds + PG8_SB(b, h) + boff + n * 2048 + k * 1024); } while (0)
#define PG8_MMA(ai, bj, At, Bt) do { __builtin_amdgcn_s_setprio(1); _Pragma("unroll") for (int m = 0; m < 4; ++m) _Pragma("unroll") for (int n = 0; n < 2; ++n) _Pragma("unroll") for (int k = 0; k < 2; ++k) \
    acc[ai][bj][m][n] = __builtin_amdgcn_mfma_f32_16x16x32_bf16(Bt[n][k], At[m][k], acc[ai][bj][m][n], 0, 0, 0); __builtin_amdgcn_s_setprio(0); } while (0)
#define PG8_WAIT_V(n) asm volatile("s_waitcnt vmcnt(" #n ")" ::: "memory")
#define PG8_WAIT_L(n) asm volatile("s_waitcnt lgkmcnt(" #n ")" ::: "memory")
#define PG8_BAR __builtin_amdgcn_s_barrier()
#define PG8_SCHED __builtin_amdgcn_sched_barrier(0)
  Unit cur, nxt; int ui = 0;
  if (!S.next(0, cur)) return;
  f32x4 acc[2][2][4][2];
#pragma unroll
  for (int a = 0; a < 2; ++a)
#pragma unroll
    for (int b = 0; b < 2; ++b)
#pragma unroll
      for (int m = 0; m < 4; ++m)
#pragma unroll
        for (int n = 0; n < 2; ++n) acc[a][b][m][n] = (f32x4){0.f, 0.f, 0.f, 0.f};
  bf16x8 At[4][2], B0[2][2], B1[2][2];
  const char* cA = (const char*)g.A + (size_t)cur.pm * tstepA; const char* cB = (const char*)g.Bt + (size_t)cur.pn * tstepB;
  PG8_STAGE(PG8_SB(0, 0), cB, voffB); PG8_STAGE(PG8_SA(0, 0), cA, voffA); PG8_STAGE(PG8_SB(0, 1), cB + hstepB, voffB); PG8_STAGE(PG8_SA(0, 1), cA + hstepA, voffA);
  if (wr == 1) PG8_BAR;
  PG8_WAIT_V(4); PG8_BAR;
  PG8_STAGE(PG8_SB(1, 0), cB + kstep, voffB); PG8_STAGE(PG8_SA(1, 0), cA + kstep, voffA); PG8_STAGE(PG8_SB(1, 1), cB + hstepB + kstep, voffB);
  PG8_WAIT_V(6); PG8_BAR;
  for (;;) {
    const bool has_next = S.next(ui + 1, nxt);
    const char* nA = has_next ? (const char*)g.A + (size_t)nxt.pm * tstepA : cA; const char* nB = has_next ? (const char*)g.Bt + (size_t)nxt.pn * tstepB : cB;
    for (int t = 0; t < nt; t += 2) {
      const bool last = (t == nt - 2);
      const char* a1 = cA + (size_t)(t + 1) * kstep;
      const char* a2 = last ? nA : cA + (size_t)(t + 2) * kstep; const char* b2 = last ? nB : cB + (size_t)(t + 2) * kstep;
      const char* a3 = a2 + kstep; const char* b3 = b2 + kstep;
      PG8_LDB(B0, 0, 0); PG8_SCHED; PG8_LDA(At, 0, 0); PG8_STAGE(PG8_SA(1, 1), a1 + hstepA, voffA);
      PG8_WAIT_L(8); PG8_BAR; PG8_WAIT_L(0); PG8_MMA(0, 0, At, B0); PG8_BAR; PG8_SCHED;
      PG8_LDB(B1, 0, 1); PG8_STAGE(PG8_SB(0, 0), b2, voffB);
      PG8_BAR; PG8_WAIT_L(0); PG8_MMA(0, 1, At, B1); PG8_BAR;
      PG8_LDA(At, 0, 1); PG8_STAGE(PG8_SA(0, 0), a2, voffA);
      PG8_BAR; PG8_WAIT_L(0); PG8_MMA(1, 0, At, B0); PG8_BAR; PG8_SCHED;
      PG8_STAGE(PG8_SB(0, 1), b2 + hstepB, voffB);
      PG8_WAIT_V(6); PG8_BAR; PG8_MMA(1, 1, At, B1); PG8_BAR;
      PG8_LDB(B0, 1, 0); PG8_SCHED; PG8_LDA(At, 1, 0); PG8_STAGE(PG8_SA(0, 1), a2 + hstepA, voffA);
      PG8_WAIT_L(8); PG8_BAR; PG8_WAIT_L(0); PG8_MMA(0, 0, At, B0); PG8_BAR; PG8_SCHED;
      PG8_LDB(B1, 1, 1); PG8_STAGE(PG8_SB(1, 0), b3, voffB);
      PG8_BAR; PG8_WAIT_L(0); PG8_MMA(0, 1, At, B1); PG8_BAR;
      PG8_LDA(At, 1, 1); PG8_STAGE(PG8_SA(1, 0), a3, voffA);
      PG8_BAR; PG8_WAIT_L(0); PG8_MMA(1, 0, At, B0); PG8_BAR; PG8_SCHED;
      PG8_STAGE(PG8_SB(1, 1), b3 + hstepB, voffB);
      PG8_WAIT_V(6); PG8_BAR; PG8_MMA(1, 1, At, B1); PG8_BAR;
    }
    if constexpr (!Epi::AFTER_DRAIN) E(acc, cur, wr, wc, fr, fq);
    if (!has_next) break;
#pragma unroll
    for (int a = 0; a < 2; ++a)
#pragma unroll
      for (int b = 0; b < 2; ++b)
#pragma unroll
        for (int m = 0; m < 4; ++m)
#pragma unroll
          for (int n = 0; n < 2; ++n) acc[a][b][m][n] = (f32x4){0.f, 0.f, 0.f, 0.f};
    cur = nxt; cA = nA; cB = nB; ++ui;
  }
  PG8_WAIT_V(0);
  if (wr == 0) PG8_BAR;
  PG8_BAR;
  if constexpr (Epi::AFTER_DRAIN) E.fused(acc, cur, wr, wc);
#undef PG8_SA
#undef PG8_SB
#undef PG8_STAGE
#undef PG8_LDA
#undef PG8_LDB
#undef PG8_MMA
#undef PG8_WAIT_V
#undef PG8_WAIT_L
#undef PG8_BAR
#undef PG8_SCHED
}
}

typedef const f32x4 (&AccRef)[2][2][4][2];

struct EpiA {
  static constexpr bool AFTER_DRAIN = false;
  Params p; int l;
  __device__ __forceinline__ void operator()(AccRef acc, const pg8::Unit& u, int wr, int wc, int fr_, int fq_) const {
    const int lane_ = tid_of(wr * 4 + wc) & 63, fr = lane_ & 15, fq = lane_ >> 4;
    const int rowb = u.pm * 256 + wr * 64 + fr;
#pragma unroll
    for (int bj = 0; bj < 2; ++bj) {
      const int cs = u.pn * 256 + bj * 128 + wc * 32;
      int kind;
      if (cs < C_KPE) kind = 0; else if (cs < C_GA) kind = 3; else if (cs < C_SGU) kind = 1;
      else if (cs < C_GB) kind = 2; else if (cs < C_SBQ) kind = 1; else if (cs < C_SBV) kind = 0;
      else if (cs < C_GC) kind = 4; else if (cs < C_MQ) kind = 1; else if (cs < C_GM) kind = 0;
      else if (cs < DIN) kind = 1; else kind = 5;
      if (kind == 5) continue;
      if (kind <= 2) {
#pragma unroll
        for (int ai = 0; ai < 2; ++ai)
#pragma unroll
          for (int m = 0; m < 4; ++m) {
            const int row = rowb + ai * 128 + m * 16;
#pragma unroll
            for (int n = 0; n < 2; ++n) {
              f32x4 v = acc[ai][bj][m][n];
              if (kind == 1) { v[0] = silu_f(v[0]); v[1] = silu_f(v[1]); v[2] = silu_f(v[2]); v[3] = silu_f(v[3]); }
              else if (kind == 2) { v[0] = gelu_f(v[0]); v[1] = gelu_f(v[1]); v[2] = gelu_f(v[2]); v[3] = gelu_f(v[3]); }
              *(uint2*)(p.h() + (size_t)row * DIN + cs + n * 16 + fq * 4) = make_uint2(pack2(v[0], v[1]), pack2(v[2], v[3]));
            }
          }
      } else if (kind == 3) {
        const int i0 = ((cs >> 5) & 1) * 16 + fq * 4;
#pragma unroll
        for (int ai = 0; ai < 2; ++ai)
#pragma unroll
          for (int m = 0; m < 4; ++m) {
            const int row = rowb + ai * 128 + m * 16;
            float4 cs4 = *(const float4*)(p.cosT() + (size_t)row * 32 + i0);
            float4 sn = *(const float4*)(p.sinT() + (size_t)row * 32 + i0);
            f32x4 x1 = acc[ai][bj][m][0], x2 = acc[ai][bj][m][1];
            float a0 = x1[0] * cs4.x - x2[0] * sn.x, a1 = x1[1] * cs4.y - x2[1] * sn.y, a2 = x1[2] * cs4.z - x2[2] * sn.z, a3 = x1[3] * cs4.w - x2[3] * sn.w;
            float b0 = x1[0] * sn.x + x2[0] * cs4.x, b1 = x1[1] * sn.y + x2[1] * cs4.y, b2 = x1[2] * sn.z + x2[2] * cs4.z, b3 = x1[3] * sn.w + x2[3] * cs4.w;
            uint2 ua = make_uint2(pack2(a0, a1), pack2(a2, a3)), ub = make_uint2(pack2(b0, b1), pack2(b2, b3));
            u16* kp = p.krope() + (size_t)row * 64 + i0;
            *(uint2*)kp = ua;
            *(uint2*)(kp + 32) = ub;
          }
      } else {
#pragma unroll
        for (int ai = 0; ai < 2; ++ai)
#pragma unroll
          for (int m = 0; m < 4; ++m) {
            const int row = rowb + ai * 128 + m * 16;
#pragma unroll
            for (int n = 0; n < 2; ++n) {
              const int c = cs - C_SBV + n * 16 + fq * 4;
#pragma unroll
              for (int j = 0; j < 4; ++j) (p.vtsb() + (size_t)(c >> 7) * 128 * SEQ)[(unsigned)((row >> 6) * 8192 + vperm(row & 63) + ((c & 127) + j) * 64)] = f2bf(acc[ai][bj][m][n][j]);
            }
          }
      }
    }
    if (u.pn < 3) {
      float* sq = p.ssq() + (u.pn == 2 ? SEQ : 0);
#pragma unroll
      for (int ai = 0; ai < 2; ++ai)
#pragma unroll
        for (int m = 0; m < 4; ++m) {
          float v = 0.f;
#pragma unroll
          for (int bj = 0; bj < 2; ++bj)
#pragma unroll
            for (int n = 0; n < 2; ++n)
#pragma unroll
              for (int j = 0; j < 4; ++j) { float a = acc[ai][bj][m][n][j]; v += a * a; }
          v = xsum16(v);
          v = xsum32(v);
          if (fq == 0) atomicAdd(sq + rowb + ai * 128 + m * 16, v);
        }
    }
  }
};

struct EpiMem {
  static constexpr bool AFTER_DRAIN = false;
  Params p;
  __device__ __forceinline__ void operator()(AccRef acc, const pg8::Unit& u, int wr, int wc, int fr_, int fq_) const {
    const int lane_ = tid_of(wr * 4 + wc) & 63, fr = lane_ & 15, fq = lane_ >> 4;
    const int l = u.pn >> 1, isv = u.pn & 1;
    const int rowb = wr * 64 + fr;
#pragma unroll
    for (int bj = 0; bj < 2; ++bj)
#pragma unroll
      for (int ai = 0; ai < 2; ++ai)
#pragma unroll
        for (int m = 0; m < 4; ++m) {
          const int row = rowb + ai * 128 + m * 16;
#pragma unroll
          for (int n = 0; n < 2; ++n) {
            const int c = bj * 128 + wc * 32 + n * 16 + fq * 4, hd = c >> 6, e = c & 63;
            if (!isv) {
              *(uint2*)(p.mk() + ((size_t)(l * 4 + hd) * 256 + row) * 64 + e) =
                  make_uint2(pack2(acc[ai][bj][m][n][0], acc[ai][bj][m][n][1]), pack2(acc[ai][bj][m][n][2], acc[ai][bj][m][n][3]));
            } else {
#pragma unroll
              for (int j = 0; j < 4; ++j) p.mvt()[(unsigned)((((l * 4 + hd) * 4 + (row >> 6)) * 64 + e + j) * 64 + vperm(row & 63))] = f2bf(acc[ai][bj][m][n][j]);
            }
          }
        }
  }
};

struct EpiQ {
  static constexpr bool AFTER_DRAIN = false;
  Params p;
  __device__ __forceinline__ void operator()(AccRef acc, const pg8::Unit& u, int wr, int wc, int fr_, int fq_) const {
    const int lane_ = tid_of(wr * 4 + wc) & 63, fr = lane_ & 15, fq = lane_ >> 4;
    const float qs = 0.07216878364870322f * 1.4426950408889634f;
    const int rowb = u.pm * 256 + wr * 64 + fr;
#pragma unroll
    for (int ai = 0; ai < 2; ++ai)
#pragma unroll
      for (int m = 0; m < 4; ++m) {
        const int row = rowb + ai * 128 + m * 16;
        const float rs = rsqrtf(p.ssq()[row] * (1.f / 512.f) + 1e-6f) * qs;
#pragma unroll
        for (int bj = 0; bj < 2; ++bj) {
          const int cs = u.pn * 256 + bj * 128 + wc * 32;
          if (cs >= 1152) continue;
          const int hd = cs / 192, o = cs % 192;
          u16* qp = p.q() + ((size_t)hd * SEQ + row) * 192;
          if (o < 128) {
#pragma unroll
            for (int n = 0; n < 2; ++n) {
              f32x4 v = acc[ai][bj][m][n] * rs;
              *(uint2*)(qp + o + n * 16 + fq * 4) = make_uint2(pack2(v[0], v[1]), pack2(v[2], v[3]));
            }
          } else {
            const int i0 = ((cs >> 5) & 1) * 16 + fq * 4;
            float4 cs4 = *(const float4*)(p.cosT() + (size_t)row * 32 + i0);
            float4 sn = *(const float4*)(p.sinT() + (size_t)row * 32 + i0);
            f32x4 x1 = acc[ai][bj][m][0] * rs, x2 = acc[ai][bj][m][1] * rs;
            float a0 = x1[0] * cs4.x - x2[0] * sn.x, a1 = x1[1] * cs4.y - x2[1] * sn.y, a2 = x1[2] * cs4.z - x2[2] * sn.z, a3 = x1[3] * cs4.w - x2[3] * sn.w;
            float b0 = x1[0] * sn.x + x2[0] * cs4.x, b1 = x1[1] * sn.y + x2[1] * cs4.y, b2 = x1[2] * sn.z + x2[2] * cs4.z, b3 = x1[3] * sn.w + x2[3] * cs4.w;
            *(uint2*)(qp + 128 + i0) = make_uint2(pack2(a0, a1), pack2(a2, a3));
            *(uint2*)(qp + 160 + i0) = make_uint2(pack2(b0, b1), pack2(b2, b3));
          }
        }
      }
  }
};

struct EpiKV {
  static constexpr bool AFTER_DRAIN = false;
  Params p;
  __device__ __forceinline__ void operator()(AccRef acc, const pg8::Unit& u, int wr, int wc, int fr_, int fq_) const {
    const int lane_ = tid_of(wr * 4 + wc) & 63, fr = lane_ & 15, fq = lane_ >> 4;
    const int rowb = u.pm * 256 + wr * 64 + fr, hd = u.pn;
#pragma unroll
    for (int ai = 0; ai < 2; ++ai)
#pragma unroll
      for (int m = 0; m < 4; ++m) {
        const int row = rowb + ai * 128 + m * 16;
        const float rs = rsqrtf(p.ssq()[SEQ + row] * (1.f / 256.f) + 1e-6f);
        u16* kp = p.k() + ((size_t)hd * SEQ + row) * 192 + wc * 32;
#pragma unroll
        for (int n = 0; n < 2; ++n) {
          f32x4 v = acc[ai][0][m][n] * rs;
          *(uint2*)(kp + n * 16 + fq * 4) = make_uint2(pack2(v[0], v[1]), pack2(v[2], v[3]));
        }
#pragma unroll
        for (int n = 0; n < 2; ++n)
#pragma unroll
          for (int j = 0; j < 4; ++j)
            (p.vt() + (size_t)hd * 128 * SEQ)[(unsigned)((row >> 6) * 8192 + vperm(row & 63) + (wc * 32 + n * 16 + fq * 4 + j) * 64)] = f2bf(acc[ai][1][m][n][j] * rs);
      }
  }
};

struct EpiD {
  static constexpr bool AFTER_DRAIN = false;
  Params p; int l;
  __device__ __forceinline__ void operator()(AccRef acc, const pg8::Unit& u, int wr, int wc, int fr_, int fq_) const {
    const int lane_ = tid_of(wr * 4 + wc) & 63, fr = lane_ & 15, fq = lane_ >> 4;
    const float alpha = 1.681792830507429f;
    const float* xres = (l == 0) ? p.x : p.out;
    const int rowb = u.pm * 256 + wr * 64 + fr;
#pragma unroll
    for (int ai = 0; ai < 2; ++ai)
#pragma unroll
      for (int m = 0; m < 4; ++m) {
        const int row = rowb + ai * 128 + m * 16;
#pragma unroll
        for (int bj = 0; bj < 2; ++bj)
#pragma unroll
          for (int n = 0; n < 2; ++n) {
            const size_t off = (size_t)row * DM + u.pn * 256 + bj * 128 + wc * 32 + n * 16 + fq * 4;
            float4 xr = *(const float4*)(xres + off);
            f32x4 a = acc[ai][bj][m][n];
            *(float4*)(p.out + off) = make_float4(alpha * xr.x + a[0], alpha * xr.y + a[1], alpha * xr.z + a[2], alpha * xr.w + a[3]);
          }
      }
  }
};

struct EpiDF {
  static constexpr bool PERM = false, AFTER_DRAIN = true;
  Params p; int l; char* sm;
  __device__ __forceinline__ void operator()(AccRef, const pg8::Unit&, int, int, int, int) const {}
  __device__ __forceinline__ void fused(f32x4 (&z)[2][2][4][2], const pg8::Unit& u, int wr, int wc) const {
    typedef unsigned long long u64;
    const int wv = wr * 4 + wc, tid = tid_of(wv), lane = tid & 63, fr = lane & 15, fq = lane >> 4;
    const float alpha = 1.681792830507429f;
    const float* xres = (l == 0) ? p.x : p.out;
    float* P = (float*)(sm + GEMM_LDS);
    float* S = P + 2048;
    const int rlb = wr * 64 + fr, colb = u.pn * 256 + wc * 32 + fq * 4;
    for (size_t c = (size_t)blockIdx.x * NT + tid; c < (size_t)2 * SEQ; c += (size_t)gridDim.x * NT) p.ssq()[c] = 0.f;
#pragma unroll
    for (int ai = 0; ai < 2; ++ai) {
      float4 xr[4][2][2];
#pragma unroll
      for (int m = 0; m < 4; ++m)
#pragma unroll
        for (int bj = 0; bj < 2; ++bj)
#pragma unroll
          for (int n = 0; n < 2; ++n)
            xr[m][bj][n] = *(const float4*)(xres + (size_t)(u.pm * 256 + rlb + ai * 128 + m * 16) * DM + colb + bj * 128 + n * 16);
#pragma unroll
      for (int m = 0; m < 4; ++m) {
        float s1 = 0.f, s2 = 0.f;
#pragma unroll
        for (int bj = 0; bj < 2; ++bj)
#pragma unroll
          for (int n = 0; n < 2; ++n) {
            const float4 x4 = xr[m][bj][n];
            f32x4 v = z[ai][bj][m][n];
            v[0] = alpha * x4.x + v[0]; v[1] = alpha * x4.y + v[1]; v[2] = alpha * x4.z + v[2]; v[3] = alpha * x4.w + v[3];
            z[ai][bj][m][n] = v;
            s1 += (v[0] + v[1]) + (v[2] + v[3]);
            s2 += (v[0] * v[0] + v[1] * v[1]) + (v[2] * v[2] + v[3] * v[3]);
          }
        s1 = xsum32(xsum16(s1)); s2 = xsum32(xsum16(s2));
        if (fq == 0) { float* pp = P + ((rlb + ai * 128 + m * 16) * 4 + wc) * 2; pp[0] = s1; pp[1] = s2; }
      }
    }
    __syncthreads();
    u64* X = p.lnx() + (size_t)(u.pm * 8) * 256;
    if (tid < 256) {
      const float4 a = *(const float4*)(P + tid * 8), b = *(const float4*)(P + tid * 8 + 4);
      const float s1 = (a.x + a.z) + (b.x + b.z), s2 = (a.y + a.w) + (b.y + b.w);
      __hip_atomic_store(X + u.pn * 256 + tid, ((u64)__float_as_uint(s2) << 32) | __float_as_uint(s1), __ATOMIC_RELAXED, __HIP_MEMORY_SCOPE_AGENT);
    }
    asm volatile("s_waitcnt vmcnt(0)" ::: "memory");
    __syncthreads();
    if (tid == 0) {
      unsigned* cnt = p.ctr() + 1024 + l * 32 + u.pm;
      __hip_atomic_fetch_add(cnt, 1u, __ATOMIC_RELAXED, __HIP_MEMORY_SCOPE_AGENT);
      unsigned sp = 0;
      while (__hip_atomic_load(cnt, __ATOMIC_RELAXED, __HIP_MEMORY_SCOPE_AGENT) < 8u) { __builtin_amdgcn_s_sleep(2); if (++sp > (1u << 24)) break; }
    }
    __syncthreads();
    if (tid < 256) {
      float s1 = 0.f, s2 = 0.f;
#pragma unroll
      for (int j = 0; j < 8; ++j) {
        const u64 w = __hip_atomic_load(X + j * 256 + tid, __ATOMIC_RELAXED, __HIP_MEMORY_SCOPE_AGENT);
        s1 += __uint_as_float((unsigned)w); s2 += __uint_as_float((unsigned)(w >> 32));
      }
      const float mu = s1 * (1.f / DM);
      const float var = fmaxf(s2 * (1.f / DM) - mu * mu, 0.f);
      S[tid * 2] = mu; S[tid * 2 + 1] = rsqrtf(var + 1e-5f);
    }
    __syncthreads();
    const float* lg = p.ln_g + (size_t)l * DM;
    const float* lb = p.ln_b + (size_t)l * DM;
#pragma unroll
    for (int bj = 0; bj < 2; ++bj)
#pragma unroll
      for (int n = 0; n < 2; ++n) {
        const int col = colb + bj * 128 + n * 16;
        const float4 gg = *(const float4*)(lg + col), bb = *(const float4*)(lb + col);
#pragma unroll
        for (int ai = 0; ai < 2; ++ai)
#pragma unroll
          for (int m = 0; m < 4; ++m) {
            const int rl = rlb + ai * 128 + m * 16;
            const float mu = S[rl * 2], rs = S[rl * 2 + 1];
            const f32x4 v = z[ai][bj][m][n];
            const float r0 = (v[0] - mu) * rs * gg.x + bb.x, r1 = (v[1] - mu) * rs * gg.y + bb.y;
            const float r2 = (v[2] - mu) * rs * gg.z + bb.z, r3 = (v[3] - mu) * rs * gg.w + bb.w;
            const size_t off = (size_t)(u.pm * 256 + rl) * DM + col;
            *(float4*)(p.out + off) = make_float4(r0, r1, r2, r3);
            *(uint2*)(p.xb() + off) = make_uint2(pack2(r0, r1), pack2(r2, r3));
          }
      }
  }
};

__device__ void phaseE(const Params& p, int l, int wv) {
  const int tid = tid_of(wv);
  const int lane = tid & 63;
  const int gw = blockIdx.x * (NT / 64) + (tid >> 6), nw = gridDim.x * (NT / 64);
  for (size_t c = (size_t)blockIdx.x * NT + tid; c < (size_t)2 * SEQ; c += (size_t)gridDim.x * NT) p.ssq()[c] = 0.f;
  const float* g = p.ln_g + (size_t)l * DM;
  const float* b = p.ln_b + (size_t)l * DM;
  for (int row = gw; row < SEQ; row += nw) {
    float* zr = p.out + (size_t)row * DM;
    float4 v[8];
    float s = 0.f;
#pragma unroll
    for (int i = 0; i < 8; ++i) { v[i] = *(const float4*)(zr + (i * 64 + lane) * 4); s += v[i].x + v[i].y + v[i].z + v[i].w; }
#pragma unroll
    for (int o = 1; o < 16; o <<= 1) s += shx(s, lane, o);
    s = xsum16(s); s = xsum32(s);
    const float mu = s * (1.f / DM);
    float q = 0.f;
#pragma unroll
    for (int i = 0; i < 8; ++i) {
      v[i].x -= mu; v[i].y -= mu; v[i].z -= mu; v[i].w -= mu;
      q += v[i].x * v[i].x + v[i].y * v[i].y + v[i].z * v[i].z + v[i].w * v[i].w;
    }
#pragma unroll
    for (int o = 1; o < 16; o <<= 1) q += shx(q, lane, o);
    q = xsum16(q); q = xsum32(q);
    const float rstd = rsqrtf(q * (1.f / DM) + 1e-5f);
#pragma unroll
    for (int i = 0; i < 8; ++i) {
      const int c = (i * 64 + lane) * 4;
      float4 gg = *(const float4*)(g + c), bb = *(const float4*)(b + c);
      float4 r = make_float4(v[i].x * rstd * gg.x + bb.x, v[i].y * rstd * gg.y + bb.y, v[i].z * rstd * gg.z + bb.z, v[i].w * rstd * gg.w + bb.w);
      *(float4*)(zr + c) = r;
      *(uint2*)(p.xb() + (size_t)row * DM + c) = make_uint2(pack2(r.x, r.y), pack2(r.z, r.w));
    }
  }
}

template <int DK, int DV, int MODE, int QSN>
__device__ void attn_item(const u16* __restrict__ Qp, int ldq, const u16* __restrict__ Kp, int ldk, const u16* __restrict__ Vt, int ldv,
                          int t_first, int t_last, int t_diag, float zscale, int q0, const u16* __restrict__ gate, u16* __restrict__ outp,
                          char* smem, int wv, int nseg = 1, int seg = 0, float* part = nullptr, unsigned* cnt = nullptr, const u16* __restrict__ Kr = nullptr) {
  constexpr int VST = 72, KCH = DK / 8;
  constexpr int NKR = (64 * KCH) / NT, NVR = (DV * 8) / NT, NST = DK / 32, NDS = DV / 16;
  u16* Ks = (u16*)smem;
  u16* Vs = Ks + 64 * DK;
  const int tid = tid_of(wv);
  asm volatile("" : "+s"(t_last));
  const int w = wv, lane = tid & 63, fr = lane & 15, fq = lane >> 4;

  const int fqs = (fq ^ ((fr >> 3) << 1)) * 16;
  constexpr int NSR = NST;
  bf16x8 qf[2][NSR];
  bf16x8* Qr = (bf16x8*)(smem + MLA_QR_OFF) + (w * 4) * 64 + lane;
#pragma unroll
  for (int qs = 0; qs < QSN; ++qs)
#pragma unroll
    for (int st = 0; st < NST; ++st) {
      bf16x8 v = *(const bf16x8*)(Qp + (unsigned)((w * (16 * QSN) + qs * 16 + fr) * ldq + st * 32 + fq * 8));
      if (st < NSR) qf[qs][st < NSR ? st : 0] = v;
      else Qr[(qs * 2 + (st - NSR)) * 64] = v;
    }

  f32x4 o[NDS][2];
#pragma unroll
  for (int ds = 0; ds < NDS; ++ds) { o[ds][0] = f32x4{0.f, 0.f, 0.f, 0.f}; o[ds][1] = f32x4{0.f, 0.f, 0.f, 0.f}; }
  float mrow[2] = {-1e30f, -1e30f};
  float lrow[2] = {0.f, 0.f};

  uint4 kk0, kk1, kk2, kk3, kk4, kk5, vv0, vv1, vv2, vv3;
#define KLOAD(i, T) if constexpr (NKR > i) { const int c_ = tid + NT * i, row_ = c_ / KCH, cc_ = c_ % KCH; kk##i = *(const uint4*)((Kp + (size_t)(T) * 64 * ldk) + (unsigned)(row_ * ldk + cc_ * 8)); }
#define KSTORE(i) if constexpr (NKR > i) { const int c_ = tid + NT * i, row_ = c_ / KCH, cc_ = c_ % KCH; \
    *(uint4*)((char*)Ks + (cc_ >> 2) * 4096 + row_ * 64 + (((cc_ & 3) ^ (((row_ >> 3) & 1) << 1)) * 16)) = kk##i; }
#define VLOAD(i, T) if constexpr (NVR > i) { const int c_ = tid + NT * i, dv_ = c_ >> 3, cc_ = c_ & 7; vv##i = *(const uint4*)((Vt + (size_t)(T) * (DV * 64)) + (unsigned)(dv_ * 64 + cc_ * 8)); }
#define VSTORE(i) if constexpr (NVR > i) { const int c_ = tid + NT * i, dv_ = c_ >> 3, cc_ = c_ & 7; *(uint4*)(Vs + dv_ * VST + cc_ * 8) = vv##i; }
#define load_k(T) do { KLOAD(0, T) KLOAD(1, T) KLOAD(2, T) KLOAD(3, T) KLOAD(4, T) KLOAD(5, T) } while (0)
#define load_v(T) do { VLOAD(0, T) VLOAD(1, T) VLOAD(2, T) VLOAD(3, T) } while (0)
#define store_tile() do { KSTORE(0) KSTORE(1) KSTORE(2) KSTORE(3) KSTORE(4) KSTORE(5) VSTORE(0) VSTORE(1) VSTORE(2) VSTORE(3) } while (0)

#define MLA_ISSUE(T, B) do { char* kb_ = smem + (B) * MLA_STAGE; \
    _Pragma("unroll") for (int i_ = 0; i_ < 3; ++i_) { const int P_ = tid + NT * i_, st_ = P_ >> 8, r_ = (P_ >> 2) & 63, q_ = (P_ & 3) ^ (((r_ >> 3) & 1) << 1); \
      const u16* src_ = (i_ < 2) ? ((Kp + (size_t)(T) * 64 * ldk) + (unsigned)(r_ * ldk + (st_ * 4 + q_) * 8)) \
                                 : ((Kr + (size_t)(T) * 64 * 64) + (unsigned)(r_ * 64 + ((st_ - 4) * 4 + q_) * 8));     \
      __builtin_amdgcn_global_load_lds((const unsigned*)src_, (LAS unsigned*)(kb_ + P_ * 16), 16, 0, 0); } \
    _Pragma("unroll") for (int i_ = 0; i_ < 2; ++i_) { const int P_ = tid + NT * i_, dv_ = P_ >> 3, c_ = (P_ & 7) ^ ((dv_ >> 1) & 7); \
      __builtin_amdgcn_global_load_lds((const unsigned*)((Vt + (size_t)(T) * 8192) + (unsigned)(dv_ * 64 + c_ * 8)), (LAS unsigned*)(kb_ + 24576 + P_ * 16), 16, 0, 0); } } while (0)

  volatile int* flg = (volatile int*)(smem + CTL_OFF) + 8;
  if (MODE == 2 && tid == 0) flg[0] = 0;
  int it = 0;
  int t = (MODE == 2) ? t_last : t_first;
  int buf = 0;
  if constexpr (MODE == 0) {
    MLA_ISSUE(t, 0);
    if (t < t_last) MLA_ISSUE(t + 1, 1);
  } else {
    load_k(t);
    load_v(t);
  }
  while (true) {
    const int tn = (MODE == 2) ? t - 1 : t + 1;
    const bool more = (MODE == 2) ? (t > 0) : (t < t_last);
    if constexpr (MODE == 0) {
      if (more) asm volatile("s_waitcnt vmcnt(5)" ::: "memory"); else asm volatile("s_waitcnt vmcnt(0)" ::: "memory");
      __builtin_amdgcn_s_barrier();
      asm volatile("" ::: "memory");
      if (t + 2 <= t_last) MLA_ISSUE(t + 2, buf == 0 ? 2 : buf - 1);
    } else {
      store_tile();
      __syncthreads();
      if (MODE == 2 && tid == 0) flg[(it & 1) ^ 1] = 0;
      if (MODE != 2 && more) { load_k(tn); load_v(tn); }
    }
    const char* Kc = (MODE == 0) ? (const char*)(smem + buf * MLA_STAGE) : (const char*)Ks;
    bool active = true;
    if (MODE == 0) active = (t <= t_diag + (w >> 1));
    if (MODE == 2) active = (t <= t_diag + (w >> 2));
    if (MODE != 2 && active) {
      f32x4 s[4][2];
#pragma unroll
      for (int ks = 0; ks < 4; ++ks) { s[ks][0] = f32x4{0.f, 0.f, 0.f, 0.f}; s[ks][1] = f32x4{0.f, 0.f, 0.f, 0.f}; }
#pragma unroll
      for (int st = 0; st < NST; ++st) {
#pragma unroll
        for (int ks = 0; ks < 4; ++ks) {
          bf16x8 kf = *(const bf16x8*)(Kc + st * 4096 + (ks * 16 + fr) * 64 + fqs);
          if (st < NSR) {
            s[ks][0] = mfma16(kf, qf[0][st < NSR ? st : 0], s[ks][0]);
            s[ks][1] = mfma16(kf, qf[1][st < NSR ? st : 0], s[ks][1]);
          } else {
            s[ks][0] = mfma16(kf, Qr[(st - NSR) * 64], s[ks][0]);
            s[ks][1] = mfma16(kf, Qr[(2 + st - NSR) * 64], s[ks][1]);
          }
        }
      }
      {
#pragma unroll
        for (int qs = 0; qs < 2; ++qs) {
          float mx = -1e30f;
#pragma unroll
          for (int ks = 0; ks < 4; ++ks)
#pragma unroll
            for (int j = 0; j < 4; ++j) mx = fmaxf(mx, s[ks][qs][j]);
          mx *= zscale;
          mx = xmax16(mx);
          mx = xmax32(mx);
          const bool bump = __builtin_amdgcn_ballot_w64(mx > mrow[qs] + 8.0f) != 0ull;
          float ls = 0.f;
          if (bump) {
            const float mn = fmaxf(mrow[qs], mx);
            const float alpha = __builtin_amdgcn_exp2f(mrow[qs] - mn);
            mrow[qs] = mn;
            lrow[qs] *= alpha;
#pragma unroll
            for (int ds = 0; ds < NDS; ++ds) o[ds][qs] *= alpha;
          }
          const float mref = mrow[qs];
#pragma unroll
          for (int ks = 0; ks < 4; ++ks)
#pragma unroll
            for (int j = 0; j < 4; ++j) {
              float pv = __builtin_amdgcn_exp2f(s[ks][qs][j] * zscale - mref);
              ls += pv;
              s[ks][qs][j] = pv;
            }
          lrow[qs] += ls;
        }
      }
      bf16x8 pf[2][2];
#pragma unroll
      for (int qs = 0; qs < 2; ++qs)
#pragma unroll
        for (int u = 0; u < 2; ++u) {
          uint4 pk;
          pk.x = pack2(s[2 * u][qs][0], s[2 * u][qs][1]);
          pk.y = pack2(s[2 * u][qs][2], s[2 * u][qs][3]);
          pk.z = pack2(s[2 * u + 1][qs][0], s[2 * u + 1][qs][1]);
          pk.w = pack2(s[2 * u + 1][qs][2], s[2 * u + 1][qs][3]);
          pf[qs][u] = *(bf16x8*)&pk;
        }
#pragma unroll
      for (int u = 0; u < 2; ++u) {
        bf16x8 vfr[NDS];
#pragma unroll
        for (int ds = 0; ds < NDS; ++ds) {
          if constexpr (MODE == 0) vfr[ds] = *(const bf16x8*)(Kc + 24576 + (ds * 16 + fr) * 128 + (((u * 4 + fq) ^ ((fr >> 1) & 7)) * 16));
          else vfr[ds] = *(const bf16x8*)(Vs + (ds * 16 + fr) * VST + u * 32 + fq * 8);
        }
#pragma unroll
        for (int ds = 0; ds < NDS; ++ds) {
          o[ds][0] = mfma16(vfr[ds], pf[0][u], o[ds][0]);
          o[ds][1] = mfma16(vfr[ds], pf[1][u], o[ds][1]);
        }
      }
    }
    if (MODE == 2 && active) {
#pragma unroll
      for (int qs = 0; qs < QSN; ++qs) {
        f32x4 s1[4];
#pragma unroll
        for (int ks = 0; ks < 4; ++ks) s1[ks] = f32x4{0.f, 0.f, 0.f, 0.f};
#pragma unroll
        for (int st = 0; st < NST; ++st) {
#pragma unroll
          for (int ks = 0; ks < 4; ++ks) {
            bf16x8 kf = *(const bf16x8*)(Kc + st * 4096 + (ks * 16 + fr) * 64 + fqs);
            s1[ks] = mfma16(kf, qf[qs][st], s1[ks]);
          }
        }
        const int tq = q0 + w * (16 * QSN) + qs * 16 + fr;
        float running = lrow[qs];
#pragma unroll
        for (int ks = 3; ks >= 0; --ks) {
          float l1[4], lb[4];
#pragma unroll
          for (int j = 0; j < 4; ++j) {
            const float z = s1[ks][j] * zscale;
            const float e = __expf(-fabsf(z));
            const float sp = fmaxf(z, 0.f) + __logf(1.f + e);
            const int key = t * 64 + ks * 16 + fq * 4 + j;
            l1[j] = (key < tq) ? -sp : 0.f;
            lb[j] = z - sp;
          }
          const float p4 = (l1[0] + l1[1]) + (l1[2] + l1[3]);
          const float x16 = shx(p4, lane, 16);
          const float a2 = p4 + x16;
          const float x32 = shx(a2, lane, 32);
          const float tot = a2 + x32;
          const float gt = ((fq & 1) == 0 ? x16 : 0.f) + ((fq & 2) == 0 ? x32 : 0.f);
          const float s3 = running + gt;
          const float s2 = s3 + l1[3];
          const float s1_ = s2 + l1[2];
          const float s0 = s1_ + l1[1];
          s1[ks][0] = (l1[0] < 0.f) ? __expf(lb[0] + s0) : 0.f;
          s1[ks][1] = (l1[1] < 0.f) ? __expf(lb[1] + s1_) : 0.f;
          s1[ks][2] = (l1[2] < 0.f) ? __expf(lb[2] + s2) : 0.f;
          s1[ks][3] = (l1[3] < 0.f) ? __expf(lb[3] + s3) : 0.f;
          running += tot;
        }
        lrow[qs] = running;
        asm volatile("" ::: "memory");
#pragma unroll
        for (int u = 0; u < 2; ++u) {
          uint4 pk;
          pk.x = pack2(s1[2 * u][0], s1[2 * u][1]);
          pk.y = pack2(s1[2 * u][2], s1[2 * u][3]);
          pk.z = pack2(s1[2 * u + 1][0], s1[2 * u + 1][1]);
          pk.w = pack2(s1[2 * u + 1][2], s1[2 * u + 1][3]);
          bf16x8 pf1 = *(bf16x8*)&pk;
          bf16x8 vfr[NDS];
#pragma unroll
          for (int ds = 0; ds < NDS; ++ds) vfr[ds] = *(const bf16x8*)(Vs + (ds * 16 + fr) * VST + u * 32 + fq * 8);
#pragma unroll
          for (int ds = 0; ds < NDS; ++ds) o[ds][qs] = mfma16(vfr[ds], pf1, o[ds][qs]);
        }
        asm volatile("" ::: "memory");
        __builtin_amdgcn_sched_barrier(0);
      }
    }
    if (MODE == 2) {
      __builtin_amdgcn_sched_barrier(0);
      if (more) { load_k(tn); load_v(tn); }
      const int cont = (more && (lrow[0] >= -104.f || (QSN > 1 && lrow[1] >= -104.f))) ? 1 : 0;
      if (lane == 0 && __builtin_amdgcn_ballot_w64(cont != 0) != 0ull) flg[it & 1] = 1;
      __syncthreads();
      if (!flg[it & 1]) break;
      ++it;
    } else if (MODE == 1) {
      __syncthreads();
      if (!more) break;
    } else {
      if (!more) break;
      buf = (buf == 2) ? 0 : buf + 1;
    }
    t = tn;
  }
  if (MODE == 0 && nseg > 1) {
    typedef unsigned long long u64;
    volatile int* ctlw = (volatile int*)(smem + CTL_OFF);
    {
      u64* po = (u64*)(part + (size_t)seg * (6 * (PART_BYTES / 4))) + (size_t)(w * 34) * 64 + lane;
#pragma unroll
      for (int ds = 0; ds < NDS; ++ds)
#pragma unroll
        for (int qs = 0; qs < 2; ++qs) {
          const f32x4 v = o[ds][qs];
          const u64 lo = ((u64)__float_as_uint(v[1]) << 32) | __float_as_uint(v[0]), hi = ((u64)__float_as_uint(v[3]) << 32) | __float_as_uint(v[2]);
          __hip_atomic_store(po + ((ds * 2 + qs) * 2 + 0) * 64, lo, __ATOMIC_RELAXED, __HIP_MEMORY_SCOPE_AGENT);
          __hip_atomic_store(po + ((ds * 2 + qs) * 2 + 1) * 64, hi, __ATOMIC_RELAXED, __HIP_MEMORY_SCOPE_AGENT);
        }
      __hip_atomic_store(po + 32 * 64, ((u64)__float_as_uint(mrow[1]) << 32) | __float_as_uint(mrow[0]), __ATOMIC_RELAXED, __HIP_MEMORY_SCOPE_AGENT);
      __hip_atomic_store(po + 33 * 64, ((u64)__float_as_uint(lrow[1]) << 32) | __float_as_uint(lrow[0]), __ATOMIC_RELAXED, __HIP_MEMORY_SCOPE_AGENT);
    }
    asm volatile("s_waitcnt vmcnt(0)" ::: "memory");
    __syncthreads();
    if (tid == 0) ctlw[1] = (int)atomicAdd(cnt, 1u);
    __syncthreads();
    const int rank = __builtin_amdgcn_readfirstlane(ctlw[1]);
    if (rank != nseg - 1) return;
    for (int s2 = 0; s2 < nseg; ++s2) {
      if (s2 == seg) continue;
      u64* po = (u64*)(part + (size_t)s2 * (6 * (PART_BYTES / 4))) + (size_t)(w * 34) * 64 + lane;
      const u64 m2p = __hip_atomic_load(po + 32 * 64, __ATOMIC_RELAXED, __HIP_MEMORY_SCOPE_AGENT);
      const u64 l2p = __hip_atomic_load(po + 33 * 64, __ATOMIC_RELAXED, __HIP_MEMORY_SCOPE_AGENT);
#pragma unroll
      for (int qs = 0; qs < 2; ++qs) {
        const float m2 = __uint_as_float((unsigned)(m2p >> (32 * qs))), l2 = __uint_as_float((unsigned)(l2p >> (32 * qs)));
        const float mn = fmaxf(mrow[qs], m2);
        const float ca = __builtin_amdgcn_exp2f(mrow[qs] - mn), cb = __builtin_amdgcn_exp2f(m2 - mn);
        mrow[qs] = mn;
        lrow[qs] = lrow[qs] * ca + l2 * cb;
        u64 plo[NDS], phi[NDS];
#pragma unroll
        for (int ds = 0; ds < NDS; ++ds) {
          plo[ds] = __hip_atomic_load(po + ((ds * 2 + qs) * 2 + 0) * 64, __ATOMIC_RELAXED, __HIP_MEMORY_SCOPE_AGENT);
          phi[ds] = __hip_atomic_load(po + ((ds * 2 + qs) * 2 + 1) * 64, __ATOMIC_RELAXED, __HIP_MEMORY_SCOPE_AGENT);
        }
#pragma unroll
        for (int ds = 0; ds < NDS; ++ds) {
          f32x4 o2;
          o2[0] = __uint_as_float((unsigned)plo[ds]); o2[1] = __uint_as_float((unsigned)(plo[ds] >> 32));
          o2[2] = __uint_as_float((unsigned)phi[ds]); o2[3] = __uint_as_float((unsigned)(phi[ds] >> 32));
          o[ds][qs] = o[ds][qs] * ca + o2 * cb;
        }
      }
    }
  }
  int fr_e = fr, fq_e = fq;
  asm volatile("" : "+v"(fr_e), "+v"(fq_e));
#pragma unroll
  for (int qs = 0; qs < QSN; ++qs) {
    float inv = 1.f;
    if (MODE != 2) {
      float lsum = lrow[qs];
      lsum = xsum16(lsum);
      lsum = xsum32(lsum);
      inv = 1.f / lsum;
    }
    const int row = w * (16 * QSN) + qs * 16 + fr_e;
#pragma unroll
    for (int ds = 0; ds < NDS; ++ds) {
      const int dv = ds * 16 + fq_e * 4;
      uint2 g2 = *(const uint2*)(gate + (unsigned)(row * DIN + dv));
      float v0 = o[ds][qs][0] * inv * bflo(g2.x), v1 = o[ds][qs][1] * inv * bfhi(g2.x);
      float v2 = o[ds][qs][2] * inv * bflo(g2.y), v3 = o[ds][qs][3] * inv * bfhi(g2.y);
      *(uint2*)(outp + (unsigned)(row * DM + dv)) = make_uint2(pack2(v0, v1), pack2(v2, v3));
    }
  }
}

#undef KLOAD
#undef KSTORE
#undef VLOAD
#undef VSTORE
#undef load_k
#undef load_v
#undef store_tile

#undef KLOAD
#undef KSTORE
#undef VLOAD
#undef VSTORE
#undef load_k
#undef load_v
#undef store_tile
#undef MLA_ISSUE

__device__ void gmlp_item(const Params& p, int l, int n, int g, char* smem, int wv) {
  constexpr int WST = 136;
  u16* Ws = (u16*)smem;
  u16* Bs = Ws + 128 * WST;
  float* s_mu = (float*)(Bs + 128 * WST);
  float* s_rs = s_mu + 128;
  const int tid = tid_of(wv);
  const int w = wv, lane = tid & 63, fr = lane & 15, fq = lane >> 4;
  const int row0 = n * 128;
  {
    const int r = tid >> 2, qt = tid & 3;
    const u16* src = p.h() + (size_t)(row0 + r) * DIN + C_SGV + qt * 128;
    uint4 v[16];
#pragma unroll
    for (int i = 0; i < 16; ++i) v[i] = *(const uint4*)(src + i * 8);
    float s = 0.f, q = 0.f;
#pragma unroll
    for (int i = 0; i < 16; ++i) {
      const unsigned ww[4] = {v[i].x, v[i].y, v[i].z, v[i].w};
#pragma unroll
      for (int k = 0; k < 4; ++k) { float a = bflo(ww[k]), b = bfhi(ww[k]); s += a + b; q += a * a + b * b; }
    }
    s += shx(s, lane, 1); q += shx(q, lane, 1);
    s += shx(s, lane, 2); q += shx(q, lane, 2);
    const float mu = s * (1.f / 512.f);
    const float var = fmaxf(q * (1.f / 512.f) - mu * mu, 0.f);
    if (qt == 0) { s_mu[r] = mu; s_rs[r] = rsqrtf(var + 1e-5f); }
  }
  {
    const float* wsrc = p.sg_w + (size_t)(l * 4 + g) * 128 * 128;
    float4 wv4[8];
#pragma unroll
    for (int i = 0; i < 8; ++i) { int id = tid + NT * i; wv4[i] = *(const float4*)(wsrc + (id >> 5) * 128 + (id & 31) * 4); }
#pragma unroll
    for (int i = 0; i < 8; ++i) {
      int id = tid + NT * i, tt = id >> 5, s4 = (id & 31) * 4;
      float4 v = wv4[i];
      if (tt < 64 && s4 >= 64) v = make_float4(0.f, 0.f, 0.f, 0.f);
      *(uint2*)(Ws + tt * WST + s4) = make_uint2(pack2(v.x, v.y), pack2(v.z, v.w));
    }
  }
  const int bs_ = tid >> 2, bc_ = (tid & 3) * 32;
  uint4 bch[4];
#pragma unroll
  for (int i = 0; i < 4; ++i) bch[i] = *(const uint4*)(p.h() + (size_t)(row0 + bs_) * DIN + C_SGV + g * 128 + bc_ + i * 8);
  float4 lgv[8], lbv[8];
#pragma unroll
  for (int i = 0; i < 8; ++i) { lgv[i] = *(const float4*)(p.sg_ln_g + (size_t)l * 512 + g * 128 + bc_ + i * 4); lbv[i] = *(const float4*)(p.sg_ln_b + (size_t)l * 512 + g * 128 + bc_ + i * 4); }
  const int tt_e = w * 16 + fr;
  const float bias_e = p.sg_b[(size_t)(l * 4 + g) * 128 + tt_e];
  uint2 u2e[8], g2e[8];
#pragma unroll
  for (int ns = 0; ns < 8; ++ns) {
    const u16* hr = p.h() + (size_t)(row0 + tt_e) * DIN + g * 128 + ns * 16 + fq * 4;
    u2e[ns] = *(const uint2*)(hr + C_SGU); g2e[ns] = *(const uint2*)(hr + C_GB);
  }
  __syncthreads();
  {
    const float mu = s_mu[bs_], rs = s_rs[bs_];
#pragma unroll
    for (int i = 0; i < 4; ++i) {
      const int c0 = bc_ + i * 8;
      const float4 g0 = lgv[2 * i], g1 = lgv[2 * i + 1], b0 = lbv[2 * i], b1 = lbv[2 * i + 1];
      const unsigned ww[4] = {bch[i].x, bch[i].y, bch[i].z, bch[i].w};
      const float gg[8] = {g0.x, g0.y, g0.z, g0.w, g1.x, g1.y, g1.z, g1.w}, bb[8] = {b0.x, b0.y, b0.z, b0.w, b1.x, b1.y, b1.z, b1.w};
#pragma unroll
      for (int k = 0; k < 4; ++k) {
        const float v0 = (bflo(ww[k]) - mu) * rs * gg[2 * k] + bb[2 * k], v1 = (bfhi(ww[k]) - mu) * rs * gg[2 * k + 1] + bb[2 * k + 1];
        const unsigned pk = pack2(v0, v1);
        Bs[(c0 + 2 * k) * WST + bs_] = (u16)(pk & 0xffffu);
        Bs[(c0 + 2 * k + 1) * WST + bs_] = (u16)(pk >> 16);
      }
    }
  }
  __syncthreads();
  f32x4 acc[8];
#pragma unroll
  for (int ns = 0; ns < 8; ++ns) acc[ns] = f32x4{0.f, 0.f, 0.f, 0.f};
#pragma unroll
  for (int st = 0; st < 4; ++st) {
    const bf16x8 wf = *(const bf16x8*)(Ws + (w * 16 + fr) * WST + st * 32 + fq * 8);
#pragma unroll
    for (int ns = 0; ns < 8; ++ns) {
      bf16x8 bfv = *(const bf16x8*)(Bs + (ns * 16 + fr) * WST + st * 32 + fq * 8);
      acc[ns] = mfma16(bfv, wf, acc[ns]);
    }
  }
  {
    const int tt = w * 16 + fr;
    const float bias = bias_e;
    const u16* hrow = p.h() + (size_t)(row0 + tt) * DIN;
#pragma unroll
    for (int ns = 0; ns < 8; ++ns) {
      const int c = g * 128 + ns * 16 + fq * 4;
      const uint2 u2 = u2e[ns], g2 = g2e[ns];
      float v0 = bflo(u2.x) * (acc[ns][0] + bias) * bflo(g2.x);
      float v1 = bfhi(u2.x) * (acc[ns][1] + bias) * bfhi(g2.x);
      float v2 = bflo(u2.y) * (acc[ns][2] + bias) * bflo(g2.y);
      float v3 = bfhi(u2.y) * (acc[ns][3] + bias) * bfhi(g2.y);
      *(uint2*)(p.yin() + (size_t)(row0 + tt) * DM + 768 + c) = make_uint2(pack2(v0, v1), pack2(v2, v3));
    }
  }
  __syncthreads();
}

__device__ const unsigned g_mla_items[288] = {
  0x7e0101fu, 0x7e0103fu, 0x7e0105fu, 0x7e0107fu, 0x7e0109fu, 0x7e010bfu, 0x4e00809u, 0x4e00829u, 0xff0111fu, 0xff0113fu, 0xff0115fu, 0xff0117fu,
  0xff0119fu, 0xff011bfu, 0x4e00849u, 0x4e00869u, 0x7e0080fu, 0x7e0082fu, 0x7e0084fu, 0x7e0086fu, 0x7e0088fu, 0x7e008afu, 0x4e00889u, 0x4e008a9u,
  0x7a0101eu, 0x7a0103eu, 0x7a0105eu, 0x7a0107eu, 0x7a0109eu, 0x7a010beu, 0x4a01012u, 0x9699112u, 0xf6f911eu, 0xf6f913eu, 0xf6f915eu, 0xf6f917eu,
  0xf6f919eu, 0xf6f91beu, 0x4a01032u, 0x9699132u, 0x760101du, 0x760103du, 0x760105du, 0x760107du, 0x760109du, 0x76010bdu, 0x4a01052u, 0x9699152u,
  0xeef111du, 0xeef113du, 0xeef115du, 0xeef117du, 0xeef119du, 0xeef11bdu, 0x4a01072u, 0x9699172u, 0x760080eu, 0x760082eu, 0x760084eu, 0x760086eu,
  0x760088eu, 0x76008aeu, 0x4a01092u, 0x9699192u, 0x720101cu, 0x720103cu, 0x720105cu, 0x720107cu, 0x720109cu, 0x72010bcu, 0x4a010b2u, 0x96991b2u,
  0xe6e911cu, 0xe6e913cu, 0xe6e915cu, 0xe6e917cu, 0xe6e919cu, 0xe6e91bcu, 0x4601011u, 0x8e91111u, 0x6e0101bu, 0x6e0103bu, 0x6e0105bu, 0x6e0107bu,
  0x6e0109bu, 0x6e010bbu, 0x4601031u, 0x8e91131u, 0xdee111bu, 0xdee113bu, 0xdee115bu, 0xdee117bu, 0xdee119bu, 0xdee11bbu, 0x4601051u, 0x8e91151u,
  0x6e0080du, 0x6e0082du, 0x6e0084du, 0x6e0086du, 0x6e0088du, 0x6e008adu, 0x4601071u, 0x8e91171u, 0x6a0101au, 0x6a0103au, 0x6a0105au, 0x6a0107au,
  0x6a0109au, 0x6a010bau, 0x4601091u, 0x8e91191u, 0xd6d911au, 0xd6d913au, 0xd6d915au, 0xd6d917au, 0xd6d919au, 0xd6d91bau, 0x46010b1u, 0x8e911b1u,
  0x6601019u, 0x6601039u, 0x6601059u, 0x6601079u, 0x6601099u, 0x66010b9u, 0x4600808u, 0x4600828u, 0xced1119u, 0xced1139u, 0xced1159u, 0xced1179u,
  0xced1199u, 0xced11b9u, 0x4600848u, 0x4600868u, 0x660080cu, 0x660082cu, 0x660084cu, 0x660086cu, 0x660088cu, 0x66008acu, 0x4600888u, 0x46008a8u,
  0x6201018u, 0x6201038u, 0x6201058u, 0x6201078u, 0x6201098u, 0x62010b8u, 0x4201010u, 0x8689110u, 0xc6c9118u, 0xc6c9138u, 0xc6c9158u, 0xc6c9178u,
  0xc6c9198u, 0xc6c91b8u, 0x4201030u, 0x8689130u, 0x5e01017u, 0x5e01037u, 0x5e01057u, 0x5e01077u, 0x5e01097u, 0x5e010b7u, 0x4201050u, 0x8689150u,
  0xbec1117u, 0xbec1137u, 0xbec1157u, 0xbec1177u, 0xbec1197u, 0xbec11b7u, 0x4201070u, 0x8689170u, 0x5e0080bu, 0x5e0082bu, 0x5e0084bu, 0x5e0086bu,
  0x5e0088bu, 0x5e008abu, 0x4201090u, 0x8689190u, 0x5a01016u, 0x5a01036u, 0x5a01056u, 0x5a01076u, 0x5a01096u, 0x5a010b6u, 0x42010b0u, 0x86891b0u,
  0xb6b9116u, 0xb6b9136u, 0xb6b9156u, 0xb6b9176u, 0xb6b9196u, 0xb6b91b6u, 0x3e00807u, 0x3e00827u, 0x5601015u, 0x5601035u, 0x5601055u, 0x5601075u,
  0x5601095u, 0x56010b5u, 0x3e00847u, 0x3e00867u, 0xaeb1115u, 0xaeb1135u, 0xaeb1155u, 0xaeb1175u, 0xaeb1195u, 0xaeb11b5u, 0x3e00887u, 0x3e008a7u,
  0x560080au, 0x560082au, 0x560084au, 0x560086au, 0x560088au, 0x56008aau, 0x3600806u, 0x3600826u, 0x5201014u, 0x5201034u, 0x5201054u, 0x5201074u,
  0x5201094u, 0x52010b4u, 0x3600846u, 0x3600866u, 0xa6a9114u, 0xa6a9134u, 0xa6a9154u, 0xa6a9174u, 0xa6a9194u, 0xa6a91b4u, 0x3600886u, 0x36008a6u,
  0x4e01013u, 0x4e01033u, 0x4e01053u, 0x4e01073u, 0x4e01093u, 0x4e010b3u, 0x2e00805u, 0x2e00825u, 0x9ea1113u, 0x9ea1133u, 0x9ea1153u, 0x9ea1173u,
  0x9ea1193u, 0x9ea11b3u, 0x2e00845u, 0x2e00865u, 0x2e00885u, 0x2e008a5u, 0x2600804u, 0x2600824u, 0x2600844u, 0x2600864u, 0x2600884u, 0x26008a4u,
  0x1e00803u, 0x1e00823u, 0x1e00843u, 0x1e00863u, 0x1e00883u, 0x1e008a3u, 0x1600802u, 0x1600822u, 0x1600842u, 0x1600862u, 0x1600882u, 0x16008a2u,
  0xe00801u, 0xe00821u, 0xe00841u, 0xe00861u, 0xe00881u, 0xe008a1u, 0x600800u, 0x600820u, 0x600840u, 0x600860u, 0x600880u, 0x6008a0u,
};
__device__ const unsigned char g_slot_base[32] = {0, 0, 0, 0, 0, 0, 0, 0, 0, 0, 0, 0, 0, 0, 0, 0, 0, 2, 4, 6, 8, 10, 12, 14, 16, 18, 20, 22, 24, 26, 28, 30};

#ifndef PROBE_PHASE
#define PROBE_PHASE 0
#endif
#define PROBE_BEGIN(k) unsigned long long pt0_##k = 0; if (PROBE_PHASE == k) pt0_##k = __builtin_amdgcn_s_memrealtime();
#define PROBE_END(k) if (PROBE_PHASE == k) { const unsigned long long dt_ = __builtin_amdgcn_s_memrealtime() - pt0_##k, t1_ = __builtin_amdgcn_s_memrealtime(); \
    while (__builtin_amdgcn_s_memrealtime() - t1_ < dt_) __builtin_amdgcn_s_sleep(8); }
__device__ void phaseC(const Params& p, int l, int ci, char* smem, int wv) {
  volatile int* ctl = (volatile int*)(smem + CTL_OFF);
  constexpr int N_MLA = 288, N_SB = 256, N_MEM = 128, N_G = 256;
  constexpr int N_ALL = N_MLA + N_SB + N_MEM + N_G;
  bool first = true;
  while (true) {
    __syncthreads();
    if (tid_of(wv) == 0) ctl[0] = first ? (int)blockIdx.x : (int)atomicAdd(&p.ctr()[ci], 1u);
    first = false;
    __syncthreads();
    const int qi = __builtin_amdgcn_readfirstlane(ctl[0]);
    if (qi >= N_ALL) break;
    const int item = qi < N_MLA ? qi : qi < N_MLA + N_G ? qi + N_SB + N_MEM : qi - N_G;
    const int kind_ = item < N_MLA ? 7 : item < N_MLA + N_SB ? 8 : item < N_MLA + N_SB + N_MEM ? 9 : 10;
    unsigned long long it0_ = 0; if (PROBE_PHASE == kind_) it0_ = __builtin_amdgcn_s_memrealtime();
    if (item < N_MLA) {
      const unsigned wd = g_mla_items[item];
      const int qb = wd & 31, hd = (wd >> 5) & 7, seg = (wd >> 8) & 7, nseg = (wd >> 11) & 7, t0 = (wd >> 14) & 127, t1 = (wd >> 21) & 127;
      const int q0 = qb * 256;
      const int sbase = g_slot_base[qb];
      attn_item<192, 128, 0, 2>(p.q() + ((size_t)hd * SEQ + q0) * 192, 192, p.k() + (size_t)hd * SEQ * 192, 192,
                                p.vt() + (size_t)hd * 128 * SEQ, SEQ, t0, t1, 4 * qb, 1.0f, q0,
                                p.h() + (size_t)q0 * DIN + C_GA + hd * 128, p.yin() + (size_t)q0 * DM + hd * 128, smem, wv,
                                nseg, seg, p.part() + (size_t)(sbase * 6 + hd) * (PART_BYTES / 4), p.ctr() + 64 + (l * 32 + qb) * 6 + hd, p.krope());
    } else if (item < N_MLA + N_SB) {
      const int it = item - N_MLA, qb = 63 - (it >> 2), hd = it & 3, q0 = qb * 128;
      attn_item<128, 128, 2, 1>(p.h() + (size_t)q0 * DIN + C_SBQ + hd * 128, DIN, p.h() + C_SBK + hd * 128, DIN,
                             p.vtsb() + (size_t)hd * 128 * SEQ, SEQ, 0, 2 * qb + 1, 2 * qb, 0.08838834764831845f, q0,
                             p.h() + (size_t)q0 * DIN + C_GC + hd * 128, p.yin() + (size_t)q0 * DM + 1280 + hd * 128, smem, wv);
    } else if (item < N_MLA + N_SB + N_MEM) {
      const int it = item - N_MLA - N_SB, qb = it >> 2, hd = it & 3, q0 = qb * 256;
      attn_item<64, 64, 1, 2>(p.h() + (size_t)q0 * DIN + C_MQ + hd * 64, DIN, p.mk() + (size_t)(l * 4 + hd) * 256 * 64, 64,
                           p.mvt() + (size_t)(l * 4 + hd) * 64 * 256, 256, 0, 3, 0, 0.125f * 1.4426950408889634f, q0,
                           p.h() + (size_t)q0 * DIN + C_GM + hd * 64, p.yin() + (size_t)q0 * DM + 1792 + hd * 64, smem, wv);
    } else {
      const int it = item - N_MLA - N_SB - N_MEM;
      gmlp_item(p, l, it >> 2, it & 3, smem, wv);
    }
    if (PROBE_PHASE == kind_) { const unsigned long long dt_ = __builtin_amdgcn_s_memrealtime() - it0_, t1_ = __builtin_amdgcn_s_memrealtime();
      while (__builtin_amdgcn_s_memrealtime() - t1_ < dt_) __builtin_amdgcn_s_sleep(8); }
  }
}

__global__ void __launch_bounds__(NT, 2) fwd_megakernel(Params p) {
  extern __shared__ __attribute__((aligned(16))) char smem[];
  volatile LAS unsigned* xst = (volatile LAS unsigned*)(smem + CTL_OFF + 16);
  const int wv = __builtin_amdgcn_readfirstlane(threadIdx.x >> 6);
  if (tid_of(wv) == 0) { xst[0] = 0u; xst[1] = 0u; }
  __syncthreads();
  const XcdBarrier xb = xcd_barrier_post(p.bar(), xst, wv);
#define grid_barrier() xcd_barrier(xb, wv)
  LAS unsigned char* glds = (LAS unsigned char*)smem;
  const int G = gridDim.x, B = blockIdx.x;
  PROBE_BEGIN(1)
  phase_prep(p, smem, wv);
  if (p.ws == nullptr) cg::this_grid().sync(); else grid_barrier();
  PROBE_END(1)
  for (int l = 0; l < NL; ++l) {
    int Bl = B, Gl = G, wvl = wv;
    asm volatile("" : "+s"(Bl), "+s"(Gl), "+s"(wvl));
    Params pl = p;
    { char* w_ = pl.ws; asm volatile("" : "+s"(w_)); pl.ws = w_; }
    PROBE_BEGIN(2)
    {
      pg8::StaticOrder S; S.init(SEQ, DINP, Gl, Bl);
      pg8::Gemm g{pl.xb(), pl.wt_in() + (size_t)l * DINP * DM, DM, DM, DM};
      EpiA E{pl, l};
      pg8::gemm_phase(glds, g, S, E, wvl);
    }
    if (l == 0) {
      __syncthreads();
      pg8::StaticOrder S; S.init(256, NL * 512, Gl, (Bl + 32) % Gl);
      pg8::Gemm g{pl.memb(), pl.wt_memkv(), DM, DM, DM};
      EpiMem E{pl};
      pg8::gemm_phase(glds, g, S, E, wvl);
    }
    grid_barrier();
    PROBE_END(2)
    PROBE_BEGIN(3)
    {
      pg8::StrideOrder Sq, Skv;
      if (Gl == 256) { Sq = pg8::StrideOrder{Bl, 0, Bl < 160 ? 1 : 0, 160}; Skv = pg8::StrideOrder{(Bl - 160) * 2, 1, Bl >= 160 ? 2 : 0, 192}; }
      else { Sq = pg8::StrideOrder{Bl, Gl, 1 << 20, 160}; Skv = pg8::StrideOrder{Bl, Gl, 1 << 20, 192}; }
      {
        pg8::Gemm g{pl.h() + C_CQ, pl.wt_uq() + (size_t)l * UQP * 512, DIN, 512, 512};
        EpiQ E{pl};
        pg8::gemm_phase(glds, g, Sq, E, wvl);
      }
      __syncthreads();
      {
        pg8::Gemm g{pl.h() + C_CKV, pl.wt_ukv() + (size_t)l * 1536 * 256, DIN, 256, 256};
        EpiKV E{pl};
        pg8::gemm_phase(glds, g, Skv, E, wvl);
      }
    }
    grid_barrier();
    PROBE_END(3)
    PROBE_BEGIN(4)
    phaseC(pl, l, l, smem, wvl);
    grid_barrier();
    PROBE_END(4)
    PROBE_BEGIN(5)
    {
      pg8::StaticOrder S; S.init(SEQ, DM, Gl, Bl);
      pg8::Gemm g{pl.yin(), pl.wt_out() + (size_t)l * DM * DM, DM, DM, DM};
      EpiDF E{pl, l, smem};
      pg8::gemm_phase(glds, g, S, E, wvl);
    }
    if (l + 1 < NL) grid_barrier();
    PROBE_END(5)
  }
}

extern "C" void kernel_launch(void* const* d_in, const int* in_sizes, int n_in, void* d_out, int out_size, void* d_ws,
                              size_t ws_size, hipStream_t stream) {
  static int grid_blocks = 0;
  if (!grid_blocks) {
    int dev = 0, cus = 0, per_cu = 0;
    (void)hipGetDevice(&dev);
    (void)hipDeviceGetAttribute(&cus, hipDeviceAttributeMultiprocessorCount, dev);
    (void)hipFuncSetAttribute((const void*)fwd_megakernel, hipFuncAttributeMaxDynamicSharedMemorySize, LDS_BYTES);
    (void)hipOccupancyMaxActiveBlocksPerMultiprocessor(&per_cu, fwd_megakernel, NT, LDS_BYTES);
    if (per_cu > 1) per_cu = 1;
    if (per_cu < 1) per_cu = 1;
    grid_blocks = cus * per_cu;
  }
  Params p{};
  p.x = (const float*)d_in[0]; p.mem = (const float*)d_in[1]; p.pos = (const int*)d_in[2]; p.w_in = (const float*)d_in[3];
  p.q_norm_g = (const float*)d_in[4]; p.w_uq = (const float*)d_in[5]; p.kv_norm_g = (const float*)d_in[6];
  p.w_ukv = (const float*)d_in[7]; p.sg_ln_g = (const float*)d_in[8]; p.sg_ln_b = (const float*)d_in[9];
  p.sg_w = (const float*)d_in[10]; p.sg_b = (const float*)d_in[11]; p.w_mem_k = (const float*)d_in[12];
  p.w_mem_v = (const float*)d_in[13]; p.w_out = (const float*)d_in[14]; p.ln_g = (const float*)d_in[15];
  p.ln_b = (const float*)d_in[16];
  p.out = (float*)d_out;
  p.ws = (char*)d_ws;
  (void)hipMemsetAsync(p.ws + OFF_BAR, 0, 16384, stream);
  void* args[] = {&p};
  hipError_t e = hipLaunchCooperativeKernel((const void*)fwd_megakernel, dim3(grid_blocks), dim3(NT), args, LDS_BYTES, stream);
  if (e != hipSuccess) fprintf(stderr, "cooperative launch failed: %s (grid %d)\n", hipGetErrorString(e), grid_blocks);
}
```
